# Optimizing an MI355X kernel written in HIP

```python
import math
import jax
import jax.numpy as jnp
from jax import lax
import numpy as np

D_MODEL = 2048
BATCH = 1
SEQ = 8192
DEPTH = 4

GRID_W = 64
CTX_LEN = 256
HEAD_DIM = 128
A_Q_HEADS = 8
A_KV_HEADS = 2
B_Q_HEADS = 8
B_KV_HEADS = 2
WINDOW = 128
ATTN_BLOCK = 128
ROPE_THETA = 10000.0
AXIS_DIM = HEAD_DIM // 2
Q_WIDTH = (A_Q_HEADS + B_Q_HEADS) * HEAD_DIM
KV_WIDTH = (A_KV_HEADS + B_KV_HEADS) * HEAD_DIM
ATTN_IN_WIDTH = Q_WIDTH + 2 * KV_WIDTH
HYENA_ORDER = 2
HYENA_IN_WIDTH = (HYENA_ORDER + 1) * D_MODEL
SHORT_CONV = 3
FILTER_EMB = 33
FILTER_HIDDEN = 64
DECAY_TARGET = 1e-2
FAST_DECAY_PCT = 0.3
SLOW_DECAY_PCT = 1.5
MAX_DECAY = math.log(DECAY_TARGET) / FAST_DECAY_PCT
MIN_DECAY = math.log(DECAY_TARGET) / SLOW_DECAY_PCT
D_FF = 4 * D_MODEL
N_MOD = 6
N_ATTN_LAYERS = (DEPTH + 1) // 2
N_HYENA_LAYERS = DEPTH // 2
EPS = 1e-6

kernel_name = 'hybrid_swa_axial_hyena_dit_block'


def rms_norm(x, g):
    x32 = x.astype(jnp.float32)
    y = x32 * lax.rsqrt(jnp.mean(x32 * x32, axis=-1, keepdims=True) + EPS)
    return y.astype(x.dtype) * g


def modulate(h, shift, scale):
    return h * (1 + scale) + shift


def axial_rope_tables(n_tok):
    rows = n_tok // GRID_W
    row = jnp.repeat(jnp.arange(rows, dtype=jnp.float32), GRID_W)
    col = jnp.tile(jnp.arange(GRID_W, dtype=jnp.float32), rows)
    inv = ROPE_THETA ** (-jnp.arange(0, AXIS_DIM, 2, dtype=jnp.float32) / AXIS_DIM)
    ang_r = row[:, None] * inv[None]
    ang_c = col[:, None] * inv[None]
    return (jnp.cos(ang_r), jnp.sin(ang_r), jnp.cos(ang_c), jnp.sin(ang_c))


def _rotate(x, cos, sin):
    x1, x2 = jnp.split(x, 2, axis=-1)
    cos = cos[:, None, :].astype(x.dtype)
    sin = sin[:, None, :].astype(x.dtype)
    return jnp.concatenate([x1 * cos - x2 * sin, x2 * cos + x1 * sin], axis=-1)


def apply_axial_rope(x, rope):
    cos_r, sin_r, cos_c, sin_c = rope
    xr, xc = jnp.split(x, 2, axis=-1)
    return jnp.concatenate([_rotate(xr, cos_r, sin_r), _rotate(xc, cos_c, sin_c)], axis=-1)


def _split_cols(t, sizes):
    idx = [int(v) for v in np.cumsum(sizes)[:-1]]
    return jnp.split(t, idx, axis=-1)


def _heads(t):
    return t.reshape(t.shape[0], t.shape[1], -1, HEAD_DIM)


def _gqa(q, n_kv):
    b, s, hq, dh = q.shape
    return q.reshape(b, s, n_kv, hq // n_kv, dh)


def window_attention(q, k, v, k_ctx, v_ctx, sink):
    b, s, hkv, g, dh = q.shape
    nb = s // ATTN_BLOCK
    nw = -(-WINDOW // ATTN_BLOCK)
    kw_len = (2 * nw + 1) * ATTN_BLOCK
    n_ctx = k_ctx.shape[1]
    qb = q.reshape(b, nb, ATTN_BLOCK, hkv, g, dh)
    pad = ((0, 0), (nw * ATTN_BLOCK, nw * ATTN_BLOCK), (0, 0), (0, 0))
    kp = jnp.pad(k, pad).reshape(b, nb + 2 * nw, ATTN_BLOCK, hkv, dh)
    vp = jnp.pad(v, pad).reshape(b, nb + 2 * nw, ATTN_BLOCK, hkv, dh)
    kw = jnp.concatenate([kp[:, o:o + nb] for o in range(2 * nw + 1)], axis=2)
    vw = jnp.concatenate([vp[:, o:o + nb] for o in range(2 * nw + 1)], axis=2)
    blk = jnp.arange(nb)[:, None] * ATTN_BLOCK
    q_pos = blk + jnp.arange(ATTN_BLOCK)[None]
    k_pos = blk - nw * ATTN_BLOCK + jnp.arange(kw_len)[None]
    valid = (jnp.abs(k_pos[:, None, :] - q_pos[:, :, None]) <= WINDOW) & ((k_pos >= 0) & (k_pos < s))[:, None, :]
    s_loc = jnp.einsum('bnqhgd,bnkhd->bnhgqk', qb, kw).astype(jnp.float32)
    s_loc = jnp.where(valid[None, :, None, None], s_loc, -jnp.inf)
    s_ctx = jnp.einsum('bnqhgd,bchd->bnhgqc', qb, k_ctx).astype(jnp.float32)
    s_sink = jnp.broadcast_to(sink.astype(jnp.float32).reshape(hkv, g)[None, None, :, :, None, None], s_loc.shape[:-1] + (1,))
    p = jax.nn.softmax(jnp.concatenate([s_loc, s_ctx, s_sink], axis=-1), axis=-1).astype(v.dtype)
    o = (jnp.einsum('bnhgqk,bnkhd->bnqhgd', p[..., :kw_len], vw)
         + jnp.einsum('bnhgqc,bchd->bnqhgd', p[..., kw_len:kw_len + n_ctx], v_ctx))
    return o.reshape(b, s, hkv * g, dh)


def global_attention(q, k_all, v_all):
    b, s, hkv, g, dh = q.shape
    nb = s // ATTN_BLOCK
    qb = jnp.moveaxis(q.reshape(b, nb, ATTN_BLOCK, hkv, g, dh), 1, 0)

    def one_block(q_blk):
        sc = jnp.einsum('bqhgd,bkhd->bhgqk', q_blk, k_all).astype(jnp.float32)
        p = jax.nn.softmax(sc, axis=-1).astype(v_all.dtype)
        return jnp.einsum('bhgqk,bkhd->bqhgd', p, v_all)

    o = lax.map(one_block, qb)
    return jnp.moveaxis(o, 0, 1).reshape(b, s, hkv * g, dh)


def context_attention(q, k, v, sink=None):
    b, n, hkv, g, dh = q.shape
    sc = jnp.einsum('bqhgd,bkhd->bhgqk', q, k).astype(jnp.float32)
    if sink is not None:
        s_sink = jnp.broadcast_to(sink.astype(jnp.float32).reshape(hkv, g)[None, :, :, None, None], sc.shape[:-1] + (1,))
        p = jax.nn.softmax(jnp.concatenate([sc, s_sink], axis=-1), axis=-1)[..., :-1]
    else:
        p = jax.nn.softmax(sc, axis=-1)
    o = jnp.einsum('bhgqk,bkhd->bqhgd', p.astype(v.dtype), v)
    return o.reshape(b, n, hkv * g, dh)


def attention_mixer(h_lat, h_ctx, w_in, w_out, sink, q_norm, k_norm, rope, ctx_out):
    b, s, _ = h_lat.shape
    n_ctx = h_ctx.shape[1]
    scale = HEAD_DIM ** -0.5
    kv_sizes = [A_KV_HEADS * HEAD_DIM, B_KV_HEADS * HEAD_DIM, A_KV_HEADS * HEAD_DIM, B_KV_HEADS * HEAD_DIM]
    q_sizes = [A_Q_HEADS * HEAD_DIM, B_Q_HEADS * HEAD_DIM]
    qa, qb, ka, kb, va, vb = [_heads(t) for t in _split_cols(h_lat @ w_in, q_sizes + kv_sizes)]
    qb = rms_norm(qb, q_norm)
    kb = rms_norm(kb, k_norm)
    qa, ka, qb, kb = [apply_axial_rope(t, rope) for t in (qa, ka, qb, kb)]
    ka_c, kb_c, va_c, vb_c = [_heads(t) for t in _split_cols(h_ctx @ w_in[:, Q_WIDTH:], kv_sizes)]
    kb_c = rms_norm(kb_c, k_norm)
    o_a = window_attention(_gqa(qa * scale, A_KV_HEADS), ka, va, ka_c, va_c, sink)
    o_b = global_attention(_gqa(qb * scale, B_KV_HEADS),
                           jnp.concatenate([kb_c, kb], axis=1), jnp.concatenate([vb_c, vb], axis=1))
    y_lat = jnp.concatenate([o_a, o_b], axis=2).reshape(b, s, Q_WIDTH) @ w_out
    if not ctx_out:
        return y_lat, None
    qa_c, qb_c = [_heads(t) for t in _split_cols(h_ctx @ w_in[:, :Q_WIDTH], q_sizes)]
    qb_c = rms_norm(qb_c, q_norm)
    o_ac = context_attention(_gqa(qa_c * scale, A_KV_HEADS), ka_c, va_c, sink)
    o_bc = context_attention(_gqa(qb_c * scale, B_KV_HEADS), kb_c, vb_c)
    y_ctx = jnp.concatenate([o_ac, o_bc], axis=2).reshape(b, n_ctx, Q_WIDTH) @ w_out
    return y_lat, y_ctx


def hyena_filters(n_tok, w1, b1, fr1, w2, b2, fr2, w3):
    f32 = jnp.float32
    bands = (FILTER_EMB - 1) // 2
    t = jnp.linspace(0.0, 1.0, n_tok, dtype=f32)[:, None]
    w = 2.0 * math.pi * jnp.arange(n_tok, dtype=f32)[:, None] / n_tok
    f = jnp.linspace(1e-4, bands - 1, bands, dtype=f32)[None]
    feats = jnp.concatenate([t, jnp.cos(f * w), -jnp.sin(f * w)], axis=-1)
    hid = jnp.sin(fr1.astype(f32) * (feats @ w1.astype(f32) + b1.astype(f32)))
    hid = jnp.sin(fr2.astype(f32) * (hid @ w2.astype(f32) + b2.astype(f32)))
    h = (hid @ w3.astype(f32)).reshape(n_tok, HYENA_ORDER, D_MODEL)
    offs = jnp.abs(jnp.arange(n_tok) - n_tok // 2).astype(f32) * (2.0 / n_tok)
    deltas = jnp.abs(jnp.linspace(MIN_DECAY, MAX_DECAY, D_MODEL, dtype=f32))
    h = h * jnp.exp(-offs[:, None, None] * deltas[None, None, :])
    return h * lax.rsqrt(jnp.sum(h * h, axis=0, keepdims=True) + EPS)


def centred_long_conv(z, h):
    n_tok = z.shape[1]
    n_fft = 2 * n_tok
    zf = jnp.fft.rfft(z.astype(jnp.float32), n=n_fft, axis=1)
    hf = jnp.fft.rfft(h, n=n_fft, axis=0)
    y = jnp.fft.irfft(zf * hf[None], n=n_fft, axis=1)[:, n_tok // 2:n_tok // 2 + n_tok]
    return y.astype(z.dtype)


def centred_short_conv(u, w, b):
    n_tok = u.shape[1]
    half = SHORT_CONV // 2
    up = jnp.pad(u, ((0, 0), (half, half), (0, 0)))
    return sum(up[:, k:k + n_tok] * w[k] for k in range(SHORT_CONV)) + b


def hyena_mixer(h, w_in, b_in, conv_w, conv_b, filt, skip, w_out, b_out):
    u = centred_short_conv(h @ w_in + b_in, conv_w, conv_b)
    x1, x2, v = jnp.split(u, HYENA_ORDER + 1, axis=-1)
    z = x1 * (centred_long_conv(v, filt[:, 0]) + v * skip[0])
    z = x2 * (centred_long_conv(z, filt[:, 1]) + z * skip[1])
    return z @ w_out + b_out


def sq_relu_mlp(h, w1, w2):
    return jnp.square(jax.nn.relu(h @ w1)) @ w2


def setup_inputs(seed: int = 0) -> dict:
    key = jax.random.key(seed)
    ks = iter(jax.random.split(key, 40))

    def nrm(shape, scale):
        return scale * jax.random.normal(next(ks), shape, jnp.float32)

    D = D_MODEL
    NA = N_ATTN_LAYERS
    NH = N_HYENA_LAYERS
    return {
        'x': nrm((BATCH, SEQ, D), 1.0),
        'c': nrm((BATCH, D), 1.0),
        'ctx': nrm((BATCH, CTX_LEN, D), 1.0),
        'c_ctx': nrm((D,), 1.0),
        'mod_w': nrm((DEPTH, D, N_MOD * D), 0.5 * D ** -0.5),
        'mod_b': nrm((DEPTH, N_MOD * D), 0.01),
        'norm_mix_g': 1.0 + nrm((DEPTH, D), 0.02),
        'norm_mlp_g': 1.0 + nrm((DEPTH, D), 0.02),
        'attn_w_in': nrm((NA, D, ATTN_IN_WIDTH), D ** -0.5),
        'attn_w_out': nrm((NA, Q_WIDTH, D), Q_WIDTH ** -0.5),
        'attn_sink': nrm((NA, A_Q_HEADS), 1.0),
        'attn_q_norm': 1.0 + nrm((NA, HEAD_DIM), 0.02),
        'attn_k_norm': 1.0 + nrm((NA, HEAD_DIM), 0.02),
        'hy_w_in': nrm((NH, D, HYENA_IN_WIDTH), D ** -0.5),
        'hy_b_in': nrm((NH, HYENA_IN_WIDTH), 0.01),
        'hy_conv_w': nrm((NH, SHORT_CONV, HYENA_IN_WIDTH), SHORT_CONV ** -0.5),
        'hy_conv_b': nrm((NH, HYENA_IN_WIDTH), 0.01),
        'hy_f_w1': nrm((NH, FILTER_EMB, FILTER_HIDDEN), FILTER_EMB ** -0.5),
        'hy_f_b1': nrm((NH, FILTER_HIDDEN), 0.1),
        'hy_f_freq1': 1.0 + nrm((NH, FILTER_HIDDEN), 0.02),
        'hy_f_w2': nrm((NH, FILTER_HIDDEN, FILTER_HIDDEN), FILTER_HIDDEN ** -0.5),
        'hy_f_b2': nrm((NH, FILTER_HIDDEN), 0.1),
        'hy_f_freq2': 1.0 + nrm((NH, FILTER_HIDDEN), 0.02),
        'hy_f_w3': nrm((NH, FILTER_HIDDEN, HYENA_ORDER * D), FILTER_HIDDEN ** -0.5),
        'hy_skip': nrm((NH, HYENA_ORDER, D), 0.5),
        'hy_w_out': nrm((NH, D, D), D ** -0.5),
        'hy_b_out': nrm((NH, D), 0.01),
        'mlp_w1': nrm((DEPTH, D, D_FF), D ** -0.5),
        'mlp_w2': nrm((DEPTH, D_FF, D), D_FF ** -0.5),
        'final_g': 1.0 + nrm((D,), 0.02),
    }


def reference(x, c, ctx, c_ctx, mod_w, mod_b, norm_mix_g, norm_mlp_g,
              attn_w_in, attn_w_out, attn_sink, attn_q_norm, attn_k_norm,
              hy_w_in, hy_b_in, hy_conv_w, hy_conv_b, hy_f_w1, hy_f_b1, hy_f_freq1,
              hy_f_w2, hy_f_b2, hy_f_freq2, hy_f_w3, hy_skip, hy_w_out, hy_b_out,
              mlp_w1, mlp_w2, final_g):
    n_lat = x.shape[1]
    n_ctx = ctx.shape[1]
    rope = axial_rope_tables(n_lat)
    last_ctx_layer = 2 * ((DEPTH - 1) // 2)
    c_act = jax.nn.silu(c)
    cc_act = jax.nn.silu(c_ctx)
    ctx_s = ctx
    for i in range(DEPTH):
        j = i // 2
        is_attn = (i % 2 == 0)
        ctx_updated = i < last_ctx_layer
        mod = (c_act @ mod_w[i] + mod_b[i])[:, None, :]
        sh1, sc1, g1, sh2, sc2, g2 = jnp.split(mod, N_MOD, axis=-1)
        h_lat = modulate(rms_norm(x, norm_mix_g[i]), sh1, sc1)
        if is_attn or ctx_updated:
            mod_c = cc_act @ mod_w[i] + mod_b[i]
            csh1, csc1, cg1, csh2, csc2, cg2 = jnp.split(mod_c, N_MOD, axis=-1)
            h_ctx = modulate(rms_norm(ctx_s, norm_mix_g[i]), csh1, csc1)
        if is_attn:
            y_lat, y_ctx = attention_mixer(h_lat, h_ctx, attn_w_in[j], attn_w_out[j], attn_sink[j],
                                           attn_q_norm[j], attn_k_norm[j], rope, ctx_updated)
        else:
            fparams = (hy_f_w1[j], hy_f_b1[j], hy_f_freq1[j], hy_f_w2[j], hy_f_b2[j], hy_f_freq2[j], hy_f_w3[j])
            y_lat = hyena_mixer(h_lat, hy_w_in[j], hy_b_in[j], hy_conv_w[j], hy_conv_b[j],
                                hyena_filters(n_lat, *fparams), hy_skip[j], hy_w_out[j], hy_b_out[j])
            if ctx_updated:
                y_ctx = hyena_mixer(h_ctx, hy_w_in[j], hy_b_in[j], hy_conv_w[j], hy_conv_b[j],
                                    hyena_filters(n_ctx, *fparams), hy_skip[j], hy_w_out[j], hy_b_out[j])
        x = x + g1 * y_lat
        x = x + g2 * sq_relu_mlp(modulate(rms_norm(x, norm_mlp_g[i]), sh2, sc2), mlp_w1[i], mlp_w2[i])
        if ctx_updated:
            ctx_s = ctx_s + cg1 * y_ctx
            ctx_s = ctx_s + cg2 * sq_relu_mlp(modulate(rms_norm(ctx_s, norm_mlp_g[i]), csh2, csc2), mlp_w1[i], mlp_w2[i])
    return rms_norm(x, final_g)
```

```cpp
#include <hip/hip_runtime.h>
#include <cstdio>
#include <cstdint>
#define MK_ONE_LAUNCH 1
namespace pg8 {
#define PG8_LAS __attribute__((address_space(3)))
typedef unsigned short bf16_t;
typedef short bf16x8 __attribute__((ext_vector_type(8)));
typedef float f32x4 __attribute__((ext_vector_type(4)));
typedef unsigned u32x4 __attribute__((ext_vector_type(4)));
constexpr int BM = 256, BK = 64, HALF = 128, HTB = HALF * BK * 2  , STAGE_BYTES = 8 * HTB, NXCD = 8, WGM = 8;

__host__ __device__ __forceinline__ int lds_byte(int r, int c) { const int st = (r >> 4) * 2 + (c >> 5), rr = r & 15, cc = c & 31, ob = rr * 64 + cc * 2; return st * 1024 + (ob ^ (((ob >> 9) & 1) << 5)); }
__host__ __device__ __forceinline__ void stage_rc(int b, int& R, int& C) { const int st = b / 1024, sb = b % 1024, swz = sb ^ (((sb >> 9) & 1) << 5); R = (st >> 1) * 16 + swz / 64; C = (st & 1) * 32 + (swz % 64) / 2; }
__host__ __device__ __forceinline__ int perm32(int rho) { const int n = rho >> 4, i = rho & 15; return 8 * (i >> 2) + 4 * n + (i & 3); }

struct Unit { int pm, pn; };
struct Gemm { const bf16_t* A; const bf16_t* Bt; int M, N, K; };

struct StaticOrder {
    int nM, nN, nwg, G, c;
    __host__ __device__ void init(int M, int N, int G_, int c_) { nM = M / BM; nN = N / BM; nwg = nM * nN; G = G_; c = c_; }
    __host__ __device__ bool next(int i, Unit& u) const {
        const long L = (long)i * G + c; if (L >= nwg) return false;
        int wgid = (int)L; { const int q = nwg / NXCD, r = nwg % NXCD, xcd = wgid % NXCD, off = wgid / NXCD; wgid = (xcd < r ? xcd * (q + 1) : r * (q + 1) + (xcd - r) * q) + off; }
        const int nig = WGM * nN, gid = wgid / nig, fm = gid * WGM, gsz = (nM - fm) < WGM ? (nM - fm) : WGM;
        u.pm = fm + ((wgid % nig) % gsz); u.pn = (wgid % nig) / gsz; return true;
    }
    __device__ __forceinline__ void a_ready(const Unit&) const {}
    __device__ __forceinline__ void done(const Unit&) const {}
};

__device__ __forceinline__ unsigned cvt_pk_bf16(float lo, float hi) { unsigned r; asm volatile("v_cvt_pk_bf16_f32 %0, %1, %2" : "=v"(r) : "v"(lo), "v"(hi)); return r; }

template <int ACT> struct EpiBf16 {
    static constexpr bool PERM = true, AFTER_DRAIN = false;
    bf16_t* O; int ldc; const float* bias;
    __device__ __forceinline__ void operator()(const f32x4 (&acc)[2][2][4][2], const Unit& u, int wr, int wc, int fr, int fq) const {
        const int row0 = u.pm * BM + wr * 64 + fr; const int col0 = u.pn * BM + wc * 32 + 8 * fq;
        f32x4 bv[2][2];
#pragma unroll
        for (int bj = 0; bj < 2; ++bj)
#pragma unroll
            for (int n = 0; n < 2; ++n) bv[bj][n] = bias ? *(const f32x4*)(bias + col0 + bj * HALF + 4 * n) : (f32x4){0.f, 0.f, 0.f, 0.f};
#pragma unroll
        for (int ai = 0; ai < 2; ++ai)
#pragma unroll
            for (int m = 0; m < 4; ++m) { bf16_t* rowp = O + (size_t)(row0 + ai * HALF + m * 16) * ldc + col0;
#pragma unroll
                for (int bj = 0; bj < 2; ++bj) { f32x4 v0 = acc[ai][bj][m][0] + bv[bj][0], v1 = acc[ai][bj][m][1] + bv[bj][1];
                    if (ACT == 1) {
#pragma unroll
                        for (int j = 0; j < 4; ++j) { const float a = fmaxf(v0[j], 0.f), b = fmaxf(v1[j], 0.f); v0[j] = a * a; v1[j] = b * b; } }
                    u32x4 w; w.x = cvt_pk_bf16(v0[0], v0[1]); w.y = cvt_pk_bf16(v0[2], v0[3]); w.z = cvt_pk_bf16(v1[0], v1[1]); w.w = cvt_pk_bf16(v1[2], v1[3]);
                    *(u32x4*)(rowp + bj * HALF) = w; } }
    }
};
struct EpiResGate {
    static constexpr bool PERM = false, AFTER_DRAIN = false;
    float* X; int ldc; const float* bias; const float* gate_lat; const float* gate_ctx; int ctx_pm;
    __device__ __forceinline__ void operator()(const f32x4 (&acc)[2][2][4][2], const Unit& u, int wr, int wc, int fr, int fq) const {
        const int row0 = u.pm * BM + wr * 64 + fr, col0 = u.pn * BM + wc * 32 + 4 * fq;
        const float* gate = (u.pm >= ctx_pm) ? gate_ctx : gate_lat;
        f32x4 bv[2][2], gv[2][2];
#pragma unroll
        for (int bj = 0; bj < 2; ++bj)
#pragma unroll
            for (int n = 0; n < 2; ++n) { bv[bj][n] = bias ? *(const f32x4*)(bias + col0 + bj * HALF + n * 16) : (f32x4){0.f, 0.f, 0.f, 0.f};
                gv[bj][n] = *(const f32x4*)(gate + col0 + bj * HALF + n * 16); }
#pragma unroll
        for (int ai = 0; ai < 2; ++ai)
#pragma unroll
            for (int m = 0; m < 4; ++m) { float* rowp = X + (size_t)(row0 + ai * HALF + m * 16) * ldc + col0;
#pragma unroll
                for (int bj = 0; bj < 2; ++bj)
#pragma unroll
                    for (int n = 0; n < 2; ++n) { f32x4* p = (f32x4*)(rowp + bj * HALF + n * 16); const f32x4 old = *p; *p = old + gv[bj][n] * (acc[ai][bj][m][n] + bv[bj][n]); } }
    }
};

template <class Epi, class Sched, bool ALIGN_EPI = false, bool SP2 = false>
__device__ __forceinline__ void gemm_phase(PG8_LAS unsigned char* lds, const Gemm g, const Sched& S, const Epi& E, const int tid) {
    const int wid = __builtin_amdgcn_readfirstlane(tid >> 6), lane = tid & 63, wr = wid >> 2, wc = wid & 3, fr = lane & 15, fq = lane >> 4;
    const int K = g.K, nt = K / BK;
    unsigned voffA[2], voffB[2];
#pragma unroll
    for (int i = 0; i < 2; ++i) { int R, C; stage_rc(tid * 16 + i * 8192, R, C); const int Rb = Epi::PERM ? ((R & ~31) + perm32(R & 31)) : R;
        voffA[i] = (unsigned)(R * K + C) * 2u; voffB[i] = (unsigned)(Rb * K + C) * 2u; }
    const size_t kstep = (size_t)(BK * 2);
    const size_t hstep = (size_t)HALF * K * 2;
    const size_t tstep = 2 * hstep;
    const unsigned ldsw = (unsigned)wid * 1024u;
    const int aoff = lds_byte(wr * 64 + fr, fq * 8), boff = lds_byte(wc * 32 + fr, fq * 8);
#define PG8_SA(b, h) (((b) * 2 + (h)) * HTB)
#define PG8_SB(b, h) ((4 + (b) * 2 + (h)) * HTB)
#define PG8_STAGE(bufoff, gbase, voff) do { _Pragma("unroll") for (int _i = 0; _i < 2; ++_i) \
        __builtin_amdgcn_global_load_lds((const unsigned*)((const char*)(gbase) + (voff)[_i]), (PG8_LAS unsigned*)(lds + (bufoff) + ldsw + _i * 8192), 16, 0, 0); } while (0)
#define PG8_LDA(dst, b, h) do { _Pragma("unroll") for (int m = 0; m < 4; ++m) _Pragma("unroll") for (int k = 0; k < 2; ++k) dst[m][k] = *(const PG8_LAS bf16x8*)(lds + PG8_SA(b, h) + aoff + m * 2048 + k * 1024); } while (0)
#define PG8_LDB(dst, b, h) do { _Pragma("unroll") for (int n = 0; n < 2; ++n) _Pragma("unroll") for (int k = 0; k < 2; ++k) dst[n][k] = *(const PG8_LAS bf16x8*)(lds + PG8_SB(b, h) + boff + n * 2048 + k * 1024); } while (0)
#define PG8_MMA(ai, bj, At, Bt) do { __builtin_amdgcn_s_setprio(1); _Pragma("unroll") for (int m = 0; m < 4; ++m) _Pragma("unroll") for (int n = 0; n < 2; ++n) _Pragma("unroll") for (int k = 0; k < 2; ++k) \
        acc[ai][bj][m][n] = __builtin_amdgcn_mfma_f32_16x16x32_bf16(Bt[n][k], At[m][k], acc[ai][bj][m][n], 0, 0, 0); __builtin_amdgcn_s_setprio(0); } while (0)
#define PG8_WAIT_V(n) asm volatile("s_waitcnt vmcnt(" #n ")" ::: "memory")
#define PG8_WAIT_L(n) asm volatile("s_waitcnt lgkmcnt(" #n ")" ::: "memory")
#define PG8_BAR __builtin_amdgcn_s_barrier()
#define PG8_SCHED __builtin_amdgcn_sched_barrier(0)
    Unit cur, nxt; int ui = 0;
    if (!S.next(0, cur)) return;
    f32x4 acc[2][2][4][2];
#pragma unroll
    for (int a = 0; a < 2; ++a)
#pragma unroll
        for (int b = 0; b < 2; ++b)
#pragma unroll
            for (int m = 0; m < 4; ++m)
#pragma unroll
                for (int n = 0; n < 2; ++n) acc[a][b][m][n] = (f32x4){0.f, 0.f, 0.f, 0.f};
    bf16x8 At[4][2], B0[2][2], B1[2][2];
    const char* cA = (const char*)g.A + (size_t)cur.pm * tstep; const char* cB = (const char*)g.Bt + (size_t)cur.pn * tstep;
    S.a_ready(cur);
    if constexpr (SP2) {
        PG8_STAGE(PG8_SB(0, 0), cB, voffB); PG8_STAGE(PG8_SB(0, 1), cB + hstep, voffB); PG8_STAGE(PG8_SA(0, 0), cA, voffA); PG8_STAGE(PG8_SA(0, 1), cA + hstep, voffA);
        if (wr == 1) PG8_BAR;
        PG8_WAIT_V(2); PG8_BAR;
        PG8_STAGE(PG8_SB(1, 0), cB + kstep, voffB); PG8_STAGE(PG8_SA(1, 0), cA + kstep, voffA); PG8_STAGE(PG8_SB(1, 1), cB + hstep + kstep, voffB);
        PG8_WAIT_V(6); PG8_BAR;
    } else {
        PG8_STAGE(PG8_SB(0, 0), cB, voffB); PG8_STAGE(PG8_SA(0, 0), cA, voffA); PG8_STAGE(PG8_SB(0, 1), cB + hstep, voffB); PG8_STAGE(PG8_SA(0, 1), cA + hstep, voffA);
        if (wr == 1) PG8_BAR;
        PG8_WAIT_V(4); PG8_BAR;
        PG8_STAGE(PG8_SB(1, 0), cB + kstep, voffB); PG8_STAGE(PG8_SA(1, 0), cA + kstep, voffA); PG8_STAGE(PG8_SB(1, 1), cB + hstep + kstep, voffB);
        PG8_WAIT_V(6); PG8_BAR;
    }
    for (;;) {
        const bool has_next = S.next(ui + 1, nxt);
        const char* nA = has_next ? (const char*)g.A + (size_t)nxt.pm * tstep : cA; const char* nB = has_next ? (const char*)g.Bt + (size_t)nxt.pn * tstep : cB;
        for (int t = 0; t < nt; t += 2) {
            const bool last = (t == nt - 2);
            const char* a1 = cA + (size_t)(t + 1) * kstep;
            const char* a2 = last ? nA : cA + (size_t)(t + 2) * kstep; const char* b2 = last ? nB : cB + (size_t)(t + 2) * kstep;
            const char* a3 = a2 + kstep; const char* b3 = b2 + kstep;
            if (last && has_next) S.a_ready(nxt);
            if constexpr (SP2) {
            PG8_LDB(B0, 0, 0); PG8_LDB(B1, 0, 1); PG8_SCHED; PG8_LDA(At, 0, 0); PG8_STAGE(PG8_SA(1, 1), a1 + hstep, voffA);
            PG8_WAIT_V(8); PG8_WAIT_L(0); PG8_BAR; PG8_MMA(0, 0, At, B0); PG8_MMA(0, 1, At, B1); PG8_BAR; PG8_SCHED;
            PG8_LDA(At, 0, 1); PG8_STAGE(PG8_SB(0, 0), b2, voffB); PG8_STAGE(PG8_SB(0, 1), b2 + hstep, voffB); PG8_STAGE(PG8_SA(0, 0), a2, voffA);
            PG8_WAIT_V(8); PG8_WAIT_L(0); PG8_BAR; PG8_MMA(1, 0, At, B0); PG8_MMA(1, 1, At, B1); PG8_BAR; PG8_SCHED;
            PG8_LDB(B0, 1, 0); PG8_LDB(B1, 1, 1); PG8_SCHED; PG8_LDA(At, 1, 0); PG8_STAGE(PG8_SA(0, 1), a2 + hstep, voffA);
            PG8_WAIT_V(8); PG8_WAIT_L(0); PG8_BAR; PG8_MMA(0, 0, At, B0); PG8_MMA(0, 1, At, B1); PG8_BAR; PG8_SCHED;
            PG8_LDA(At, 1, 1); PG8_STAGE(PG8_SB(1, 0), b3, voffB); PG8_STAGE(PG8_SB(1, 1), b3 + hstep, voffB); PG8_STAGE(PG8_SA(1, 0), a3, voffA);
            PG8_WAIT_V(8); PG8_WAIT_L(0); PG8_BAR; PG8_MMA(1, 0, At, B0); PG8_MMA(1, 1, At, B1); PG8_BAR; PG8_SCHED;
            } else {
            PG8_LDB(B0, 0, 0); PG8_SCHED; PG8_LDA(At, 0, 0); PG8_STAGE(PG8_SA(1, 1), a1 + hstep, voffA);
            PG8_WAIT_L(8); PG8_BAR; PG8_WAIT_L(0); PG8_MMA(0, 0, At, B0); PG8_BAR; PG8_SCHED;
            PG8_LDB(B1, 0, 1); PG8_STAGE(PG8_SB(0, 0), b2, voffB);
            PG8_BAR; PG8_WAIT_L(0); PG8_MMA(0, 1, At, B1); PG8_BAR;
            PG8_LDA(At, 0, 1); PG8_STAGE(PG8_SA(0, 0), a2, voffA);
            PG8_BAR; PG8_WAIT_L(0); PG8_MMA(1, 0, At, B0); PG8_BAR; PG8_SCHED;
            PG8_STAGE(PG8_SB(0, 1), b2 + hstep, voffB);
            PG8_WAIT_V(6); PG8_BAR; PG8_MMA(1, 1, At, B1); PG8_BAR;
            PG8_LDB(B0, 1, 0); PG8_SCHED; PG8_LDA(At, 1, 0); PG8_STAGE(PG8_SA(0, 1), a2 + hstep, voffA);
            PG8_WAIT_L(8); PG8_BAR; PG8_WAIT_L(0); PG8_MMA(0, 0, At, B0); PG8_BAR; PG8_SCHED;
            PG8_LDB(B1, 1, 1); PG8_STAGE(PG8_SB(1, 0), b3, voffB);
            PG8_BAR; PG8_WAIT_L(0); PG8_MMA(0, 1, At, B1); PG8_BAR;
            PG8_LDA(At, 1, 1); PG8_STAGE(PG8_SA(1, 0), a3, voffA);
            PG8_BAR; PG8_WAIT_L(0); PG8_MMA(1, 0, At, B0); PG8_BAR; PG8_SCHED;
            PG8_STAGE(PG8_SB(1, 1), b3 + hstep, voffB);
            PG8_WAIT_V(6); PG8_BAR; PG8_MMA(1, 1, At, B1); PG8_BAR;
            }
        }
        if constexpr (ALIGN_EPI) { if (wr == 0) PG8_BAR; }
        if constexpr (!Epi::AFTER_DRAIN) { E(acc, cur, wr, wc, fr, fq); S.done(cur); }
        if (!has_next) break;
#pragma unroll
        for (int a = 0; a < 2; ++a)
#pragma unroll
            for (int b = 0; b < 2; ++b)
#pragma unroll
                for (int m = 0; m < 4; ++m)
#pragma unroll
                    for (int n = 0; n < 2; ++n) acc[a][b][m][n] = (f32x4){0.f, 0.f, 0.f, 0.f};
        cur = nxt; cA = nA; cB = nB; ++ui;
        if constexpr (ALIGN_EPI) { if (wr == 1) PG8_BAR; }
    }
    PG8_WAIT_V(0);
    if constexpr (!ALIGN_EPI) { if (wr == 0) PG8_BAR; }
    PG8_BAR;
    if constexpr (Epi::AFTER_DRAIN) { E.fused(acc, cur, wr, wc, fr, fq, lds, wid, lane); S.done(cur); }
#undef PG8_SA
#undef PG8_SB
#undef PG8_STAGE
#undef PG8_LDA
#undef PG8_LDB
#undef PG8_MMA
#undef PG8_WAIT_V
#undef PG8_WAIT_L
#undef PG8_BAR
#undef PG8_SCHED
}
}
#ifndef PG8_SP2
#define PG8_SP2 true
#endif
#ifndef PG8_ALIGN
#define PG8_ALIGN true
#endif
#ifndef MK_ONE_LAUNCH
#define MK_ONE_LAUNCH 0
#endif

constexpr int D = 2048, S = 8192, C = 256, R = S + C, DEPTH = 4, HD = 128;
constexpr int AW = 3072, HW = 6144, FF = 8192, NMODW = 6 * D;
constexpr float EPS = 1e-6f;
constexpr float QSCALE = 0.08838834764831845f;
constexpr float MIN_DECAY = -3.0701134573253944f, MAX_DECAY = -15.350567286626973f;
constexpr int NWAVES = 8, NTHREADS = 512;

constexpr size_t MiB = 1u << 20;
constexpr size_t WS_CTL = 0, CTL_ZERO_BYTES = 1 * MiB;
constexpr size_t WS_WAIN = 1 * MiB;
constexpr size_t WS_WAOUT = WS_WAIN + 24 * MiB;
constexpr size_t WS_WHIN = WS_WAOUT + 16 * MiB;
constexpr size_t WS_WHOUT = WS_WHIN + 48 * MiB;
constexpr size_t WS_WM1 = WS_WHOUT + 16 * MiB;
constexpr size_t WS_WM2 = WS_WM1 + 128 * MiB;
constexpr size_t WS_X = WS_WM2 + 128 * MiB;
constexpr size_t WS_H = WS_X + 66 * MiB;
constexpr size_t WS_QKV = WS_H + 33 * MiB;
constexpr size_t WS_KP = WS_QKV + 50 * MiB;
constexpr size_t WS_VP = WS_KP + 9 * MiB;
constexpr size_t WS_O = WS_VP + 9 * MiB;
constexpr size_t WS_U = WS_O + 33 * MiB;
constexpr size_t WS_UP = WS_U + 132 * MiB;
constexpr size_t WS_XV = WS_UP + 99 * MiB;
constexpr size_t WS_ZC = WS_XV + 99 * MiB;
constexpr size_t WS_FILT = WS_ZC + 33 * MiB;
constexpr size_t WS_FILTC = WS_FILT + 256 * MiB;
constexpr size_t WS_HID = WS_FILTC + 4 * MiB;
constexpr size_t WS_MISC = WS_HID + 5 * MiB;
constexpr size_t WS_END = WS_MISC + 2 * MiB;
constexpr int MO_MOD = 0, MO_MODC = MO_MOD + 4 * NMODW, MO_RCOS = MO_MODC + 4 * NMODW, MO_RSIN = MO_RCOS + 128 * 32, MO_FPART = MO_RSIN + 128 * 32, MO_FPARTC = MO_FPART + 2 * 4096 * 16, MO_END = MO_FPARTC + 4096;
static_assert((size_t)MO_END * 4 <= 2 * MiB, "misc");
constexpr int CW_BAR = 4096;

constexpr int LDS_BYTES = 147456;
constexpr int MISC_OFF = LDS_BYTES - 256;

#define GAS __attribute__((address_space(1)))
#define LAS __attribute__((address_space(3)))
typedef unsigned short bf16;
typedef unsigned v4u __attribute__((ext_vector_type(4)));
typedef unsigned v2u __attribute__((ext_vector_type(2)));
typedef float f32x4 __attribute__((ext_vector_type(4)));
#define LDS_WAIT() asm volatile("s_waitcnt lgkmcnt(0)" ::: "memory")
__device__ __forceinline__ unsigned f2bf(float f) { unsigned u = __builtin_bit_cast(unsigned, f); return (u + 0x7fffu + ((u >> 16) & 1u)) >> 16; }
__device__ __forceinline__ unsigned pk2(float lo, float hi) { return f2bf(lo) | (f2bf(hi) << 16); }
__device__ __forceinline__ float bf2f(unsigned b) { return __builtin_bit_cast(float, b << 16); }
__device__ __forceinline__ float wave_sum(float v) {
#pragma unroll
    for (int o = 1; o < 64; o <<= 1) v += __shfl_xor(v, o);
    return v;
}
__device__ __forceinline__ float wave_max(float v) {
#pragma unroll
    for (int o = 1; o < 64; o <<= 1) v = fmaxf(v, __shfl_xor(v, o));
    return v;
}
#define XB_SPIN_CAP_OVERRIDE 1
#define XB_TMO      128
#define XB_XCNT(j)  (256  + 64 * (j))
#define XB_XSUB(j)  (1280 + 64 * (j))
#define XB_XGEN(j)  (2304 + 64 * (j))
#define XB_TOP      3328
#define XB_TOPGEN   3392
#define XCD_BAR_WORDS 3456
#define XB_SPIN_CAP (1u << 22)

__device__ __forceinline__ unsigned xb_ld(unsigned* p)              { return __hip_atomic_load(p, __ATOMIC_RELAXED, __HIP_MEMORY_SCOPE_AGENT); }
__device__ __forceinline__ unsigned xb_add(unsigned* p, unsigned v) { return __hip_atomic_fetch_add(p, v, __ATOMIC_RELAXED, __HIP_MEMORY_SCOPE_AGENT); }
__device__ __forceinline__ unsigned xb_xcc_id() { return (unsigned)__builtin_amdgcn_s_getreg((3 << 11) | 20) & 0xFu; }
#define XB_SPIN(cond, bar) do { unsigned _sp = 0; while (cond) { __builtin_amdgcn_s_sleep(1); \
    if ((++_sp & 255u) == 0u) { if (xb_ld(&(bar)[XB_TMO])) break; if (_sp > XB_SPIN_CAP) { atomicAdd(&(bar)[XB_TMO], 1u); break; } } } } while (0)

struct XcdBarrier {
    unsigned* bar; unsigned x;
    volatile LAS unsigned* st;
};

__device__ __forceinline__ XcdBarrier xcd_barrier_post(unsigned* bar, volatile LAS unsigned* st) {
    XcdBarrier b; b.bar = bar; b.x = xb_xcc_id(); b.st = st;
    if (threadIdx.x == 0) (void)xb_add(&bar[XB_XCNT(b.x)], 1u);
    return b;
}
__device__ __forceinline__ void xcd_barrier_complete(unsigned* bar, unsigned x, unsigned& nloc, unsigned& nx) {
    const unsigned G = gridDim.x * gridDim.y * gridDim.z;
    unsigned sum, cnt, mine, sp = 0u;
    for (;;) {
        sum = 0u; cnt = 0u; mine = 0u;
#pragma unroll
        for (unsigned j = 0; j < 16; ++j) { const unsigned c = xb_ld(&bar[XB_XCNT(j)]); sum += c; cnt += (c > 0u) ? 1u : 0u; mine = (j == x) ? c : mine; }
        if (sum == G) break;
        __builtin_amdgcn_s_sleep(1);
        if ((++sp & 255u) == 0u) { if (xb_ld(&bar[XB_TMO])) break; if (sp > XB_SPIN_CAP) { atomicAdd(&bar[XB_TMO], 1u); break; } }
    }
    nloc = mine > 0u ? mine : 1u; nx = cnt > 0u ? cnt : 1u;
}

__device__ __forceinline__ void xcd_barrier(const XcdBarrier& b) {
    asm volatile("s_waitcnt vmcnt(0)" ::: "memory");
    __syncthreads();
    if (threadIdx.x == 0) {
        unsigned* bar = b.bar;
        __builtin_amdgcn_s_waitcnt(0);
        unsigned nloc = b.st[0], nx = b.st[1];
        if (nloc == 0u) { xcd_barrier_complete(bar, b.x, nloc, nx); b.st[0] = nloc; b.st[1] = nx; }
        const unsigned old = xb_add(&bar[XB_XSUB(b.x)], 1u);
        const unsigned gen = old / nloc;
        if (old + 1u == (gen + 1u) * nloc) {
            __builtin_amdgcn_fence(__ATOMIC_RELEASE, "agent");
            asm volatile("s_waitcnt vmcnt(0)" ::: "memory");
            const unsigned og = xb_add(&bar[XB_TOP], 1u);
            const unsigned tg = og / nx;
            if (og + 1u == (tg + 1u) * nx) xb_add(&bar[XB_TOPGEN], 1u);
            else XB_SPIN(xb_ld(&bar[XB_TOPGEN]) == tg, bar);
            __builtin_amdgcn_fence(__ATOMIC_ACQUIRE, "agent");
            xb_add(&bar[XB_XGEN(b.x)], 1u);
            asm volatile("s_waitcnt vmcnt(0)" ::: "memory");
        } else {
            XB_SPIN(xb_ld(&bar[XB_XGEN(b.x)]) == gen, bar);
            __builtin_amdgcn_fence(__ATOMIC_ACQUIRE, "agent");
            asm volatile("s_waitcnt vmcnt(0)" ::: "memory");
        }
    }
    __syncthreads();
}

__device__ __forceinline__ void p0_transpose_item(const float* W, int K, int N, bf16* WT, LAS float* scr, int item, int lane) {
    const int nblk = N / 32, kb = item / nblk, nb = item % nblk, k0 = 64 * kb, n0 = 32 * nb;
#pragma unroll 8
    for (int i = 0; i < 32; ++i) { const int kk = 2 * i + (lane >> 5); scr[kk * 33 + (lane & 31)] = W[(size_t)(k0 + kk) * N + n0 + (lane & 31)]; }
    LDS_WAIT();
    const int c = lane & 7;
#pragma unroll
    for (int j = 0; j < 4; ++j) { const int n = (lane >> 3) + 8 * j; const LAS float* s = scr + (8 * c) * 33 + n;
        v4u o; o.x = pk2(s[0 * 33], s[1 * 33]); o.y = pk2(s[2 * 33], s[3 * 33]); o.z = pk2(s[4 * 33], s[5 * 33]); o.w = pk2(s[6 * 33], s[7 * 33]);
        *(v4u*)(WT + (size_t)(n0 + n) * K + k0 + 8 * c) = o; }
    LDS_WAIT();
}
__device__ __forceinline__ void transpose_mat(const float* W, int K, int N, bf16* WT, LAS float* scr, int gw, int NGW, int lane) {
    const int items = (K / 64) * (N / 32);
    for (int it = gw; it < items; it += NGW) p0_transpose_item(W, K, N, WT, scr, it, lane);
}

struct Ctx {
    LAS unsigned char* lds; int tid, lane, wave, bid, G, gw, NGW;
};

__device__ __forceinline__ void phase_prologue(const Ctx& F, const float* const* in, unsigned char* ws) {
    float* misc = (float*)(ws + WS_MISC);
    LAS float* scr = (LAS float*)(F.lds + F.wave * 16384);
    for (int j = 0; j < 2; ++j) {
        transpose_mat(in[8] + (size_t)j * D * AW, D, AW, (bf16*)(ws + WS_WAIN) + (size_t)j * AW * D, scr, F.gw, F.NGW, F.lane);
        transpose_mat(in[9] + (size_t)j * D * D, D, D, (bf16*)(ws + WS_WAOUT) + (size_t)j * D * D, scr, F.gw, F.NGW, F.lane);
        transpose_mat(in[13] + (size_t)j * D * HW, D, HW, (bf16*)(ws + WS_WHIN) + (size_t)j * HW * D, scr, F.gw, F.NGW, F.lane);
        transpose_mat(in[25] + (size_t)j * D * D, D, D, (bf16*)(ws + WS_WHOUT) + (size_t)j * D * D, scr, F.gw, F.NGW, F.lane);
    }
    for (int i = 0; i < 4; ++i) {
        transpose_mat(in[27] + (size_t)i * D * FF, D, FF, (bf16*)(ws + WS_WM1) + (size_t)i * FF * D, scr, F.gw, F.NGW, F.lane);
        transpose_mat(in[28] + (size_t)i * FF * D, FF, D, (bf16*)(ws + WS_WM2) + (size_t)i * D * FF, scr, F.gw, F.NGW, F.lane);
    }
    {
        f32x4* X4 = (f32x4*)(ws + WS_X); const f32x4* x4 = (const f32x4*)in[0]; const f32x4* c4 = (const f32x4*)in[2];
        const int gt = F.bid * NTHREADS + F.tid, NGT = F.G * NTHREADS;
        for (int i = gt; i < S * D / 4; i += NGT) X4[i] = x4[i];
        for (int i = gt; i < C * D / 4; i += NGT) X4[S * D / 4 + i] = c4[i];
        for (int i = gt; i < 128 * 32; i += NGT) { const int pos = i >> 5, k = i & 31; const float inv = powf(10000.0f, -(float)(2 * k) / 64.0f); const float a = (float)pos * inv;
            misc[MO_RCOS + i] = cosf(a); misc[MO_RSIN + i] = sinf(a); }
    }
    {
        float* HID = (float*)(ws + WS_HID);
        for (int p = F.gw; p < 2 * S + C; p += F.NGW) {
            int j, i, n; if (p < 2 * S) { j = p >> 13; i = p & (S - 1); n = S; } else { j = 0; i = p - 2 * S; n = C; }
            const float tt = (float)i / (float)(n - 1);
            const float w = (6.283185307179586f * (float)i) / (float)n;
            const int k = (F.lane - 1) & 15; const float fk = 1e-4f + (float)k * ((15.0f - 1e-4f) / 15.0f);
            const float feat = F.lane == 0 ? tt : (F.lane <= 16 ? cosf(fk * w) : (F.lane <= 32 ? -sinf(fk * w) : 0.f));
            const float* w1 = in[17] + (size_t)j * 33 * 64; const float* w2 = in[20] + (size_t)j * 64 * 64;
            float a = in[18][j * 64 + F.lane];
            for (int f = 0; f < 33; ++f) a += __shfl(feat, f) * w1[f * 64 + F.lane];
            const float h1 = sinf(in[19][j * 64 + F.lane] * a);
            float b = in[21][j * 64 + F.lane];
            for (int q = 0; q < 64; ++q) b += __shfl(h1, q) * w2[q * 64 + F.lane];
            HID[(size_t)p * 64 + F.lane] = sinf(in[22][j * 64 + F.lane] * b);
        }
    }
    __syncthreads();
    {
        LAS float* s_c = (LAS float*)F.lds; LAS float* s_cc = s_c + D; LAS f32x4* red = (LAS f32x4*)(F.lds + 16384);
        for (int k = F.tid; k < D; k += NTHREADS) { const float a = in[1][k], b = in[3][k]; s_c[k] = a / (1.0f + expf(-a)); s_cc[k] = b / (1.0f + expf(-b)); }
        __syncthreads();
        for (int item = F.bid; item < 4 * 48; item += F.G) {
            const int layer = item / 48, chunk = item % 48, col4 = chunk * 64 + F.lane;
            const f32x4* Wp = (const f32x4*)(in[4] + (size_t)layer * D * NMODW) + col4;
            f32x4 a0 = {0.f, 0.f, 0.f, 0.f}, a1 = {0.f, 0.f, 0.f, 0.f};
#pragma unroll 8
            for (int k = F.wave; k < D; k += 8) { const f32x4 w = Wp[(size_t)k * (NMODW / 4)]; a0 += w * s_c[k]; a1 += w * s_cc[k]; }
            red[(F.wave * 2 + 0) * 64 + F.lane] = a0; red[(F.wave * 2 + 1) * 64 + F.lane] = a1;
            __syncthreads();
            if (F.wave < 2) { f32x4 s = {0.f, 0.f, 0.f, 0.f};
#pragma unroll
                for (int w = 0; w < 8; ++w) s += red[(w * 2 + F.wave) * 64 + F.lane];
                s += ((const f32x4*)(in[5] + (size_t)layer * NMODW))[col4];
                ((f32x4*)(misc + (F.wave ? MO_MODC : MO_MOD) + layer * NMODW))[col4] = s; }
            __syncthreads();
        }
    }
}

__device__ __forceinline__ void phase_filters(const Ctx& F, const float* const* in, unsigned char* ws) {
    float* misc = (float*)(ws + WS_MISC); const float* HID = (const float*)(ws + WS_HID);
    LAS float* red = (LAS float*)F.lds;
    for (int item = F.bid; item < 2048 + 64; item += F.G) {
        const bool isctx = item >= 2048; int j, g, it, n;
        if (!isctx) { j = item >> 10; g = (item >> 4) & 63; it = item & 15; n = S; } else { j = 0; g = item - 2048; it = 0; n = C; }
        const int i = it * 512 + F.wave * 64 + F.lane; const bool act = i < n;
        const f32x4* hp = (const f32x4*)(HID + ((size_t)(isctx ? 2 * S : j * S) + (act ? i : 0)) * 64);
        float hr[64];
#pragma unroll
        for (int k = 0; k < 16; ++k) { const f32x4 t = hp[k]; hr[4 * k] = t.x; hr[4 * k + 1] = t.y; hr[4 * k + 2] = t.z; hr[4 * k + 3] = t.w; }
        const float offs = fabsf((float)(i - n / 2)) * (2.0f / (float)n);
        float* dst = isctx ? (float*)(ws + WS_FILTC) : (float*)(ws + WS_FILT) + (size_t)j * 4096 * S;
        for (int o = 0; o < 64; ++o) {
            const int od = g * 64 + o; const float* w3p = in[23] + (size_t)j * 64 * 4096 + od;
            float a = 0.f;
#pragma unroll
            for (int k = 0; k < 64; ++k) a += hr[k] * w3p[(size_t)k * 4096];
            const int d = od & (D - 1); const float delta = fabsf(MIN_DECAY + (float)d * ((MAX_DECAY - MIN_DECAY) / (float)(D - 1)));
            const float h = a * expf(-offs * delta);
            if (act) dst[(size_t)od * n + i] = h;
            const float ss = wave_sum(act ? h * h : 0.f);
            if (F.lane == 0) red[F.wave * 64 + o] = ss;
        }
        __syncthreads();
        if (F.tid < 64) { float s = 0.f;
#pragma unroll
            for (int w = 0; w < 8; ++w) s += red[w * 64 + F.tid];
            const int od = g * 64 + F.tid;
            if (isctx) misc[MO_FPARTC + od] = s; else misc[MO_FPART + (j * 4096 + od) * 16 + it] = s; }
        __syncthreads();
    }
}

__device__ __forceinline__ void phase_norm_mod(const Ctx& F, const float* X, bf16* H, int nrows, const float* g, const float* shL, const float* scL, const float* shC, const float* scC) {
    for (int r = F.gw; r < nrows; r += F.NGW) {
        const f32x4* xr = (const f32x4*)(X + (size_t)r * D) + F.lane;
        const f32x4* sh = (const f32x4*)(r < S ? shL : shC) + F.lane; const f32x4* sc = (const f32x4*)(r < S ? scL : scC) + F.lane; const f32x4* g4 = (const f32x4*)g + F.lane;
        f32x4 v[8]; float ss = 0.f;
#pragma unroll
        for (int j = 0; j < 8; ++j) { v[j] = xr[64 * j]; ss += (v[j].x * v[j].x + v[j].y * v[j].y) + (v[j].z * v[j].z + v[j].w * v[j].w); }
        const float rstd = 1.0f / sqrtf(wave_sum(ss) * (1.0f / D) + EPS);
        v2u* o = (v2u*)(H + (size_t)r * D) + F.lane;
#pragma unroll
        for (int j = 0; j < 8; ++j) { const f32x4 y = (v[j] * rstd) * g4[64 * j]; const f32x4 z = y * (1.0f + sc[64 * j]) + sh[64 * j];
            v2u w; w.x = pk2(z.x, z.y); w.y = pk2(z.z, z.w); o[64 * j] = w; }
    }
}
__device__ __forceinline__ void phase_final_norm(const Ctx& F, const float* X, float* out, const float* g) {
    for (int r = F.gw; r < S; r += F.NGW) {
        const f32x4* xr = (const f32x4*)(X + (size_t)r * D) + F.lane; const f32x4* g4 = (const f32x4*)g + F.lane;
        f32x4 v[8]; float ss = 0.f;
#pragma unroll
        for (int j = 0; j < 8; ++j) { v[j] = xr[64 * j]; ss += (v[j].x * v[j].x + v[j].y * v[j].y) + (v[j].z * v[j].z + v[j].w * v[j].w); }
        const float rstd = 1.0f / sqrtf(wave_sum(ss) * (1.0f / D) + EPS);
        f32x4* o = (f32x4*)(out + (size_t)r * D) + F.lane;
#pragma unroll
        for (int j = 0; j < 8; ++j) o[64 * j] = (v[j] * rstd) * g4[64 * j];
    }
}

__device__ __forceinline__ void phase_kprep(const Ctx& F, const bf16* QKV, bf16* KP, bf16* VP, const float* knorm, const float* rcos, const float* rsin) {
    const int p = F.lane & 31, half = F.lane >> 5, da = half * 64 + p, db = da + 32;
    for (int r = F.gw; r < R; r += F.NGW) {
        const bool lat = r < S; const int kr = lat ? C + r : r - S;
        const int pos = half == 0 ? (r >> 6) : (r & 63);
        const float cs = lat ? rcos[pos * 32 + p] : 1.0f, sn = lat ? rsin[pos * 32 + p] : 0.0f;
#pragma unroll
        for (int h = 0; h < 4; ++h) {
            const bf16* src = QKV + (size_t)r * AW + 2048 + h * HD;
            float a = bf2f(src[da]), b = bf2f(src[db]);
            if (h >= 2) { const float ss = wave_sum(a * a + b * b); const float rstd = 1.0f / sqrtf(ss * (1.0f / HD) + EPS); a = a * rstd * knorm[da]; b = b * rstd * knorm[db]; }
            const float oa = a * cs - b * sn, ob = b * cs + a * sn;
            bf16* dst = KP + (size_t)kr * 512 + h * HD; dst[da] = (bf16)f2bf(oa); dst[db] = (bf16)f2bf(ob);
            ((unsigned*)(VP + (size_t)kr * 512 + h * HD))[F.lane] = ((const unsigned*)(QKV + (size_t)r * AW + 2560 + h * HD))[F.lane];
        }
    }
}

__device__ __forceinline__ void phase_attn_naive(const Ctx& F, const bf16* QKV, const bf16* KP, const bf16* VP, bf16* O, int nq, const float* sink, const float* qnorm, const float* rcos, const float* rsin) {
    LAS float* qs = (LAS float*)(F.lds + F.wave * 1024); LAS float* outs = qs + 128;
    const int p = F.lane & 31, half = F.lane >> 5, da = half * 64 + p, db = da + 32;
    const int ks = F.lane & 31, dh = F.lane >> 5;
    for (int it = F.gw; it < nq * 16; it += F.NGW) {
        const int r = it >> 4, h = it & 15; const bool lat = r < S;
        {
            const bf16* src = QKV + (size_t)r * AW + h * HD;
            float a = bf2f(src[da]), b = bf2f(src[db]);
            if (h >= 8) { const float ss = wave_sum(a * a + b * b); const float rstd = 1.0f / sqrtf(ss * (1.0f / HD) + EPS); a = a * rstd * qnorm[da]; b = b * rstd * qnorm[db]; }
            const int pos = half == 0 ? (r >> 6) : (r & 63);
            const float cs = lat ? rcos[pos * 32 + p] : 1.0f, sn = lat ? rsin[pos * 32 + p] : 0.0f;
            qs[da] = (a * cs - b * sn) * QSCALE; qs[db] = (b * cs + a * sn) * QSCALE;
            LDS_WAIT();
        }
        const int kvh = h < 8 ? (h >> 2) : 2 + ((h - 8) >> 2);
        int lo = 0, nl = 0;
        if (lat) { if (h < 8) { lo = r - 128 < 0 ? 0 : r - 128; const int hi = r + 128 > S - 1 ? S - 1 : r + 128; nl = hi - lo + 1; } else { lo = 0; nl = S; } }
        const int total = C + nl;
        float m = -1e30f, l = 0.f; float o[64];
#pragma unroll
        for (int d = 0; d < 64; ++d) o[d] = 0.f;
        if (h < 8 && ks == 0) { m = sink[h]; l = 1.0f; }
        const int nsteps = (total + 31) >> 5;
        for (int st = 0; st < nsteps; ++st) {
            const int kk = st * 32 + ks; const bool valid = kk < total; const int kc = valid ? kk : 0;
            const int krow = kc < C ? kc : C + lo + (kc - C);
            const v4u* kp = (const v4u*)(KP + (size_t)krow * 512 + kvh * HD + dh * 64); const v4u* vp = (const v4u*)(VP + (size_t)krow * 512 + kvh * HD + dh * 64);
            float s = 0.f;
#pragma unroll
            for (int c = 0; c < 8; ++c) { const v4u kv = kp[c]; const LAS f32x4* q4 = (const LAS f32x4*)(qs + dh * 64) + 2 * c; const f32x4 qa = q4[0], qb = q4[1];
                s += bf2f(kv.x & 0xffffu) * qa.x + bf2f(kv.x >> 16) * qa.y + bf2f(kv.y & 0xffffu) * qa.z + bf2f(kv.y >> 16) * qa.w
                   + bf2f(kv.z & 0xffffu) * qb.x + bf2f(kv.z >> 16) * qb.y + bf2f(kv.w & 0xffffu) * qb.z + bf2f(kv.w >> 16) * qb.w; }
            s += __shfl_xor(s, 32);
            if (valid) {
                const float mn = fmaxf(m, s), al = expf(m - mn), pp = expf(s - mn); l = l * al + pp; m = mn;
#pragma unroll
                for (int c = 0; c < 8; ++c) { const v4u vv = vp[c];
                    o[8 * c + 0] = o[8 * c + 0] * al + pp * bf2f(vv.x & 0xffffu); o[8 * c + 1] = o[8 * c + 1] * al + pp * bf2f(vv.x >> 16);
                    o[8 * c + 2] = o[8 * c + 2] * al + pp * bf2f(vv.y & 0xffffu); o[8 * c + 3] = o[8 * c + 3] * al + pp * bf2f(vv.y >> 16);
                    o[8 * c + 4] = o[8 * c + 4] * al + pp * bf2f(vv.z & 0xffffu); o[8 * c + 5] = o[8 * c + 5] * al + pp * bf2f(vv.z >> 16);
                    o[8 * c + 6] = o[8 * c + 6] * al + pp * bf2f(vv.w & 0xffffu); o[8 * c + 7] = o[8 * c + 7] * al + pp * bf2f(vv.w >> 16); }
            }
        }
        const float M = wave_max(m), f = expf(m - M); const float L = 0.5f * wave_sum(l * f); const float rl = 1.0f / L;
#pragma unroll
        for (int d = 0; d < 64; ++d) { float sd = o[d] * f;
            sd += __shfl_xor(sd, 1); sd += __shfl_xor(sd, 2); sd += __shfl_xor(sd, 4); sd += __shfl_xor(sd, 8); sd += __shfl_xor(sd, 16);
            if (ks == 0) outs[dh * 64 + d] = sd * rl; }
        LDS_WAIT();
        ((unsigned*)(O + (size_t)r * D + h * HD))[F.lane] = pk2(outs[2 * F.lane], outs[2 * F.lane + 1]);
        LDS_WAIT();
    }
}

__device__ __forceinline__ void phase_shortconv(const Ctx& F, const bf16* UP, bf16* XV, const float* cw, const float* cb, int nrows) {
    LAS float* scr = (LAS float*)(F.lds + F.wave * 16896);
    const int ntb = nrows / 64;
    for (int it = F.gw; it < ntb * 96; it += F.NGW) {
        const int tb = it / 96, cbk = it % 96, r0 = tb * 64, c0 = cbk * 64;
        const int slo = tb < 128 ? 0 : S, shi = tb < 128 ? S : R;
        const int c = c0 + F.lane; const float w0 = cw[c], w1 = cw[HW + c], w2 = cw[2 * HW + c], bb = cb[c];
        float prev = (r0 - 1 >= slo) ? bf2f(UP[(size_t)(r0 - 1) * HW + c]) : 0.f; float cur = bf2f(UP[(size_t)r0 * HW + c]);
        for (int t = 0; t < 64; ++t) { const int r = r0 + t; const float nxt = (r + 1 < shi) ? bf2f(UP[(size_t)(r + 1) * HW + c]) : 0.f;
            scr[F.lane * 65 + t] = w0 * prev + w1 * cur + w2 * nxt + bb; prev = cur; cur = nxt; }
        LDS_WAIT();
        for (int cc = 0; cc < 64; ++cc) XV[(size_t)(c0 + cc) * R + r0 + F.lane] = (bf16)f2bf(scr[cc * 65 + F.lane]);
        LDS_WAIT();
    }
}

__device__ __forceinline__ void conv_naive(const LAS float* zs, const LAS float* Ts, int n, int tid, float (&acc)[16]) {
#pragma unroll
    for (int q = 0; q < 16; ++q) acc[q] = 0.f;
    const int half = n >> 1;
    for (int s = 0; s < n; ++s) { const float zv = zs[s];
#pragma unroll
        for (int q = 0; q < 16; ++q) { const int t = tid + 512 * q; const int idx = t - s + half; const bool ok = ((unsigned)idx < (unsigned)n) && (t < n);
            const float tv = Ts[ok ? idx : 0]; acc[q] += ok ? zv * tv : 0.f; } }
}
__device__ __forceinline__ void phase_longconv_naive(const Ctx& F, const bf16* XV, bf16* ZC, const float* FILT, const float* FILTC, const float* fpart, const float* fpartc, const float* skip, bool with_ctx) {
    LAS float* zs = (LAS float*)F.lds; LAS float* Ts = zs + S; LAS float* z2 = Ts + S;
    const int nitems = with_ctx ? 2 * D : D;
    for (int it = F.bid; it < nitems; it += F.G) {
        const bool isctx = it >= D; const int c = isctx ? it - D : it, n = isctx ? C : S, base = isctx ? S : 0;
        const bf16* vsrc = XV + (size_t)(2 * D + c) * R + base; const bf16* x1 = XV + (size_t)c * R + base; const bf16* x2 = XV + (size_t)(D + c) * R + base;
        float s0, s1;
        if (isctx) { s0 = 1.0f / sqrtf(fpartc[c] + EPS); s1 = 1.0f / sqrtf(fpartc[D + c] + EPS); }
        else { float a = 0.f, b = 0.f; for (int k = 0; k < 16; ++k) { a += fpart[c * 16 + k]; b += fpart[(D + c) * 16 + k]; } s0 = 1.0f / sqrtf(a + EPS); s1 = 1.0f / sqrtf(b + EPS); }
        const float* T0 = isctx ? FILTC + (size_t)c * C : FILT + (size_t)c * S; const float* T1 = isctx ? FILTC + (size_t)(D + c) * C : FILT + (size_t)(D + c) * S;
        for (int t = F.tid; t < n; t += NTHREADS) { zs[t] = bf2f(vsrc[t]); Ts[t] = T0[t]; }
        __syncthreads();
        float acc[16];
        conv_naive(zs, Ts, n, F.tid, acc);
        const float sk0 = skip[c], sk1 = skip[D + c];
#pragma unroll
        for (int q = 0; q < 16; ++q) { const int t = F.tid + 512 * q; if (t < n) z2[t] = bf2f(x1[t]) * (s0 * acc[q] + zs[t] * sk0); }
        __syncthreads();
        for (int t = F.tid; t < n; t += NTHREADS) Ts[t] = T1[t];
        __syncthreads();
        conv_naive(z2, Ts, n, F.tid, acc);
#pragma unroll
        for (int q = 0; q < 16; ++q) { const int t = F.tid + 512 * q; if (t < n) ZC[(size_t)c * R + base + t] = (bf16)f2bf(bf2f(x2[t]) * (s1 * acc[q] + z2[t] * sk1)); }
        __syncthreads();
    }
}
__device__ __forceinline__ void phase_transpose_zc(const Ctx& F, const bf16* ZC, bf16* O, int nrows) {
    LAS float* scr = (LAS float*)(F.lds + F.wave * 16896);
    const int ntb = nrows / 64;
    for (int it = F.gw; it < ntb * 32; it += F.NGW) {
        const int tb = it / 32, cbk = it % 32, r0 = tb * 64, c0 = cbk * 64;
        for (int cc = 0; cc < 64; ++cc) scr[cc * 65 + F.lane] = bf2f(ZC[(size_t)(c0 + cc) * R + r0 + F.lane]);
        LDS_WAIT();
        for (int t = 0; t < 64; ++t) O[(size_t)(r0 + t) * D + c0 + F.lane] = (bf16)f2bf(scr[F.lane * 65 + t]);
        LDS_WAIT();
    }
}
struct Args { const float* in[30]; float* out; unsigned char* ws; int ph_lo, ph_hi; };
constexpr int N_PHASES = 2 + 4 * 9 + 1;

__global__ void __launch_bounds__(NTHREADS, 2) fwd(Args args) {
    extern __shared__ __attribute__((aligned(16))) unsigned char lds_raw[];
    Ctx F;
    F.lds = (LAS unsigned char*)lds_raw;
    F.tid = threadIdx.x; F.lane = F.tid & 63; F.wave = __builtin_amdgcn_readfirstlane(F.tid >> 6);
    F.bid = blockIdx.x; F.G = gridDim.x; F.gw = F.bid * NWAVES + F.wave; F.NGW = F.G * NWAVES;
    unsigned char* ws = args.ws;
    volatile LAS unsigned* MISC = (volatile LAS unsigned*)(F.lds + MISC_OFF);
    if (F.tid < 32) MISC[F.tid] = 0u;
    __syncthreads();
    XcdBarrier bar; bar.bar = (unsigned*)(ws + WS_CTL) + CW_BAR; bar.x = 0; bar.st = nullptr;
#if MK_ONE_LAUNCH
    bar = xcd_barrier_post((unsigned*)(ws + WS_CTL) + CW_BAR, MISC + 8);
#endif
    const int lo = args.ph_lo, hi = args.ph_hi;
    int ph = 0;
#define PH_BEGIN if (ph >= lo && ph < hi) { int tid_ = threadIdx.x; asm volatile("" : "+v"(tid_)); F.tid = tid_; F.lane = tid_ & 63;
#if MK_ONE_LAUNCH
#define PH_END if (ph + 1 < hi) xcd_barrier(bar); } ++ph;
#else
#define PH_END } ++ph;
#endif
    const float* const* in = args.in;
    float* misc = (float*)(ws + WS_MISC);
    float* X = (float*)(ws + WS_X); bf16* H = (bf16*)(ws + WS_H); bf16* QKV = (bf16*)(ws + WS_QKV); bf16* KP = (bf16*)(ws + WS_KP); bf16* VP = (bf16*)(ws + WS_VP);
    bf16* O = (bf16*)(ws + WS_O); bf16* U = (bf16*)(ws + WS_U); bf16* UP = (bf16*)(ws + WS_UP); bf16* XV = (bf16*)(ws + WS_XV); bf16* ZC = (bf16*)(ws + WS_ZC);
    const float* rcos = misc + MO_RCOS; const float* rsin = misc + MO_RSIN;

    PH_BEGIN phase_prologue(F, in, ws); PH_END
    PH_BEGIN phase_filters(F, in, ws); PH_END

    for (int i = 0; i < DEPTH; ++i) {
        const int j = i >> 1; const bool is_attn = (i & 1) == 0, ctx_upd = i < 2, has_ctx = is_attn || ctx_upd;
        const int nrows1 = has_ctx ? R : S, nrows2 = ctx_upd ? R : S;
        const float* mod = misc + MO_MOD + i * NMODW; const float* modc = misc + MO_MODC + i * NMODW;
        PH_BEGIN phase_norm_mod(F, X, H, nrows1, in[6] + i * D, mod, mod + D, modc, modc + D); PH_END
        PH_BEGIN { const int N = is_attn ? AW : HW;
            pg8::Gemm g{H, is_attn ? (const bf16*)(ws + WS_WAIN) + (size_t)j * AW * D : (const bf16*)(ws + WS_WHIN) + (size_t)j * HW * D, nrows1, N, D};
            pg8::StaticOrder So; So.init(nrows1, N, F.G, F.bid);
            pg8::EpiBf16<0> E{is_attn ? QKV : UP, N, is_attn ? nullptr : in[14] + j * HW};
            pg8::gemm_phase<pg8::EpiBf16<0>, pg8::StaticOrder, PG8_ALIGN, PG8_SP2>(F.lds, g, So, E, F.tid); } PH_END
        if (is_attn) {
            PH_BEGIN phase_kprep(F, QKV, KP, VP, in[12] + j * HD, rcos, rsin); PH_END
            PH_BEGIN phase_attn_naive(F, QKV, KP, VP, O, nrows2, in[10] + j * 8, in[11] + j * HD, rcos, rsin); PH_END
            ++ph;
        } else {
            PH_BEGIN phase_shortconv(F, UP, XV, in[15] + (size_t)j * 3 * HW, in[16] + j * HW, nrows2); PH_END
            PH_BEGIN phase_longconv_naive(F, XV, ZC, (const float*)(ws + WS_FILT) + (size_t)j * 4096 * S, (const float*)(ws + WS_FILTC), misc + MO_FPART + j * 4096 * 16, misc + MO_FPARTC, in[24] + j * 2 * D, ctx_upd); PH_END
            PH_BEGIN phase_transpose_zc(F, ZC, O, nrows2); PH_END
        }
        PH_BEGIN { pg8::Gemm g{O, is_attn ? (const bf16*)(ws + WS_WAOUT) + (size_t)j * D * D : (const bf16*)(ws + WS_WHOUT) + (size_t)j * D * D, nrows2, D, D};
            pg8::StaticOrder So; So.init(nrows2, D, F.G, F.bid);
            pg8::EpiResGate E{X, D, is_attn ? nullptr : in[26] + j * D, mod + 2 * D, modc + 2 * D, S / 256};
            pg8::gemm_phase<pg8::EpiResGate, pg8::StaticOrder, PG8_ALIGN, PG8_SP2>(F.lds, g, So, E, F.tid); } PH_END
        PH_BEGIN phase_norm_mod(F, X, H, nrows2, in[7] + i * D, mod + 3 * D, mod + 4 * D, modc + 3 * D, modc + 4 * D); PH_END
        PH_BEGIN { pg8::Gemm g{H, (const bf16*)(ws + WS_WM1) + (size_t)i * FF * D, nrows2, FF, D}; pg8::StaticOrder So; So.init(nrows2, FF, F.G, F.bid);
            pg8::EpiBf16<1> E{U, FF, nullptr};
            pg8::gemm_phase<pg8::EpiBf16<1>, pg8::StaticOrder, PG8_ALIGN, PG8_SP2>(F.lds, g, So, E, F.tid); } PH_END
        PH_BEGIN { pg8::Gemm g{U, (const bf16*)(ws + WS_WM2) + (size_t)i * D * FF, nrows2, D, FF}; pg8::StaticOrder So; So.init(nrows2, D, F.G, F.bid);
            pg8::EpiResGate E{X, D, nullptr, mod + 5 * D, modc + 5 * D, S / 256};
            pg8::gemm_phase<pg8::EpiResGate, pg8::StaticOrder, PG8_ALIGN, PG8_SP2>(F.lds, g, So, E, F.tid); } PH_END
    }
    PH_BEGIN phase_final_norm(F, X, args.out, in[29]); PH_END
#undef PH_BEGIN
#undef PH_END
}

extern "C" void kernel_launch(void* const* d_in, const int* in_sizes, int n_in, void* d_out, int out_size, void* d_ws, size_t ws_size, hipStream_t stream) {
    static int grid = 0;
    if (grid == 0) {
        if (n_in != 30 || out_size != S * D || ws_size < WS_END) { fprintf(stderr, "kernel_launch: unexpected shapes: n_in %d out %d ws %zu (need %zu)\n", n_in, out_size, ws_size, (size_t)WS_END); grid = -1; return; }
        int dev = 0, cus = 0, per_cu = 0;
        if (hipGetDevice(&dev) != hipSuccess || hipDeviceGetAttribute(&cus, hipDeviceAttributeMultiprocessorCount, dev) != hipSuccess) { grid = -1; return; }
        if (hipFuncSetAttribute((const void*)fwd, hipFuncAttributeMaxDynamicSharedMemorySize, LDS_BYTES) != hipSuccess) { fprintf(stderr, "kernel_launch: hipFuncSetAttribute failed\n"); grid = -1; return; }
        if (hipOccupancyMaxActiveBlocksPerMultiprocessor(&per_cu, (const void*)fwd, NTHREADS, LDS_BYTES) != hipSuccess || per_cu < 1)
            fprintf(stderr, "kernel_launch: occupancy query reports %d workgroups per CU\n", per_cu);
        (void)hipGetLastError();
        grid = cus;
    }
    if (grid < 0) return;
    (void)hipMemsetAsync((char*)d_ws + WS_CTL, 0, CTL_ZERO_BYTES, stream);
    Args a{};
    for (int i = 0; i < 30; ++i) a.in[i] = (const float*)d_in[i];
    a.out = (float*)d_out; a.ws = (unsigned char*)d_ws;
#if MK_ONE_LAUNCH
    a.ph_lo = 0; a.ph_hi = N_PHASES;
    hipLaunchKernelGGL(fwd, dim3(grid), dim3(NTHREADS), LDS_BYTES, stream, a);
#else
    for (int p = 0; p < N_PHASES; ++p) { a.ph_lo = p; a.ph_hi = p + 1; hipLaunchKernelGGL(fwd, dim3(grid), dim3(NTHREADS), LDS_BYTES, stream, a); }
#endif
    const hipError_t le = hipPeekAtLastError();
    if (le != hipSuccess) fprintf(stderr, "kernel_launch: launch failed: %s\n", hipGetErrorName(le));
}
```

```cpp
#include <hip/hip_runtime.h>
#include <cstdio>
#include <cstdint>
#define MK_ONE_LAUNCH 1
namespace pg8 {
#define PG8_LAS __attribute__((address_space(3)))
typedef unsigned short bf16_t;
typedef short bf16x8 __attribute__((ext_vector_type(8)));
typedef float f32x4 __attribute__((ext_vector_type(4)));
typedef unsigned u32x4 __attribute__((ext_vector_type(4)));
constexpr int BM = 256, BK = 64, HALF = 128, HTB = HALF * BK * 2  , STAGE_BYTES = 8 * HTB, NXCD = 8, WGM = 8;

__host__ __device__ __forceinline__ int lds_byte(int r, int c) { const int st = (r >> 4) * 2 + (c >> 5), rr = r & 15, cc = c & 31, ob = rr * 64 + cc * 2; return st * 1024 + (ob ^ (((ob >> 9) & 1) << 5)); }
__host__ __device__ __forceinline__ void stage_rc(int b, int& R, int& C) { const int st = b / 1024, sb = b % 1024, swz = sb ^ (((sb >> 9) & 1) << 5); R = (st >> 1) * 16 + swz / 64; C = (st & 1) * 32 + (swz % 64) / 2; }
__host__ __device__ __forceinline__ int perm32(int rho) { const int n = rho >> 4, i = rho & 15; return 8 * (i >> 2) + 4 * n + (i & 3); }

struct Unit { int pm, pn; };
struct Gemm { const bf16_t* A; const bf16_t* Bt; int M, N, K; };

struct StaticOrder {
    int nM, nN, nwg, G, c;
    __host__ __device__ void init(int M, int N, int G_, int c_) { nM = M / BM; nN = N / BM; nwg = nM * nN; G = G_; c = c_; }
    __host__ __device__ bool next(int i, Unit& u) const {
        const long L = (long)i * G + c; if (L >= nwg) return false;
        int wgid = (int)L; { const int q = nwg / NXCD, r = nwg % NXCD, xcd = wgid % NXCD, off = wgid / NXCD; wgid = (xcd < r ? xcd * (q + 1) : r * (q + 1) + (xcd - r) * q) + off; }
        const int nig = WGM * nN, gid = wgid / nig, fm = gid * WGM, gsz = (nM - fm) < WGM ? (nM - fm) : WGM;
        u.pm = fm + ((wgid % nig) % gsz); u.pn = (wgid % nig) / gsz; return true;
    }
    __device__ __forceinline__ void a_ready(const Unit&) const {}
    __device__ __forceinline__ void done(const Unit&) const {}
};

__device__ __forceinline__ unsigned cvt_pk_bf16(float lo, float hi) { unsigned r; asm volatile("v_cvt_pk_bf16_f32 %0, %1, %2" : "=v"(r) : "v"(lo), "v"(hi)); return r; }

template <int ACT> struct EpiBf16 {
    static constexpr bool PERM = true, AFTER_DRAIN = false;
    bf16_t* O; int ldc; const float* bias;
    __device__ __forceinline__ void operator()(const f32x4 (&acc)[2][2][4][2], const Unit& u, int wr, int wc, int fr, int fq) const {
        const int row0 = u.pm * BM + wr * 64 + fr; const int col0 = u.pn * BM + wc * 32 + 8 * fq;
        f32x4 bv[2][2];
#pragma unroll
        for (int bj = 0; bj < 2; ++bj)
#pragma unroll
            for (int n = 0; n < 2; ++n) bv[bj][n] = bias ? *(const f32x4*)(bias + col0 + bj * HALF + 4 * n) : (f32x4){0.f, 0.f, 0.f, 0.f};
#pragma unroll
        for (int ai = 0; ai < 2; ++ai)
#pragma unroll
            for (int m = 0; m < 4; ++m) { bf16_t* rowp = O + (size_t)(row0 + ai * HALF + m * 16) * ldc + col0;
#pragma unroll
                for (int bj = 0; bj < 2; ++bj) { f32x4 v0 = acc[ai][bj][m][0] + bv[bj][0], v1 = acc[ai][bj][m][1] + bv[bj][1];
                    if (ACT == 1) {
#pragma unroll
                        for (int j = 0; j < 4; ++j) { const float a = fmaxf(v0[j], 0.f), b = fmaxf(v1[j], 0.f); v0[j] = a * a; v1[j] = b * b; } }
                    u32x4 w; w.x = cvt_pk_bf16(v0[0], v0[1]); w.y = cvt_pk_bf16(v0[2], v0[3]); w.z = cvt_pk_bf16(v1[0], v1[1]); w.w = cvt_pk_bf16(v1[2], v1[3]);
                    *(u32x4*)(rowp + bj * HALF) = w; } }
    }
};
struct EpiResGate {
    static constexpr bool PERM = false, AFTER_DRAIN = false;
    float* X; int ldc; const float* bias; const float* gate_lat; const float* gate_ctx; int ctx_pm;
    __device__ __forceinline__ void operator()(const f32x4 (&acc)[2][2][4][2], const Unit& u, int wr, int wc, int fr, int fq) const {
        const int row0 = u.pm * BM + wr * 64 + fr, col0 = u.pn * BM + wc * 32 + 4 * fq;
        const float* gate = (u.pm >= ctx_pm) ? gate_ctx : gate_lat;
        f32x4 bv[2][2], gv[2][2];
#pragma unroll
        for (int bj = 0; bj < 2; ++bj)
#pragma unroll
            for (int n = 0; n < 2; ++n) { bv[bj][n] = bias ? *(const f32x4*)(bias + col0 + bj * HALF + n * 16) : (f32x4){0.f, 0.f, 0.f, 0.f};
                gv[bj][n] = *(const f32x4*)(gate + col0 + bj * HALF + n * 16); }
#pragma unroll
        for (int ai = 0; ai < 2; ++ai)
#pragma unroll
            for (int m = 0; m < 4; ++m) { float* rowp = X + (size_t)(row0 + ai * HALF + m * 16) * ldc + col0;
#pragma unroll
                for (int bj = 0; bj < 2; ++bj)
#pragma unroll
                    for (int n = 0; n < 2; ++n) { f32x4* p = (f32x4*)(rowp + bj * HALF + n * 16); const f32x4 old = *p; *p = old + gv[bj][n] * (acc[ai][bj][m][n] + bv[bj][n]); } }
    }
};

template <class Epi, class Sched, bool ALIGN_EPI = false, bool SP2 = false>
__device__ __forceinline__ void gemm_phase(PG8_LAS unsigned char* lds, const Gemm g, const Sched& S, const Epi& E, const int tid) {
    const int wid = __builtin_amdgcn_readfirstlane(tid >> 6), lane = tid & 63, wr = wid >> 2, wc = wid & 3, fr = lane & 15, fq = lane >> 4;
    const int K = g.K, nt = K / BK;
    unsigned voffA[2], voffB[2];
#pragma unroll
    for (int i = 0; i < 2; ++i) { int R, C; stage_rc(tid * 16 + i * 8192, R, C); const int Rb = Epi::PERM ? ((R & ~31) + perm32(R & 31)) : R;
        voffA[i] = (unsigned)(R * K + C) * 2u; voffB[i] = (unsigned)(Rb * K + C) * 2u; }
    const size_t kstep = (size_t)(BK * 2);
    const size_t hstep = (size_t)HALF * K * 2;
    const size_t tstep = 2 * hstep;
    const unsigned ldsw = (unsigned)wid * 1024u;
    const int aoff = lds_byte(wr * 64 + fr, fq * 8), boff = lds_byte(wc * 32 + fr, fq * 8);
#define PG8_SA(b, h) (((b) * 2 + (h)) * HTB)
#define PG8_SB(b, h) ((4 + (b) * 2 + (h)) * HTB)
#define PG8_STAGE(bufoff, gbase, voff) do { _Pragma("unroll") for (int _i = 0; _i < 2; ++_i) \
        __builtin_amdgcn_global_load_lds((const unsigned*)((const char*)(gbase) + (voff)[_i]), (PG8_LAS unsigned*)(lds + (bufoff) + ldsw + _i * 8192), 16, 0, 0); } while (0)
#define PG8_LDA(dst, b, h) do { _Pragma("unroll") for (int m = 0; m < 4; ++m) _Pragma("unroll") for (int k = 0; k < 2; ++k) dst[m][k] = *(const PG8_LAS bf16x8*)(lds + PG8_SA(b, h) + aoff + m * 2048 + k * 1024); } while (0)
#define PG8_LDB(dst, b, h) do { _Pragma("unroll") for (int n = 0; n < 2; ++n) _Pragma("unroll") for (int k = 0; k < 2; ++k) dst[n][k] = *(const PG8_LAS bf16x8*)(lds + PG8_SB(b, h) + boff + n * 2048 + k * 1024); } while (0)
#define PG8_MMA(ai, bj, At, Bt) do { __builtin_amdgcn_s_setprio(1); _Pragma("unroll") for (int m = 0; m < 4; ++m) _Pragma("unroll") for (int n = 0; n < 2; ++n) _Pragma("unroll") for (int k = 0; k < 2; ++k) \
        acc[ai][bj][m][n] = __builtin_amdgcn_mfma_f32_16x16x32_bf16(Bt[n][k], At[m][k], acc[ai][bj][m][n], 0, 0, 0); __builtin_amdgcn_s_setprio(0); } while (0)
#define PG8_WAIT_V(n) asm volatile("s_waitcnt vmcnt(" #n ")" ::: "memory")
#define PG8_WAIT_L(n) asm volatile("s_waitcnt lgkmcnt(" #n ")" ::: "memory")
#define PG8_BAR __builtin_amdgcn_s_barrier()
#define PG8_SCHED __builtin_amdgcn_sched_barrier(0)
    Unit cur, nxt; int ui = 0;
    if (!S.next(0, cur)) return;
    f32x4 acc[2][2][4][2];
#pragma unroll
    for (int a = 0; a < 2; ++a)
#pragma unroll
        for (int b = 0; b < 2; ++b)
#pragma unroll
            for (int m = 0; m < 4; ++m)
#pragma unroll
                for (int n = 0; n < 2; ++n) acc[a][b][m][n] = (f32x4){0.f, 0.f, 0.f, 0.f};
    bf16x8 At[4][2], B0[2][2], B1[2][2];
    const char* cA = (const char*)g.A + (size_t)cur.pm * tstep; const char* cB = (const char*)g.Bt + (size_t)cur.pn * tstep;
    S.a_ready(cur);
    if constexpr (SP2) {
        PG8_STAGE(PG8_SB(0, 0), cB, voffB); PG8_STAGE(PG8_SB(0, 1), cB + hstep, voffB); PG8_STAGE(PG8_SA(0, 0), cA, voffA); PG8_STAGE(PG8_SA(0, 1), cA + hstep, voffA);
        if (wr == 1) PG8_BAR;
        PG8_WAIT_V(2); PG8_BAR;
        PG8_STAGE(PG8_SB(1, 0), cB + kstep, voffB); PG8_STAGE(PG8_SA(1, 0), cA + kstep, voffA); PG8_STAGE(PG8_SB(1, 1), cB + hstep + kstep, voffB);
        PG8_WAIT_V(6); PG8_BAR;
    } else {
        PG8_STAGE(PG8_SB(0, 0), cB, voffB); PG8_STAGE(PG8_SA(0, 0), cA, voffA); PG8_STAGE(PG8_SB(0, 1), cB + hstep, voffB); PG8_STAGE(PG8_SA(0, 1), cA + hstep, voffA);
        if (wr == 1) PG8_BAR;
        PG8_WAIT_V(4); PG8_BAR;
        PG8_STAGE(PG8_SB(1, 0), cB + kstep, voffB); PG8_STAGE(PG8_SA(1, 0), cA + kstep, voffA); PG8_STAGE(PG8_SB(1, 1), cB + hstep + kstep, voffB);
        PG8_WAIT_V(6); PG8_BAR;
    }
    for (;;) {
        const bool has_next = S.next(ui + 1, nxt);
        const char* nA = has_next ? (const char*)g.A + (size_t)nxt.pm * tstep : cA; const char* nB = has_next ? (const char*)g.Bt + (size_t)nxt.pn * tstep : cB;
        for (int t = 0; t < nt; t += 2) {
            const bool last = (t == nt - 2);
            const char* a1 = cA + (size_t)(t + 1) * kstep;
            const char* a2 = last ? nA : cA + (size_t)(t + 2) * kstep; const char* b2 = last ? nB : cB + (size_t)(t + 2) * kstep;
            const char* a3 = a2 + kstep; const char* b3 = b2 + kstep;
            if (last && has_next) S.a_ready(nxt);
            if constexpr (SP2) {
            PG8_LDB(B0, 0, 0); PG8_LDB(B1, 0, 1); PG8_SCHED; PG8_LDA(At, 0, 0); PG8_STAGE(PG8_SA(1, 1), a1 + hstep, voffA);
            PG8_WAIT_V(8); PG8_WAIT_L(0); PG8_BAR; PG8_MMA(0, 0, At, B0); PG8_MMA(0, 1, At, B1); PG8_BAR; PG8_SCHED;
            PG8_LDA(At, 0, 1); PG8_STAGE(PG8_SB(0, 0), b2, voffB); PG8_STAGE(PG8_SB(0, 1), b2 + hstep, voffB); PG8_STAGE(PG8_SA(0, 0), a2, voffA);
            PG8_WAIT_V(8); PG8_WAIT_L(0); PG8_BAR; PG8_MMA(1, 0, At, B0); PG8_MMA(1, 1, At, B1); PG8_BAR; PG8_SCHED;
            PG8_LDB(B0, 1, 0); PG8_LDB(B1, 1, 1); PG8_SCHED; PG8_LDA(At, 1, 0); PG8_STAGE(PG8_SA(0, 1), a2 + hstep, voffA);
            PG8_WAIT_V(8); PG8_WAIT_L(0); PG8_BAR; PG8_MMA(0, 0, At, B0); PG8_MMA(0, 1, At, B1); PG8_BAR; PG8_SCHED;
            PG8_LDA(At, 1, 1); PG8_STAGE(PG8_SB(1, 0), b3, voffB); PG8_STAGE(PG8_SB(1, 1), b3 + hstep, voffB); PG8_STAGE(PG8_SA(1, 0), a3, voffA);
            PG8_WAIT_V(8); PG8_WAIT_L(0); PG8_BAR; PG8_MMA(1, 0, At, B0); PG8_MMA(1, 1, At, B1); PG8_BAR; PG8_SCHED;
            } else {
            PG8_LDB(B0, 0, 0); PG8_SCHED; PG8_LDA(At, 0, 0); PG8_STAGE(PG8_SA(1, 1), a1 + hstep, voffA);
            PG8_WAIT_L(8); PG8_BAR; PG8_WAIT_L(0); PG8_MMA(0, 0, At, B0); PG8_BAR; PG8_SCHED;
            PG8_LDB(B1, 0, 1); PG8_STAGE(PG8_SB(0, 0), b2, voffB);
            PG8_BAR; PG8_WAIT_L(0); PG8_MMA(0, 1, At, B1); PG8_BAR;
            PG8_LDA(At, 0, 1); PG8_STAGE(PG8_SA(0, 0), a2, voffA);
            PG8_BAR; PG8_WAIT_L(0); PG8_MMA(1, 0, At, B0); PG8_BAR; PG8_SCHED;
            PG8_STAGE(PG8_SB(0, 1), b2 + hstep, voffB);
            PG8_WAIT_V(6); PG8_BAR; PG8_MMA(1, 1, At, B1); PG8_BAR;
            PG8_LDB(B0, 1, 0); PG8_SCHED; PG8_LDA(At, 1, 0); PG8_STAGE(PG8_SA(0, 1), a2 + hstep, voffA);
            PG8_WAIT_L(8); PG8_BAR; PG8_WAIT_L(0); PG8_MMA(0, 0, At, B0); PG8_BAR; PG8_SCHED;
            PG8_LDB(B1, 1, 1); PG8_STAGE(PG8_SB(1, 0), b3, voffB);
            PG8_BAR; PG8_WAIT_L(0); PG8_MMA(0, 1, At, B1); PG8_BAR;
            PG8_LDA(At, 1, 1); PG8_STAGE(PG8_SA(1, 0), a3, voffA);
            PG8_BAR; PG8_WAIT_L(0); PG8_MMA(1, 0, At, B0); PG8_BAR; PG8_SCHED;
            PG8_STAGE(PG8_SB(1, 1), b3 + hstep, voffB);
            PG8_WAIT_V(6); PG8_BAR; PG8_MMA(1, 1, At, B1); PG8_BAR;
            }
        }
        if constexpr (ALIGN_EPI) { if (wr == 0) PG8_BAR; }
        if constexpr (!Epi::AFTER_DRAIN) { E(acc, cur, wr, wc, fr, fq); S.done(cur); }
        if (!has_next) break;
#pragma unroll
        for (int a = 0; a < 2; ++a)
#pragma unroll
            for (int b = 0; b < 2; ++b)
#pragma unroll
                for (int m = 0; m < 4; ++m)
#pragma unroll
                    for (int n = 0; n < 2; ++n) acc[a][b][m][n] = (f32x4){0.f, 0.f, 0.f, 0.f};
        cur = nxt; cA = nA; cB = nB; ++ui;
        if constexpr (ALIGN_EPI) { if (wr == 1) PG8_BAR; }
    }
    PG8_WAIT_V(0);
    if constexpr (!ALIGN_EPI) { if (wr == 0) PG8_BAR; }
    PG8_BAR;
    if constexpr (Epi::AFTER_DRAIN) { E.fused(acc, cur, wr, wc, fr, fq, lds, wid, lane); S.done(cur); }
#undef PG8_SA
#undef PG8_SB
#undef PG8_STAGE
#undef PG8_LDA
#undef PG8_LDB
#undef PG8_MMA
#undef PG8_WAIT_V
#undef PG8_WAIT_L
#undef PG8_BAR
#undef PG8_SCHED
}
}
#ifndef PG8_SP2
#define PG8_SP2 true
#endif
#ifndef PG8_ALIGN
#define PG8_ALIGN true
#endif
#ifndef MK_ONE_LAUNCH
#define MK_ONE_LAUNCH 0
#endif

constexpr int D = 2048, S = 8192, C = 256, R = S + C, DEPTH = 4, HD = 128;
constexpr int AW = 3072, HW = 6144, FF = 8192, NMODW = 6 * D;
constexpr float EPS = 1e-6f;
constexpr float QSCALE = 0.08838834764831845f;
constexpr float MIN_DECAY = -3.0701134573253944f, MAX_DECAY = -15.350567286626973f;
constexpr int NWAVES = 8, NTHREADS = 512;

constexpr size_t MiB = 1u << 20;
constexpr size_t WS_CTL = 0, CTL_ZERO_BYTES = 1 * MiB;
constexpr size_t WS_WAIN = 1 * MiB;
constexpr size_t WS_WAOUT = WS_WAIN + 24 * MiB;
constexpr size_t WS_WHIN = WS_WAOUT + 16 * MiB;
constexpr size_t WS_WHOUT = WS_WHIN + 48 * MiB;
constexpr size_t WS_WM1 = WS_WHOUT + 16 * MiB;
constexpr size_t WS_WM2 = WS_WM1 + 128 * MiB;
constexpr size_t WS_X = WS_WM2 + 128 * MiB;
constexpr size_t WS_H = WS_X + 66 * MiB;
constexpr size_t WS_QKV = WS_H + 33 * MiB;
constexpr size_t WS_KP = WS_QKV + 50 * MiB;
constexpr size_t WS_VP = WS_KP + 9 * MiB;
constexpr size_t WS_O = WS_VP + 9 * MiB;
constexpr size_t WS_U = WS_O + 33 * MiB;
constexpr size_t WS_UP = WS_U + 132 * MiB;
constexpr size_t WS_XV = WS_UP + 99 * MiB;
constexpr size_t WS_ZC = WS_XV + 99 * MiB;
constexpr size_t WS_FILT = WS_ZC + 33 * MiB;
constexpr size_t WS_FILTC = WS_FILT + 256 * MiB;
constexpr size_t WS_HID = WS_FILTC + 4 * MiB;
constexpr size_t WS_MISC = WS_HID + 5 * MiB;
constexpr size_t WS_END = WS_MISC + 2 * MiB;
constexpr int MO_MOD = 0, MO_MODC = MO_MOD + 4 * NMODW, MO_RCOS = MO_MODC + 4 * NMODW, MO_RSIN = MO_RCOS + 128 * 32, MO_FPART = MO_RSIN + 128 * 32, MO_FPARTC = MO_FPART + 2 * 4096 * 16, MO_END = MO_FPARTC + 4096;
static_assert((size_t)MO_END * 4 <= 2 * MiB, "misc");
constexpr int CW_BAR = 4096;

constexpr int LDS_BYTES = 147456;
constexpr int MISC_OFF = LDS_BYTES - 256;

#define GAS __attribute__((address_space(1)))
#define LAS __attribute__((address_space(3)))
typedef unsigned short bf16;
typedef unsigned v4u __attribute__((ext_vector_type(4)));
typedef unsigned v2u __attribute__((ext_vector_type(2)));
typedef float f32x4 __attribute__((ext_vector_type(4)));
#define LDS_WAIT() asm volatile("s_waitcnt lgkmcnt(0)" ::: "memory")
__device__ __forceinline__ unsigned f2bf(float f) { unsigned u = __builtin_bit_cast(unsigned, f); return (u + 0x7fffu + ((u >> 16) & 1u)) >> 16; }
__device__ __forceinline__ unsigned pk2(float lo, float hi) { return f2bf(lo) | (f2bf(hi) << 16); }
__device__ __forceinline__ float bf2f(unsigned b) { return __builtin_bit_cast(float, b << 16); }
__device__ __forceinline__ float xl_dpp_b1(float v) { return __builtin_bit_cast(float, __builtin_amdgcn_update_dpp(0, __builtin_bit_cast(int, v), 0xB1, 0xF, 0xF, true)); }
__device__ __forceinline__ float xl_dpp_4e(float v) { return __builtin_bit_cast(float, __builtin_amdgcn_update_dpp(0, __builtin_bit_cast(int, v), 0x4E, 0xF, 0xF, true)); }
__device__ __forceinline__ float xl_swz4(float v)  { return __builtin_bit_cast(float, __builtin_amdgcn_ds_swizzle(__builtin_bit_cast(int, v), 0x101F)); }
__device__ __forceinline__ float xl_swz8(float v)  { return __builtin_bit_cast(float, __builtin_amdgcn_ds_swizzle(__builtin_bit_cast(int, v), 0x201F)); }
__device__ __forceinline__ float xl_swz16(float v) { return __builtin_bit_cast(float, __builtin_amdgcn_ds_swizzle(__builtin_bit_cast(int, v), 0x401F)); }
__device__ __forceinline__ float xl_x32(float v) { const unsigned u = __builtin_bit_cast(unsigned, v); auto rr = __builtin_amdgcn_permlane32_swap(u, u, false, false);
    return __builtin_bit_cast(float, (unsigned)((threadIdx.x & 32) ? rr[0] : rr[1])); }
__device__ __forceinline__ float wave_sum(float v) {
    v += xl_dpp_b1(v); v += xl_dpp_4e(v); v += xl_swz4(v); v += xl_swz8(v); v += xl_swz16(v);
    { const unsigned u = __builtin_bit_cast(unsigned, v); auto rr = __builtin_amdgcn_permlane32_swap(u, u, false, false); v = __builtin_bit_cast(float, (unsigned)rr[0]) + __builtin_bit_cast(float, (unsigned)rr[1]); }
    return v;
}
__device__ __forceinline__ float wave_max(float v) {
    v = fmaxf(v, xl_dpp_b1(v)); v = fmaxf(v, xl_dpp_4e(v)); v = fmaxf(v, xl_swz4(v)); v = fmaxf(v, xl_swz8(v)); v = fmaxf(v, xl_swz16(v));
    { const unsigned u = __builtin_bit_cast(unsigned, v); auto rr = __builtin_amdgcn_permlane32_swap(u, u, false, false); v = fmaxf(__builtin_bit_cast(float, (unsigned)rr[0]), __builtin_bit_cast(float, (unsigned)rr[1])); }
    return v;
}
#define XB_SPIN_CAP_OVERRIDE 1
#define XB_TMO      128
#define XB_XCNT(j)  (256  + 64 * (j))
#define XB_XSUB(j)  (1280 + 64 * (j))
#define XB_XGEN(j)  (2304 + 64 * (j))
#define XB_TOP      3328
#define XB_TOPGEN   3392
#define XCD_BAR_WORDS 3456
#define XB_SPIN_CAP (1u << 22)

__device__ __forceinline__ unsigned xb_ld(unsigned* p)              { return __hip_atomic_load(p, __ATOMIC_RELAXED, __HIP_MEMORY_SCOPE_AGENT); }
__device__ __forceinline__ unsigned xb_add(unsigned* p, unsigned v) { return __hip_atomic_fetch_add(p, v, __ATOMIC_RELAXED, __HIP_MEMORY_SCOPE_AGENT); }
__device__ __forceinline__ unsigned xb_xcc_id() { return (unsigned)__builtin_amdgcn_s_getreg((3 << 11) | 20) & 0xFu; }
#define XB_SPIN(cond, bar) do { unsigned _sp = 0; while (cond) { __builtin_amdgcn_s_sleep(1); \
    if ((++_sp & 255u) == 0u) { if (xb_ld(&(bar)[XB_TMO])) break; if (_sp > XB_SPIN_CAP) { atomicAdd(&(bar)[XB_TMO], 1u); break; } } } } while (0)

struct XcdBarrier {
    unsigned* bar; unsigned x;
    volatile LAS unsigned* st;
};

__device__ __forceinline__ XcdBarrier xcd_barrier_post(unsigned* bar, volatile LAS unsigned* st) {
    XcdBarrier b; b.bar = bar; b.x = xb_xcc_id(); b.st = st;
    if (threadIdx.x == 0) (void)xb_add(&bar[XB_XCNT(b.x)], 1u);
    return b;
}
__device__ __forceinline__ void xcd_barrier_complete(unsigned* bar, unsigned x, unsigned& nloc, unsigned& nx) {
    const unsigned G = gridDim.x * gridDim.y * gridDim.z;
    unsigned sum, cnt, mine, sp = 0u;
    for (;;) {
        sum = 0u; cnt = 0u; mine = 0u;
#pragma unroll
        for (unsigned j = 0; j < 16; ++j) { const unsigned c = xb_ld(&bar[XB_XCNT(j)]); sum += c; cnt += (c > 0u) ? 1u : 0u; mine = (j == x) ? c : mine; }
        if (sum == G) break;
        __builtin_amdgcn_s_sleep(1);
        if ((++sp & 255u) == 0u) { if (xb_ld(&bar[XB_TMO])) break; if (sp > XB_SPIN_CAP) { atomicAdd(&bar[XB_TMO], 1u); break; } }
    }
    nloc = mine > 0u ? mine : 1u; nx = cnt > 0u ? cnt : 1u;
}

__device__ __forceinline__ void xcd_barrier(const XcdBarrier& b) {
    asm volatile("s_waitcnt vmcnt(0)" ::: "memory");
    __syncthreads();
    if (threadIdx.x == 0) {
        unsigned* bar = b.bar;
        __builtin_amdgcn_s_waitcnt(0);
        unsigned nloc = b.st[0], nx = b.st[1];
        if (nloc == 0u) { xcd_barrier_complete(bar, b.x, nloc, nx); b.st[0] = nloc; b.st[1] = nx; }
        const unsigned old = xb_add(&bar[XB_XSUB(b.x)], 1u);
        const unsigned gen = old / nloc;
        if (old + 1u == (gen + 1u) * nloc) {
            __builtin_amdgcn_fence(__ATOMIC_RELEASE, "agent");
            asm volatile("s_waitcnt vmcnt(0)" ::: "memory");
            const unsigned og = xb_add(&bar[XB_TOP], 1u);
            const unsigned tg = og / nx;
            if (og + 1u == (tg + 1u) * nx) xb_add(&bar[XB_TOPGEN], 1u);
            else XB_SPIN(xb_ld(&bar[XB_TOPGEN]) == tg, bar);
            __builtin_amdgcn_fence(__ATOMIC_ACQUIRE, "agent");
            xb_add(&bar[XB_XGEN(b.x)], 1u);
            asm volatile("s_waitcnt vmcnt(0)" ::: "memory");
        } else {
            XB_SPIN(xb_ld(&bar[XB_XGEN(b.x)]) == gen, bar);
            __builtin_amdgcn_fence(__ATOMIC_ACQUIRE, "agent");
            asm volatile("s_waitcnt vmcnt(0)" ::: "memory");
        }
    }
    __syncthreads();
}

__device__ __forceinline__ void p0_transpose_item(const float* W, int K, int N, bf16* WT, LAS float* scr, int item, int lane) {
    const int nblk = N / 32, kb = item / nblk, nb = item % nblk, k0 = 64 * kb, n0 = 32 * nb;
#pragma unroll 8
    for (int i = 0; i < 32; ++i) { const int kk = 2 * i + (lane >> 5); scr[kk * 33 + (lane & 31)] = W[(size_t)(k0 + kk) * N + n0 + (lane & 31)]; }
    LDS_WAIT();
    const int c = lane & 7;
#pragma unroll
    for (int j = 0; j < 4; ++j) { const int n = (lane >> 3) + 8 * j; const LAS float* s = scr + (8 * c) * 33 + n;
        v4u o; o.x = pk2(s[0 * 33], s[1 * 33]); o.y = pk2(s[2 * 33], s[3 * 33]); o.z = pk2(s[4 * 33], s[5 * 33]); o.w = pk2(s[6 * 33], s[7 * 33]);
        *(v4u*)(WT + (size_t)(n0 + n) * K + k0 + 8 * c) = o; }
    LDS_WAIT();
}
__device__ __forceinline__ void transpose_mat(const float* W, int K, int N, bf16* WT, LAS float* scr, int gw, int NGW, int lane) {
    const int items = (K / 64) * (N / 32);
    for (int it = gw; it < items; it += NGW) p0_transpose_item(W, K, N, WT, scr, it, lane);
}

struct Ctx {
    LAS unsigned char* lds; int tid, lane, wave, bid, G, gw, NGW;
};

__device__ __forceinline__ void phase_prologue(const Ctx& F, const float* const* in, unsigned char* ws) {
    float* misc = (float*)(ws + WS_MISC);
    LAS float* scr = (LAS float*)(F.lds + F.wave * 16384);
    for (int j = 0; j < 2; ++j) {
        transpose_mat(in[8] + (size_t)j * D * AW, D, AW, (bf16*)(ws + WS_WAIN) + (size_t)j * AW * D, scr, F.gw, F.NGW, F.lane);
        transpose_mat(in[9] + (size_t)j * D * D, D, D, (bf16*)(ws + WS_WAOUT) + (size_t)j * D * D, scr, F.gw, F.NGW, F.lane);
        transpose_mat(in[13] + (size_t)j * D * HW, D, HW, (bf16*)(ws + WS_WHIN) + (size_t)j * HW * D, scr, F.gw, F.NGW, F.lane);
        transpose_mat(in[25] + (size_t)j * D * D, D, D, (bf16*)(ws + WS_WHOUT) + (size_t)j * D * D, scr, F.gw, F.NGW, F.lane);
    }
    for (int i = 0; i < 4; ++i) {
        transpose_mat(in[27] + (size_t)i * D * FF, D, FF, (bf16*)(ws + WS_WM1) + (size_t)i * FF * D, scr, F.gw, F.NGW, F.lane);
        transpose_mat(in[28] + (size_t)i * FF * D, FF, D, (bf16*)(ws + WS_WM2) + (size_t)i * D * FF, scr, F.gw, F.NGW, F.lane);
    }
    {
        f32x4* X4 = (f32x4*)(ws + WS_X); const f32x4* x4 = (const f32x4*)in[0]; const f32x4* c4 = (const f32x4*)in[2];
        const int gt = F.bid * NTHREADS + F.tid, NGT = F.G * NTHREADS;
        for (int i = gt; i < S * D / 4; i += NGT) X4[i] = x4[i];
        for (int i = gt; i < C * D / 4; i += NGT) X4[S * D / 4 + i] = c4[i];
        for (int i = gt; i < 128 * 32; i += NGT) { const int pos = i >> 5, k = i & 31; const float inv = powf(10000.0f, -(float)(2 * k) / 64.0f); const float a = (float)pos * inv;
            misc[MO_RCOS + i] = cosf(a); misc[MO_RSIN + i] = sinf(a); }
    }
    {
        float* HID = (float*)(ws + WS_HID);
        for (int p = F.gw; p < 2 * S + C; p += F.NGW) {
            int j, i, n; if (p < 2 * S) { j = p >> 13; i = p & (S - 1); n = S; } else { j = 0; i = p - 2 * S; n = C; }
            const float tt = (float)i / (float)(n - 1);
            const float w = (6.283185307179586f * (float)i) / (float)n;
            const int k = (F.lane - 1) & 15; const float fk = 1e-4f + (float)k * ((15.0f - 1e-4f) / 15.0f);
            const float feat = F.lane == 0 ? tt : (F.lane <= 16 ? cosf(fk * w) : (F.lane <= 32 ? -sinf(fk * w) : 0.f));
            const float* w1 = in[17] + (size_t)j * 33 * 64; const float* w2 = in[20] + (size_t)j * 64 * 64;
            float a = in[18][j * 64 + F.lane];
            for (int f = 0; f < 33; ++f) a += __builtin_bit_cast(float, __builtin_amdgcn_readlane(__builtin_bit_cast(int, feat), f)) * w1[f * 64 + F.lane];
            const float h1 = sinf(in[19][j * 64 + F.lane] * a);
            float b = in[21][j * 64 + F.lane];
            for (int q = 0; q < 64; ++q) b += __builtin_bit_cast(float, __builtin_amdgcn_readlane(__builtin_bit_cast(int, h1), q)) * w2[q * 64 + F.lane];
            HID[(size_t)p * 64 + F.lane] = sinf(in[22][j * 64 + F.lane] * b);
        }
    }
    __syncthreads();
    {
        LAS float* s_c = (LAS float*)F.lds; LAS float* s_cc = s_c + D; LAS f32x4* red = (LAS f32x4*)(F.lds + 16384);
        for (int k = F.tid; k < D; k += NTHREADS) { const float a = in[1][k], b = in[3][k]; s_c[k] = a / (1.0f + expf(-a)); s_cc[k] = b / (1.0f + expf(-b)); }
        __syncthreads();
        for (int item = F.bid; item < 4 * 48; item += F.G) {
            const int layer = item / 48, chunk = item % 48, col4 = chunk * 64 + F.lane;
            const f32x4* Wp = (const f32x4*)(in[4] + (size_t)layer * D * NMODW) + col4;
            f32x4 a0 = {0.f, 0.f, 0.f, 0.f}, a1 = {0.f, 0.f, 0.f, 0.f};
#pragma unroll 8
            for (int k = F.wave; k < D; k += 8) { const f32x4 w = Wp[(size_t)k * (NMODW / 4)]; a0 += w * s_c[k]; a1 += w * s_cc[k]; }
            red[(F.wave * 2 + 0) * 64 + F.lane] = a0; red[(F.wave * 2 + 1) * 64 + F.lane] = a1;
            __syncthreads();
            if (F.wave < 2) { f32x4 s = {0.f, 0.f, 0.f, 0.f};
#pragma unroll
                for (int w = 0; w < 8; ++w) s += red[(w * 2 + F.wave) * 64 + F.lane];
                s += ((const f32x4*)(in[5] + (size_t)layer * NMODW))[col4];
                ((f32x4*)(misc + (F.wave ? MO_MODC : MO_MOD) + layer * NMODW))[col4] = s; }
            __syncthreads();
        }
    }
}

__device__ __forceinline__ void phase_filters(const Ctx& F, const float* const* in, unsigned char* ws) {
    float* misc = (float*)(ws + WS_MISC); const float* HID = (const float*)(ws + WS_HID);
    LAS float* red = (LAS float*)F.lds;
    {
        bf16* rg = (bf16*)(ws + WS_FILT);
        for (int q = F.bid * NTHREADS + F.tid; q < 2 * 4096 * 128; q += F.G * NTHREADS) { const int row = q >> 7, e = q & 127; rg[(size_t)row * 8320 + (e < 65 ? e : 8192 + e)] = 0; }
    }
    for (int item = F.bid; item < 2048 + 64; item += F.G) {
        const bool isctx = item >= 2048; int j, g, it, n;
        if (!isctx) { j = item >> 10; g = (item >> 4) & 63; it = item & 15; n = S; } else { j = 0; g = item - 2048; it = 0; n = C; }
        const int i = it * 512 + F.wave * 64 + F.lane; const bool act = i < n;
        const f32x4* hp = (const f32x4*)(HID + ((size_t)(isctx ? 2 * S : j * S) + (act ? i : 0)) * 64);
        float hr[64];
#pragma unroll
        for (int k = 0; k < 16; ++k) { const f32x4 t = hp[k]; hr[4 * k] = t.x; hr[4 * k + 1] = t.y; hr[4 * k + 2] = t.z; hr[4 * k + 3] = t.w; }
        const float offs = fabsf((float)(i - n / 2)) * (2.0f / (float)n);
        float* dstc = (float*)(ws + WS_FILTC); bf16* dstr = (bf16*)(ws + WS_FILT) + (size_t)j * 4096 * 8320;
        for (int o = 0; o < 64; ++o) {
            const int od = g * 64 + o; const float* w3p = in[23] + (size_t)j * 64 * 4096 + od;
            float a = 0.f;
#pragma unroll
            for (int k = 0; k < 64; ++k) a += hr[k] * w3p[(size_t)k * 4096];
            const int d = od & (D - 1); const float delta = fabsf(MIN_DECAY + (float)d * ((MAX_DECAY - MIN_DECAY) / (float)(D - 1)));
            const float h = a * expf(-offs * delta);
            if (act) { if (isctx) dstc[(size_t)od * C + i] = h; else dstr[(size_t)od * 8320 + 8256 - i] = (bf16)f2bf(h); }
            const float ss = wave_sum(act ? h * h : 0.f);
            if (F.lane == 0) red[F.wave * 64 + o] = ss;
        }
        __syncthreads();
        if (F.tid < 64) { float s = 0.f;
#pragma unroll
            for (int w = 0; w < 8; ++w) s += red[w * 64 + F.tid];
            const int od = g * 64 + F.tid;
            if (isctx) misc[MO_FPARTC + od] = s; else misc[MO_FPART + (j * 4096 + od) * 16 + it] = s; }
        __syncthreads();
    }
}

__device__ __forceinline__ void phase_norm_mod(const Ctx& F, const float* X, bf16* H, int nrows, const float* g, const float* shL, const float* scL, const float* shC, const float* scC) {
    for (int r = F.gw; r < nrows; r += F.NGW) {
        const f32x4* xr = (const f32x4*)(X + (size_t)r * D) + F.lane;
        const f32x4* sh = (const f32x4*)(r < S ? shL : shC) + F.lane; const f32x4* sc = (const f32x4*)(r < S ? scL : scC) + F.lane; const f32x4* g4 = (const f32x4*)g + F.lane;
        f32x4 v[8]; float ss = 0.f;
#pragma unroll
        for (int j = 0; j < 8; ++j) { v[j] = xr[64 * j]; ss += (v[j].x * v[j].x + v[j].y * v[j].y) + (v[j].z * v[j].z + v[j].w * v[j].w); }
        const float rstd = 1.0f / sqrtf(wave_sum(ss) * (1.0f / D) + EPS);
        v2u* o = (v2u*)(H + (size_t)r * D) + F.lane;
#pragma unroll
        for (int j = 0; j < 8; ++j) { const f32x4 y = (v[j] * rstd) * g4[64 * j]; const f32x4 z = y * (1.0f + sc[64 * j]) + sh[64 * j];
            v2u w; w.x = pk2(z.x, z.y); w.y = pk2(z.z, z.w); o[64 * j] = w; }
    }
}
__device__ __forceinline__ void phase_final_norm(const Ctx& F, const float* X, float* out, const float* g) {
    for (int r = F.gw; r < S; r += F.NGW) {
        const f32x4* xr = (const f32x4*)(X + (size_t)r * D) + F.lane; const f32x4* g4 = (const f32x4*)g + F.lane;
        f32x4 v[8]; float ss = 0.f;
#pragma unroll
        for (int j = 0; j < 8; ++j) { v[j] = xr[64 * j]; ss += (v[j].x * v[j].x + v[j].y * v[j].y) + (v[j].z * v[j].z + v[j].w * v[j].w); }
        const float rstd = 1.0f / sqrtf(wave_sum(ss) * (1.0f / D) + EPS);
        f32x4* o = (f32x4*)(out + (size_t)r * D) + F.lane;
#pragma unroll
        for (int j = 0; j < 8; ++j) o[64 * j] = (v[j] * rstd) * g4[64 * j];
    }
}

__device__ __forceinline__ void phase_kprep(const Ctx& F, const bf16* QKV, bf16* KP, bf16* VP, const float* knorm, const float* rcos, const float* rsin) {
    const int p = F.lane & 31, half = F.lane >> 5, da = half * 64 + p, db = da + 32;
    for (int r = F.gw; r < R; r += F.NGW) {
        const bool lat = r < S; const int kr = lat ? C + r : r - S;
        const int pos = half == 0 ? (r >> 6) : (r & 63);
        const float cs = lat ? rcos[pos * 32 + p] : 1.0f, sn = lat ? rsin[pos * 32 + p] : 0.0f;
#pragma unroll
        for (int h = 0; h < 4; ++h) {
            const bf16* src = QKV + (size_t)r * AW + 2048 + h * HD;
            float a = bf2f(src[da]), b = bf2f(src[db]);
            if (h >= 2) { const float ss = wave_sum(a * a + b * b); const float rstd = 1.0f / sqrtf(ss * (1.0f / HD) + EPS); a = a * rstd * knorm[da]; b = b * rstd * knorm[db]; }
            const float oa = a * cs - b * sn, ob = b * cs + a * sn;
            bf16* dst = KP + (size_t)kr * 512 + h * HD; dst[da] = (bf16)f2bf(oa); dst[db] = (bf16)f2bf(ob);
            ((unsigned*)(VP + (size_t)kr * 512 + h * HD))[F.lane] = ((const unsigned*)(QKV + (size_t)r * AW + 2560 + h * HD))[F.lane];
        }
    }
}

__device__ __forceinline__ void phase_attn_naive(const Ctx& F, const bf16* QKV, const bf16* KP, const bf16* VP, bf16* O, int nq, const float* sink, const float* qnorm, const float* rcos, const float* rsin) {
    LAS float* qs = (LAS float*)(F.lds + F.wave * 1024); LAS float* outs = qs + 128;
    const int p = F.lane & 31, half = F.lane >> 5, da = half * 64 + p, db = da + 32;
    const int ks = F.lane & 31, dh = F.lane >> 5;
    for (int it = F.gw; it < nq * 16; it += F.NGW) {
        const int r = it >> 4, h = it & 15; const bool lat = r < S;
        {
            const bf16* src = QKV + (size_t)r * AW + h * HD;
            float a = bf2f(src[da]), b = bf2f(src[db]);
            if (h >= 8) { const float ss = wave_sum(a * a + b * b); const float rstd = 1.0f / sqrtf(ss * (1.0f / HD) + EPS); a = a * rstd * qnorm[da]; b = b * rstd * qnorm[db]; }
            const int pos = half == 0 ? (r >> 6) : (r & 63);
            const float cs = lat ? rcos[pos * 32 + p] : 1.0f, sn = lat ? rsin[pos * 32 + p] : 0.0f;
            qs[da] = (a * cs - b * sn) * QSCALE; qs[db] = (b * cs + a * sn) * QSCALE;
            LDS_WAIT();
        }
        const int kvh = h < 8 ? (h >> 2) : 2 + ((h - 8) >> 2);
        int lo = 0, nl = 0;
        if (lat) { if (h < 8) { lo = r - 128 < 0 ? 0 : r - 128; const int hi = r + 128 > S - 1 ? S - 1 : r + 128; nl = hi - lo + 1; } else { lo = 0; nl = S; } }
        const int total = C + nl;
        float m = -1e30f, l = 0.f; float o[64];
#pragma unroll
        for (int d = 0; d < 64; ++d) o[d] = 0.f;
        if (h < 8 && ks == 0) { m = sink[h]; l = 1.0f; }
        const int nsteps = (total + 31) >> 5;
        for (int st = 0; st < nsteps; ++st) {
            const int kk = st * 32 + ks; const bool valid = kk < total; const int kc = valid ? kk : 0;
            const int krow = kc < C ? kc : C + lo + (kc - C);
            const v4u* kp = (const v4u*)(KP + (size_t)krow * 512 + kvh * HD + dh * 64); const v4u* vp = (const v4u*)(VP + (size_t)krow * 512 + kvh * HD + dh * 64);
            float s = 0.f;
#pragma unroll
            for (int c = 0; c < 8; ++c) { const v4u kv = kp[c]; const LAS f32x4* q4 = (const LAS f32x4*)(qs + dh * 64) + 2 * c; const f32x4 qa = q4[0], qb = q4[1];
                s += bf2f(kv.x & 0xffffu) * qa.x + bf2f(kv.x >> 16) * qa.y + bf2f(kv.y & 0xffffu) * qa.z + bf2f(kv.y >> 16) * qa.w
                   + bf2f(kv.z & 0xffffu) * qb.x + bf2f(kv.z >> 16) * qb.y + bf2f(kv.w & 0xffffu) * qb.z + bf2f(kv.w >> 16) * qb.w; }
            s += xl_x32(s);
            if (valid) {
                const float mn = fmaxf(m, s), al = expf(m - mn), pp = expf(s - mn); l = l * al + pp; m = mn;
#pragma unroll
                for (int c = 0; c < 8; ++c) { const v4u vv = vp[c];
                    o[8 * c + 0] = o[8 * c + 0] * al + pp * bf2f(vv.x & 0xffffu); o[8 * c + 1] = o[8 * c + 1] * al + pp * bf2f(vv.x >> 16);
                    o[8 * c + 2] = o[8 * c + 2] * al + pp * bf2f(vv.y & 0xffffu); o[8 * c + 3] = o[8 * c + 3] * al + pp * bf2f(vv.y >> 16);
                    o[8 * c + 4] = o[8 * c + 4] * al + pp * bf2f(vv.z & 0xffffu); o[8 * c + 5] = o[8 * c + 5] * al + pp * bf2f(vv.z >> 16);
                    o[8 * c + 6] = o[8 * c + 6] * al + pp * bf2f(vv.w & 0xffffu); o[8 * c + 7] = o[8 * c + 7] * al + pp * bf2f(vv.w >> 16); }
            }
        }
        const float M = wave_max(m), f = expf(m - M); const float L = 0.5f * wave_sum(l * f); const float rl = 1.0f / L;
#pragma unroll
        for (int d = 0; d < 64; ++d) { float sd = o[d] * f;
            sd += xl_dpp_b1(sd); sd += xl_dpp_4e(sd); sd += xl_swz4(sd); sd += xl_swz8(sd); sd += xl_swz16(sd);
            if (ks == 0) outs[dh * 64 + d] = sd * rl; }
        LDS_WAIT();
        ((unsigned*)(O + (size_t)r * D + h * HD))[F.lane] = pk2(outs[2 * F.lane], outs[2 * F.lane + 1]);
        LDS_WAIT();
    }
}

__device__ __forceinline__ void phase_shortconv(const Ctx& F, const bf16* UP, bf16* XV, const float* cw, const float* cb, int nrows) {
    LAS float* scr = (LAS float*)(F.lds + F.wave * 16896);
    const int ntb = nrows / 64;
    for (int it = F.gw; it < ntb * 96; it += F.NGW) {
        const int tb = it / 96, cbk = it % 96, r0 = tb * 64, c0 = cbk * 64;
        const int slo = tb < 128 ? 0 : S, shi = tb < 128 ? S : R;
        const int c = c0 + F.lane; const float w0 = cw[c], w1 = cw[HW + c], w2 = cw[2 * HW + c], bb = cb[c];
        float prev = (r0 - 1 >= slo) ? bf2f(UP[(size_t)(r0 - 1) * HW + c]) : 0.f; float cur = bf2f(UP[(size_t)r0 * HW + c]);
        for (int t = 0; t < 64; ++t) { const int r = r0 + t; const float nxt = (r + 1 < shi) ? bf2f(UP[(size_t)(r + 1) * HW + c]) : 0.f;
            scr[F.lane * 65 + t] = w0 * prev + w1 * cur + w2 * nxt + bb; prev = cur; cur = nxt; }
        LDS_WAIT();
        for (int cc = 0; cc < 64; ++cc) XV[(size_t)(c0 + cc) * R + r0 + F.lane] = (bf16)f2bf(scr[cc * 65 + F.lane]);
        LDS_WAIT();
    }
}

__device__ __forceinline__ void conv_naive(const LAS float* zs, const LAS float* Ts, int n, int tid, float (&acc)[16]) {
#pragma unroll
    for (int q = 0; q < 16; ++q) acc[q] = 0.f;
    const int half = n >> 1;
    for (int s = 0; s < n; ++s) { const float zv = zs[s];
#pragma unroll
        for (int q = 0; q < 16; ++q) { const int t = tid + 512 * q; const int idx = t - s + half; const bool ok = ((unsigned)idx < (unsigned)n) && (t < n);
            const float tv = Ts[ok ? idx : 0]; acc[q] += ok ? zv * tv : 0.f; } }
}
__device__ __forceinline__ void phase_longconv_naive(const Ctx& F, const bf16* XV, bf16* ZC, const float* FILT, const float* FILTC, const float* fpart, const float* fpartc, const float* skip, bool with_ctx, bool with_lat) {
    LAS float* zs = (LAS float*)F.lds; LAS float* Ts = zs + S; LAS float* z2 = Ts + S;
    const int nitems = with_ctx ? 2 * D : D;
    for (int it = (with_lat ? 0 : D) + F.bid; it < nitems; it += F.G) {
        const bool isctx = it >= D; const int c = isctx ? it - D : it, n = isctx ? C : S, base = isctx ? S : 0;
        const bf16* vsrc = XV + (size_t)(2 * D + c) * R + base; const bf16* x1 = XV + (size_t)c * R + base; const bf16* x2 = XV + (size_t)(D + c) * R + base;
        float s0, s1;
        if (isctx) { s0 = 1.0f / sqrtf(fpartc[c] + EPS); s1 = 1.0f / sqrtf(fpartc[D + c] + EPS); }
        else { float a = 0.f, b = 0.f; for (int k = 0; k < 16; ++k) { a += fpart[c * 16 + k]; b += fpart[(D + c) * 16 + k]; } s0 = 1.0f / sqrtf(a + EPS); s1 = 1.0f / sqrtf(b + EPS); }
        const float* T0 = isctx ? FILTC + (size_t)c * C : FILT + (size_t)c * S; const float* T1 = isctx ? FILTC + (size_t)(D + c) * C : FILT + (size_t)(D + c) * S;
        for (int t = F.tid; t < n; t += NTHREADS) { zs[t] = bf2f(vsrc[t]); Ts[t] = T0[t]; }
        __syncthreads();
        float acc[16];
        conv_naive(zs, Ts, n, F.tid, acc);
        const float sk0 = skip[c], sk1 = skip[D + c];
#pragma unroll
        for (int q = 0; q < 16; ++q) { const int t = F.tid + 512 * q; if (t < n) z2[t] = bf2f(x1[t]) * (s0 * acc[q] + zs[t] * sk0); }
        __syncthreads();
        for (int t = F.tid; t < n; t += NTHREADS) Ts[t] = T1[t];
        __syncthreads();
        conv_naive(z2, Ts, n, F.tid, acc);
#pragma unroll
        for (int q = 0; q < 16; ++q) { const int t = F.tid + 512 * q; if (t < n) ZC[(size_t)c * R + base + t] = (bf16)f2bf(bf2f(x2[t]) * (s1 * acc[q] + z2[t] * sk1)); }
        __syncthreads();
    }
}
__device__ __forceinline__ void phase_transpose_zc(const Ctx& F, const bf16* ZC, bf16* O, int nrows) {
    LAS float* scr = (LAS float*)(F.lds + F.wave * 16896);
    const int ntb = nrows / 64;
    for (int it = F.gw; it < ntb * 32; it += F.NGW) {
        const int tb = it / 32, cbk = it % 32, r0 = tb * 64, c0 = cbk * 64;
        for (int cc = 0; cc < 64; ++cc) scr[cc * 65 + F.lane] = bf2f(ZC[(size_t)(c0 + cc) * R + r0 + F.lane]);
        LDS_WAIT();
        for (int t = 0; t < 64; ++t) O[(size_t)(r0 + t) * D + c0 + F.lane] = (bf16)f2bf(scr[F.lane * 65 + t]);
        LDS_WAIT();
    }
}
namespace att {
using bf16x8 = __attribute__((ext_vector_type(8))) short;
using s16x4  = __attribute__((ext_vector_type(4))) short;
using f32x16 = __attribute__((ext_vector_type(16))) float;
using u32x4  = __attribute__((ext_vector_type(4))) unsigned;
constexpr int KVBLK = 64, LDQ = AW, LDK = 512, LDO = D;
constexpr float SCALE = 0.088388347648318440f;
constexpr float THR = 8.f;
constexpr int SDEPTH = 1;
constexpr int SHM_V = KVBLK * 128 * 2, SHM_K = KVBLK * 128 * 2, SHM_ATTN = 2 * SHM_V + 2 * SHM_K + 8 * 64 * 4;
#define KSWZ(row, colB) ((row) * 256 + ((colB) ^ (((row) & 7) << 4)))
#define SBAR() __builtin_amdgcn_sched_barrier(0)
__device__ __forceinline__ int crow(int r, int hi) { return (r & 3) + 8 * (r >> 2) + 4 * hi; }
__device__ __forceinline__ unsigned cvtpk(float lo, float hi) { unsigned r; asm volatile("v_cvt_pk_bf16_f32 %0, %1, %2" : "=v"(r) : "v"(lo), "v"(hi)); return r; }

__device__ __forceinline__ void partialSM(f32x16& p0, f32x16& p1, float& m_reg, float& mn, float& alpha) {
  constexpr float Cc = SCALE * 1.4426950408889634f;
  float pmax = p0[0]; for (int r = 1; r < 16; ++r) pmax = fmaxf(pmax, p0[r]); for (int r = 0; r < 16; ++r) pmax = fmaxf(pmax, p1[r]);
  { auto rr = __builtin_amdgcn_permlane32_swap(__float_as_uint(pmax), __float_as_uint(pmax), false, false);
    pmax = fmaxf(__uint_as_float(rr[0]), __uint_as_float(rr[1])); }
  if (__builtin_expect(__all(pmax - m_reg <= THR / SCALE), 1)) { mn = m_reg; alpha = 1.f; }
  else { mn = fmaxf(m_reg, pmax); alpha = __builtin_amdgcn_exp2f((m_reg - mn) * Cc); m_reg = mn; }
  float mnC = -mn * Cc;
  for (int r = 0; r < 16; ++r) p0[r] = fmaf(p0[r], Cc, mnC); for (int r = 0; r < 16; ++r) p1[r] = fmaf(p1[r], Cc, mnC);
  for (int r = 0; r < 16; ++r) p0[r] = __builtin_amdgcn_exp2f(p0[r]);
}
__device__ __forceinline__ void finishSM(f32x16& p0, f32x16& p1, float alpha, float& l_reg, bf16x8& pa0, bf16x8& pa1, bf16x8& pa2, bf16x8& pa3) {
  for (int r = 0; r < 16; ++r) p1[r] = __builtin_amdgcn_exp2f(p1[r]);
  float ps = 0; for (int r = 0; r < 16; ++r) ps += p0[r]; for (int r = 0; r < 16; ++r) ps += p1[r];
  { auto rr = __builtin_amdgcn_permlane32_swap(__float_as_uint(ps), __float_as_uint(ps), false, false);
    ps = __uint_as_float(rr[0]) + __uint_as_float(rr[1]); }
  l_reg = l_reg * alpha + ps;
#define PK4(P, BASE, OUT) do { unsigned a0 = cvtpk(P[BASE + 0], P[BASE + 1]), a1 = cvtpk(P[BASE + 2], P[BASE + 3]);   \
    unsigned b0 = cvtpk(P[BASE + 4], P[BASE + 5]), b1 = cvtpk(P[BASE + 6], P[BASE + 7]);                              \
    auto r0 = __builtin_amdgcn_permlane32_swap(a0, b0, false, false); auto r1 = __builtin_amdgcn_permlane32_swap(a1, b1, false, false); \
    u32x4 w = {r0[0], r1[0], r0[1], r1[1]}; OUT = *reinterpret_cast<bf16x8*>(&w); } while (0)
  PK4(p0, 0, pa0); PK4(p0, 8, pa1); PK4(p1, 0, pa2); PK4(p1, 8, pa3);
#undef PK4
}
__device__ __forceinline__ void qkt(f32x16& p0, f32x16& p1, const char* Ks, const bf16x8* qr, int r32, int hi) {
  p0 = f32x16{}; p1 = f32x16{};
  for (int d0 = 0; d0 < 8; ++d0) { int cb = (d0 * 16 + hi * 8) * 2;
    bf16x8 b0 = *reinterpret_cast<const bf16x8*>(Ks + KSWZ(r32, cb));
    bf16x8 b1 = *reinterpret_cast<const bf16x8*>(Ks + KSWZ(32 + r32, cb));
    p0 = __builtin_amdgcn_mfma_f32_32x32x16_bf16(b0, qr[d0], p0, 0, 0, 0);
    p1 = __builtin_amdgcn_mfma_f32_32x32x16_bf16(b1, qr[d0], p1, 0, 0, 0); }
}
__device__ __forceinline__ int v_st(int k, int c) { const int kk = (k & ~0xC) | ((k & 4) << 1) | ((k & 8) >> 1); return ((kk >> 3) * 4 + (c >> 5)) * 512 + ((kk & 7) * 32 + (c & 31)) * 2; }
__device__ __forceinline__ int v_rd_base(int lane) { return ((lane & 3) << 3) | (((lane >> 2) & 3) << 6) | (((lane >> 4) & 1) << 5) | (((lane >> 5) & 1) << 8); }
constexpr int v_rd_off(int d0, int ks, int half) { return d0 * 512 + ks * 4096 + half * 2048; }
template <int OFF> __device__ __forceinline__ s16x4 tr_read(int vb) {
  s16x4 r; asm volatile("ds_read_b64_tr_b16 %0, %1 offset:%2" : "=&v"(r) : "v"(vb), "i"(OFF) : "memory"); return r;
}
template <int D0> __device__ __forceinline__ void pv_one(f32x16& od, int vb, bf16x8 pa0, bf16x8 pa1, bf16x8 pa2, bf16x8 pa3) {
  const s16x4 l0 = tr_read<v_rd_off(D0, 0, 0)>(vb), h0 = tr_read<v_rd_off(D0, 0, 1)>(vb), l1 = tr_read<v_rd_off(D0, 1, 0)>(vb), h1 = tr_read<v_rd_off(D0, 1, 1)>(vb);
  const s16x4 l2 = tr_read<v_rd_off(D0, 2, 0)>(vb), h2 = tr_read<v_rd_off(D0, 2, 1)>(vb), l3 = tr_read<v_rd_off(D0, 3, 0)>(vb), h3 = tr_read<v_rd_off(D0, 3, 1)>(vb);
  asm volatile("s_waitcnt lgkmcnt(0)" ::: "memory"); SBAR();
#define PK(L, H) (bf16x8){L[0], L[1], L[2], L[3], H[0], H[1], H[2], H[3]}
  od = __builtin_amdgcn_mfma_f32_32x32x16_bf16(pa0, PK(l0, h0), od, 0, 0, 0);
  od = __builtin_amdgcn_mfma_f32_32x32x16_bf16(pa1, PK(l1, h1), od, 0, 0, 0);
  od = __builtin_amdgcn_mfma_f32_32x32x16_bf16(pa2, PK(l2, h2), od, 0, 0, 0);
  od = __builtin_amdgcn_mfma_f32_32x32x16_bf16(pa3, PK(l3, h3), od, 0, 0, 0);
#undef PK
}
__device__ __forceinline__ void pv_d0(f32x16* o, int vb, bf16x8 pa0, bf16x8 pa1, bf16x8 pa2, bf16x8 pa3) {
  pv_one<0>(o[0], vb, pa0, pa1, pa2, pa3); pv_one<1>(o[1], vb, pa0, pa1, pa2, pa3); pv_one<2>(o[2], vb, pa0, pa1, pa2, pa3); pv_one<3>(o[3], vb, pa0, pa1, pa2, pa3);
}

struct Unit {
    const bf16* Qb;
    const bf16* Kh;
    const bf16* Vh;
    bf16* Ob;
    int NT;
    int lat0;
    int i0;
    int windowed;
    int norm_q;
    float sink; int has_sink;
};

__device__ __forceinline__ void window_mask(f32x16& p0, f32x16& p1, int base, int hi) {
#pragma unroll
  for (int r = 0; r < 16; ++r) { const int d0 = base + crow(r, hi), d1 = d0 + 32;
    p0[r] = (d0 >= -128 && d0 <= 128) ? p0[r] : -__builtin_inff();
    p1[r] = (d1 >= -128 && d1 <= 128) ? p1[r] : -__builtin_inff(); }
}

__device__ __forceinline__ void attn_unit(const Unit u, const float* __restrict__ qn, const float* __restrict__ rcos, const float* __restrict__ rsin, char* lds, const int tid) {
  const int wid = tid >> 6, lane = tid & 63, r32 = lane & 31, hi = lane >> 5;
  char* V_lds = lds; char* K_lds = lds + 2 * SHM_V;
  float* wsx = (float*)(lds + 2 * SHM_V + 2 * SHM_K) + wid * 64; float* li_l = wsx; float* al_l = wsx + 32;
  float m_reg = u.has_sink ? u.sink * (1.0f / SCALE) : -1e30f, l_reg = u.has_sink ? 1.f : 0.f; f32x16 o[4] = {}; bf16x8 qr[8];
  const int qpos = u.i0 + wid * 32 + r32;
  {
    const bf16* Qw = u.Qb + (long)(wid * 32 + r32) * LDQ + hi * 8;
    float qf[8][8];
#pragma unroll
    for (int d0 = 0; d0 < 8; ++d0) { const u32x4 raw = *reinterpret_cast<const u32x4*>(Qw + d0 * 16);
#pragma unroll
      for (int e = 0; e < 4; ++e) { qf[d0][2 * e] = bf2f(raw[e] & 0xffffu); qf[d0][2 * e + 1] = bf2f(raw[e] >> 16); } }
    if (u.norm_q) { float ss = 0.f;
#pragma unroll
      for (int d0 = 0; d0 < 8; ++d0)
#pragma unroll
        for (int e = 0; e < 8; ++e) ss += qf[d0][e] * qf[d0][e];
      ss += xl_x32(ss);
      const float rstd = 1.0f / sqrtf(ss * (1.0f / 128.0f) + EPS);
#pragma unroll
      for (int d0 = 0; d0 < 8; ++d0) { const f32x4 g0 = *(const f32x4*)(qn + d0 * 16 + hi * 8), g1 = *(const f32x4*)(qn + d0 * 16 + hi * 8 + 4);
        qf[d0][0] *= rstd * g0.x; qf[d0][1] *= rstd * g0.y; qf[d0][2] *= rstd * g0.z; qf[d0][3] *= rstd * g0.w;
        qf[d0][4] *= rstd * g1.x; qf[d0][5] *= rstd * g1.y; qf[d0][6] *= rstd * g1.z; qf[d0][7] *= rstd * g1.w; } }
    if (u.i0 >= 0) {
#pragma unroll
      for (int hf = 0; hf < 2; ++hf) { const int pos = hf == 0 ? (qpos >> 6) : (qpos & 63);
#pragma unroll
        for (int dd = 0; dd < 2; ++dd) { const int pb = pos * 32 + dd * 16 + hi * 8;
          const f32x4 c0 = *(const f32x4*)(rcos + pb), c1 = *(const f32x4*)(rcos + pb + 4), s0 = *(const f32x4*)(rsin + pb), s1 = *(const f32x4*)(rsin + pb + 4);
          const float cs[8] = {c0.x, c0.y, c0.z, c0.w, c1.x, c1.y, c1.z, c1.w}, sn[8] = {s0.x, s0.y, s0.z, s0.w, s1.x, s1.y, s1.z, s1.w};
#pragma unroll
          for (int e = 0; e < 8; ++e) { const float a = qf[4 * hf + dd][e], b = qf[4 * hf + dd + 2][e];
            qf[4 * hf + dd][e] = a * cs[e] - b * sn[e]; qf[4 * hf + dd + 2][e] = b * cs[e] + a * sn[e]; } } } }
#pragma unroll
    for (int d0 = 0; d0 < 8; ++d0) { u32x4 w = {cvtpk(qf[d0][0], qf[d0][1]), cvtpk(qf[d0][2], qf[d0][3]), cvtpk(qf[d0][4], qf[d0][5]), cvtpk(qf[d0][6], qf[d0][7])}; qr[d0] = *reinterpret_cast<bf16x8*>(&w); }
  }
  const int sr = tid >> 4, sc = (tid & 15) * 8, vst0 = v_st(sr, sc), vst1 = v_st(32 + sr, sc);
  const int vb0 = (int)(uintptr_t)V_lds + v_rd_base(lane);
  const bf16* Kh = u.Kh; const bf16* Vh = u.Vh; const int lat0 = u.lat0;
  struct { bf16x8 vs0, vs1, ks0, ks1; } sr_[SDEPTH];
#define KOFF(t) (64 * (t) + ((t) >= 4 ? lat0 : 0))
#define SLOAD(i, k0) do { const long _k = (k0); sr_[i].vs0 = *reinterpret_cast<const bf16x8*>(&Vh[(_k + sr) * LDK + sc]); sr_[i].vs1 = *reinterpret_cast<const bf16x8*>(&Vh[(_k + 32 + sr) * LDK + sc]); \
    sr_[i].ks0 = *reinterpret_cast<const bf16x8*>(&Kh[(_k + sr) * LDK + sc]); sr_[i].ks1 = *reinterpret_cast<const bf16x8*>(&Kh[(_k + 32 + sr) * LDK + sc]); } while (0)
#define SWRITE(b, i) do { *(bf16x8*)(V_lds + (b) * SHM_V + vst0) = sr_[i].vs0;          \
    *(bf16x8*)(V_lds + (b) * SHM_V + vst1) = sr_[i].vs1; int kc = sc * 2;               \
    *(bf16x8*)(K_lds + (b) * SHM_K + KSWZ(sr, kc)) = sr_[i].ks0;                       \
    *(bf16x8*)(K_lds + (b) * SHM_K + KSWZ(32 + sr, kc)) = sr_[i].ks1; } while (0)
#define SWAIT() do { if constexpr (SDEPTH == 2) asm volatile("s_waitcnt vmcnt(4)" ::: "memory"); else asm volatile("s_waitcnt vmcnt(0)" ::: "memory"); } while (0)
#define RESC(a) do { if (__any((a) < 1.f)) { if (hi == 0) al_l[r32] = (a); asm volatile("s_waitcnt lgkmcnt(0)" ::: "memory"); \
    for (int d = 0; d < 4; ++d) for (int r = 0; r < 16; ++r) o[d][r] *= al_l[crow(r, hi)]; } } while (0)
#define WMASK(P0, P1, t) do { if (u.windowed && (t) >= 4) { const int _b = KOFF(t) - C - qpos; if (__any(_b < -128 || _b + 63 > 128)) window_mask(P0, P1, _b, hi); } } while (0)
  f32x16 pA0, pA1, pB0, pB1; float mnA, mnB, alA, alB; bf16x8 pa0, pa1, pa2, pa3; const int NT = u.NT;
  constexpr int SE = 0, SO = SDEPTH - 1;
  SLOAD(SE, KOFF(0)); asm volatile("s_waitcnt vmcnt(0)" ::: "memory"); SWRITE(0, SE); __syncthreads();
  qkt(pA0, pA1, K_lds, qr, r32, hi); WMASK(pA0, pA1, 0); partialSM(pA0, pA1, m_reg, mnA, alA);
  SLOAD(SO, KOFF(1)); if constexpr (SDEPTH == 2) { if (2 < NT) SLOAD(SE, KOFF(2)); }
  SWAIT(); SWRITE(1, SO); __syncthreads();
  for (int j = 1; j + 1 < NT; j += 2) {
    SBAR(); qkt(pB0, pB1, K_lds + SHM_K, qr, r32, hi);
    finishSM(pA0, pA1, alA, l_reg, pa0, pa1, pa2, pa3); SBAR();
    SLOAD(SO, KOFF(j + SDEPTH)); SBAR();
    pv_d0(o, vb0, pa0, pa1, pa2, pa3); WMASK(pB0, pB1, j); partialSM(pB0, pB1, m_reg, mnB, alB);
    __syncthreads(); SWAIT(); SWRITE(0, SE);
    RESC(alB); __syncthreads();
    SBAR(); qkt(pA0, pA1, K_lds, qr, r32, hi);
    finishSM(pB0, pB1, alB, l_reg, pa0, pa1, pa2, pa3); SBAR();
    if (SDEPTH == 1 || j + 3 < NT) SLOAD(SE, KOFF(j + 1 + SDEPTH)); SBAR();
    pv_d0(o, vb0 + (int)SHM_V, pa0, pa1, pa2, pa3); WMASK(pA0, pA1, j + 1); partialSM(pA0, pA1, m_reg, mnA, alA);
    __syncthreads(); SWAIT(); SWRITE(1, SO);
    RESC(alA); __syncthreads();
  }
  SBAR(); qkt(pB0, pB1, K_lds + SHM_K, qr, r32, hi);
  finishSM(pA0, pA1, alA, l_reg, pa0, pa1, pa2, pa3); SBAR();
  pv_d0(o, vb0, pa0, pa1, pa2, pa3); WMASK(pB0, pB1, NT - 1); partialSM(pB0, pB1, m_reg, mnB, alB);
  __syncthreads(); RESC(alB);
  finishSM(pB0, pB1, alB, l_reg, pa0, pa1, pa2, pa3); SBAR();
  pv_d0(o, vb0 + (int)SHM_V, pa0, pa1, pa2, pa3);
  if (hi == 0) li_l[r32] = l_reg; asm volatile("s_waitcnt lgkmcnt(0)" ::: "memory");
  float rli[16];
#pragma unroll
  for (int r = 0; r < 16; ++r) rli[r] = __builtin_amdgcn_rcpf(li_l[crow(r, hi)]);
  bf16* Ow = u.Ob + (long)(wid * 32) * LDO;
#pragma unroll
  for (int r = 0; r < 16; ++r) { const int orow = crow(r, hi);
#pragma unroll
    for (int d0 = 0; d0 < 4; ++d0) Ow[(long)orow * LDO + d0 * 32 + r32] = (bf16)f2bf(o[d0][r] * rli[r]); }
  __syncthreads();
#undef KOFF
#undef SLOAD
#undef SWRITE
#undef SWAIT
#undef RESC
#undef WMASK
}
#undef KSWZ
#undef SBAR
}

__device__ __forceinline__ void phase_attn(const Ctx& F, const bf16* QKV, const bf16* KP, const bf16* VP, bf16* O, bool ctx_out, const float* sink, const float* qnorm, const float* rcos, const float* rsin) {
    const int nunits = 256 + 256 + (ctx_out ? 16 : 0);
    for (int un = F.bid; un < nunits; un += F.G) {
        att::Unit u;
        int h, qb, isctx = 0;
        if (un < 256) { h = 8 + (un >> 5); qb = un & 31; }
        else if (un < 512) { h = (un - 256) >> 5; qb = un & 31; }
        else { h = un - 512; qb = 32; isctx = 1; }
        const int kvh = h < 8 ? (h >> 2) : 2 + ((h - 8) >> 2);
        const int row0 = qb * 256;
        u.Qb = QKV + (size_t)row0 * AW + h * HD; u.Kh = KP + kvh * HD; u.Vh = VP + kvh * HD; u.Ob = O + (size_t)row0 * D + h * HD;
        u.i0 = isctx ? -1 : row0; u.norm_q = h >= 8; u.has_sink = h < 8; u.sink = h < 8 ? sink[h] : 0.f;
        if (isctx) { u.NT = 4; u.lat0 = 0; u.windowed = 0; }
        else if (h >= 8) { u.NT = R / 64; u.lat0 = 0; u.windowed = 0; }
        else { const int l0 = row0 - 128 < 0 ? 0 : row0 - 128, l1 = row0 + 384 > S ? S : row0 + 384; u.lat0 = l0; u.NT = 4 + (l1 - l0) / 64; u.windowed = 1; }
        att::attn_unit(u, qnorm, rcos, rsin, (char*)F.lds, F.tid);
    }
}
namespace hconv {
using bf16x8 = __attribute__((ext_vector_type(8))) short;
using f32x16 = __attribute__((ext_vector_type(16))) float;
using u32x4  = __attribute__((ext_vector_type(4))) unsigned;
constexpr int RLEN = 8320, ROFF = 4160;
constexpr int ZPITCH = 144, ZBYTES = 128 * ZPITCH, RBYTES = RLEN * 2, CHBYTES = ZBYTES + RBYTES, ZERO_OFF = 4 * CHBYTES;
static_assert(ZERO_OFF + 128 <= LDS_BYTES - 256, "conv LDS map");
__device__ __forceinline__ int crow(int r, int hi) { return (r & 3) + 8 * (r >> 2) + 4 * hi; }

__device__ __forceinline__ void conv_wave(const LAS unsigned char* zl, const LAS unsigned char* rl, const LAS unsigned char* zero, int nh, int lane, f32x16 (&acc)[2][2]) {
    const int n = lane & 31, hi = lane >> 5;
#pragma unroll
    for (int a = 0; a < 2; ++a)
#pragma unroll
        for (int b = 0; b < 2; ++b) acc[a][b] = f32x16{};
    const int dlo = nh ? -63 : -64, dhi = nh ? 64 : 63;
    const LAS unsigned char* ap = rl + 2 * (8 * hi - 2 * n - 2 + ROFF) - 128 * dlo;
    const int zlane = ZPITCH * n + 16 * hi;
    for (int dl = dlo; dl <= dhi; ++dl, ap -= 128) {
        bf16x8 AE[4], AO[4];
#pragma unroll
        for (int kb = 0; kb < 4; ++kb) {
            const LAS unsigned* p = (const LAS unsigned*)(ap + 32 * kb);
            const unsigned d0 = p[0], d1 = p[1], d2 = p[2], d3 = p[3], d4 = p[4];
            u32x4 e = {d1, d2, d3, d4};
            u32x4 o = {__builtin_amdgcn_alignbit(d1, d0, 16), __builtin_amdgcn_alignbit(d2, d1, 16), __builtin_amdgcn_alignbit(d3, d2, 16), __builtin_amdgcn_alignbit(d4, d3, 16)};
            AE[kb] = *reinterpret_cast<bf16x8*>(&e); AO[kb] = *reinterpret_cast<bf16x8*>(&o);
        }
#pragma unroll
        for (int nt = 0; nt < 2; ++nt) {
            const int lo = 64 * nh + 32 * nt - dl;
            if (lo + 31 < 0 || lo > 127) continue;
            const int sb = lo + n; const bool ok = (unsigned)sb < 128u;
            const LAS unsigned char* bp = ok ? zl + ZPITCH * lo + zlane : zero;
#pragma unroll
            for (int kb = 0; kb < 4; ++kb) {
                const bf16x8 b = *(const LAS bf16x8*)(bp + 32 * kb);
                acc[nt][0] = __builtin_amdgcn_mfma_f32_32x32x16_bf16(AE[kb], b, acc[nt][0], 0, 0, 0);
                acc[nt][1] = __builtin_amdgcn_mfma_f32_32x32x16_bf16(AO[kb], b, acc[nt][1], 0, 0, 0);
            }
        }
    }
}
}

__device__ __forceinline__ void phase_longconv_mfma(const Ctx& F, const bf16* XV, bf16* ZC, const bf16* RG, const float* fpart, const float* skip) {
    using namespace hconv;
    const int chs = F.wave >> 1, nh = F.wave & 1, n = F.lane & 31, hi = F.lane >> 5;
    LAS unsigned char* zl = F.lds + chs * CHBYTES; LAS unsigned char* rl = zl + ZBYTES; LAS unsigned char* zero = F.lds + ZERO_OFF;
    if (F.tid < 32) ((LAS unsigned*)zero)[F.tid] = 0u;
    for (int grp = F.bid; grp < D / 4; grp += F.G) {
        const int c0 = grp * 4, c = c0 + chs;
        for (int q = F.tid; q < 4 * 1024; q += NTHREADS) { const int cc = q >> 10, qq = q & 1023;
            const v4u v = *(const v4u*)(XV + (size_t)(2 * D + c0 + cc) * R + qq * 8);
            *(LAS v4u*)(F.lds + cc * CHBYTES + (qq >> 3) * ZPITCH + (qq & 7) * 16) = v; }
        for (int q = F.tid; q < 4 * (RLEN / 8); q += NTHREADS) { const int cc = q / (RLEN / 8), qq = q % (RLEN / 8);
            *(LAS v4u*)(F.lds + cc * CHBYTES + ZBYTES + qq * 16) = *(const v4u*)(RG + (size_t)(c0 + cc) * RLEN + qq * 8); }
        float s0, s1;
        { const float a = F.lane < 16 ? fpart[c * 16 + F.lane] : 0.f, b = F.lane < 16 ? fpart[(D + c) * 16 + F.lane] : 0.f;
          s0 = 1.0f / sqrtf(wave_sum(a) + EPS); s1 = 1.0f / sqrtf(wave_sum(b) + EPS); }
        const float sk0 = skip[c], sk1 = skip[D + c];
        __syncthreads();
        f32x16 acc[2][2];
        conv_wave(zl, rl, zero, nh, F.lane, acc);
        __syncthreads();
#pragma unroll
        for (int nt = 0; nt < 2; ++nt) { const int tb = 64 * nh + 32 * nt + n;
#pragma unroll
            for (int g = 0; g < 4; ++g) { LAS v4u* zp = (LAS v4u*)(zl + ZPITCH * tb + 2 * (16 * g + 8 * hi));
                const v4u vv = *zp; const v4u xx = *(const v4u*)(XV + (size_t)c * R + 64 * tb + 16 * g + 8 * hi);
                v4u w;
#pragma unroll
                for (int q = 0; q < 4; ++q) { const float ye = acc[nt][0][4 * g + q], yo = acc[nt][1][4 * g + q];
                    const float ze = bf2f(xx[q] & 0xffffu) * (s0 * ye + bf2f(vv[q] & 0xffffu) * sk0), zo = bf2f(xx[q] >> 16) * (s0 * yo + bf2f(vv[q] >> 16) * sk0);
                    w[q] = pk2(ze, zo); }
                *zp = w; } }
        for (int q = F.tid; q < 4 * (RLEN / 8); q += NTHREADS) { const int cc = q / (RLEN / 8), qq = q % (RLEN / 8);
            *(LAS v4u*)(F.lds + cc * CHBYTES + ZBYTES + qq * 16) = *(const v4u*)(RG + (size_t)(D + c0 + cc) * RLEN + qq * 8); }
        __syncthreads();
        conv_wave(zl, rl, zero, nh, F.lane, acc);
#pragma unroll
        for (int nt = 0; nt < 2; ++nt) { const int tb = 64 * nh + 32 * nt + n;
#pragma unroll
            for (int g = 0; g < 4; ++g) { const v4u vv = *(const LAS v4u*)(zl + ZPITCH * tb + 2 * (16 * g + 8 * hi));
                const v4u xx = *(const v4u*)(XV + (size_t)(D + c) * R + 64 * tb + 16 * g + 8 * hi);
                v4u w;
#pragma unroll
                for (int q = 0; q < 4; ++q) { const float ye = acc[nt][0][4 * g + q], yo = acc[nt][1][4 * g + q];
                    const float ze = bf2f(xx[q] & 0xffffu) * (s1 * ye + bf2f(vv[q] & 0xffffu) * sk1), zo = bf2f(xx[q] >> 16) * (s1 * yo + bf2f(vv[q] >> 16) * sk1);
                    w[q] = pk2(ze, zo); }
                *(v4u*)(ZC + (size_t)c * R + 64 * tb + 16 * g + 8 * hi) = w; } }
        __syncthreads();
    }
}
struct Args { const float* in[30]; float* out; unsigned char* ws; int ph_lo, ph_hi; };
constexpr int N_PHASES = 2 + 4 * 9 + 1;

__global__ void __launch_bounds__(NTHREADS, 2) fwd(Args args) {
    extern __shared__ __attribute__((aligned(16))) unsigned char lds_raw[];
    Ctx F;
    F.lds = (LAS unsigned char*)lds_raw;
    F.tid = threadIdx.x; F.lane = F.tid & 63; F.wave = __builtin_amdgcn_readfirstlane(F.tid >> 6);
    F.bid = blockIdx.x; F.G = gridDim.x; F.gw = F.bid * NWAVES + F.wave; F.NGW = F.G * NWAVES;
    unsigned char* ws = args.ws;
    volatile LAS unsigned* MISC = (volatile LAS unsigned*)(F.lds + MISC_OFF);
    if (F.tid < 32) MISC[F.tid] = 0u;
    __syncthreads();
    XcdBarrier bar; bar.bar = (unsigned*)(ws + WS_CTL) + CW_BAR; bar.x = 0; bar.st = nullptr;
#if MK_ONE_LAUNCH
    bar = xcd_barrier_post((unsigned*)(ws + WS_CTL) + CW_BAR, MISC + 8);
#endif
    const int lo = args.ph_lo, hi = args.ph_hi;
    int ph = 0;
#define PH_BEGIN if (ph >= lo && ph < hi) { int tid_ = threadIdx.x; asm volatile("" : "+v"(tid_)); F.tid = tid_; F.lane = tid_ & 63;
#if MK_ONE_LAUNCH
#define PH_END if (ph + 1 < hi) xcd_barrier(bar); } ++ph;
#else
#define PH_END } ++ph;
#endif
    const float* const* in = args.in;
    float* misc = (float*)(ws + WS_MISC);
    float* X = (float*)(ws + WS_X); bf16* H = (bf16*)(ws + WS_H); bf16* QKV = (bf16*)(ws + WS_QKV); bf16* KP = (bf16*)(ws + WS_KP); bf16* VP = (bf16*)(ws + WS_VP);
    bf16* O = (bf16*)(ws + WS_O); bf16* U = (bf16*)(ws + WS_U); bf16* UP = (bf16*)(ws + WS_UP); bf16* XV = (bf16*)(ws + WS_XV); bf16* ZC = (bf16*)(ws + WS_ZC);
    const float* rcos = misc + MO_RCOS; const float* rsin = misc + MO_RSIN;

    PH_BEGIN phase_prologue(F, in, ws); PH_END
    PH_BEGIN phase_filters(F, in, ws); PH_END

    for (int i = 0; i < DEPTH; ++i) {
        const int j = i >> 1; const bool is_attn = (i & 1) == 0, ctx_upd = i < 2, has_ctx = is_attn || ctx_upd;
        const int nrows1 = has_ctx ? R : S, nrows2 = ctx_upd ? R : S;
        const float* mod = misc + MO_MOD + i * NMODW; const float* modc = misc + MO_MODC + i * NMODW;
        PH_BEGIN phase_norm_mod(F, X, H, nrows1, in[6] + i * D, mod, mod + D, modc, modc + D); PH_END
        PH_BEGIN { const int N = is_attn ? AW : HW;
            pg8::Gemm g{H, is_attn ? (const bf16*)(ws + WS_WAIN) + (size_t)j * AW * D : (const bf16*)(ws + WS_WHIN) + (size_t)j * HW * D, nrows1, N, D};
            pg8::StaticOrder So; So.init(nrows1, N, F.G, F.bid);
            pg8::EpiBf16<0> E{is_attn ? QKV : UP, N, is_attn ? nullptr : in[14] + j * HW};
            pg8::gemm_phase<pg8::EpiBf16<0>, pg8::StaticOrder, PG8_ALIGN, PG8_SP2>(F.lds, g, So, E, F.tid); } PH_END
        if (is_attn) {
            PH_BEGIN phase_kprep(F, QKV, KP, VP, in[12] + j * HD, rcos, rsin); PH_END
            PH_BEGIN phase_attn(F, QKV, KP, VP, O, ctx_upd, in[10] + j * 8, in[11] + j * HD, rcos, rsin); PH_END
            ++ph;
        } else {
            PH_BEGIN phase_shortconv(F, UP, XV, in[15] + (size_t)j * 3 * HW, in[16] + j * HW, nrows2); PH_END
            PH_BEGIN phase_longconv_mfma(F, XV, ZC, (const bf16*)(ws + WS_FILT) + (size_t)j * 4096 * 8320, misc + MO_FPART + j * 4096 * 16, in[24] + j * 2 * D);
                if (ctx_upd) { __syncthreads(); phase_longconv_naive(F, XV, ZC, (const float*)(ws + WS_FILTC), (const float*)(ws + WS_FILTC), misc + MO_FPART + j * 4096 * 16, misc + MO_FPARTC, in[24] + j * 2 * D, true, false); } PH_END
            PH_BEGIN phase_transpose_zc(F, ZC, O, nrows2); PH_END
        }
        PH_BEGIN { pg8::Gemm g{O, is_attn ? (const bf16*)(ws + WS_WAOUT) + (size_t)j * D * D : (const bf16*)(ws + WS_WHOUT) + (size_t)j * D * D, nrows2, D, D};
            pg8::StaticOrder So; So.init(nrows2, D, F.G, F.bid);
            pg8::EpiResGate E{X, D, is_attn ? nullptr : in[26] + j * D, mod + 2 * D, modc + 2 * D, S / 256};
            pg8::gemm_phase<pg8::EpiResGate, pg8::StaticOrder, PG8_ALIGN, PG8_SP2>(F.lds, g, So, E, F.tid); } PH_END
        PH_BEGIN phase_norm_mod(F, X, H, nrows2, in[7] + i * D, mod + 3 * D, mod + 4 * D, modc + 3 * D, modc + 4 * D); PH_END
        PH_BEGIN { pg8::Gemm g{H, (const bf16*)(ws + WS_WM1) + (size_t)i * FF * D, nrows2, FF, D}; pg8::StaticOrder So; So.init(nrows2, FF, F.G, F.bid);
            pg8::EpiBf16<1> E{U, FF, nullptr};
            pg8::gemm_phase<pg8::EpiBf16<1>, pg8::StaticOrder, PG8_ALIGN, PG8_SP2>(F.lds, g, So, E, F.tid); } PH_END
        PH_BEGIN { pg8::Gemm g{U, (const bf16*)(ws + WS_WM2) + (size_t)i * D * FF, nrows2, D, FF}; pg8::StaticOrder So; So.init(nrows2, D, F.G, F.bid);
            pg8::EpiResGate E{X, D, nullptr, mod + 5 * D, modc + 5 * D, S / 256};
            pg8::gemm_phase<pg8::EpiResGate, pg8::StaticOrder, PG8_ALIGN, PG8_SP2>(F.lds, g, So, E, F.tid); } PH_END
    }
    PH_BEGIN phase_final_norm(F, X, args.out, in[29]); PH_END
#undef PH_BEGIN
#undef PH_END
}

extern "C" void kernel_launch(void* const* d_in, const int* in_sizes, int n_in, void* d_out, int out_size, void* d_ws, size_t ws_size, hipStream_t stream) {
    static int grid = 0;
    if (grid == 0) {
        if (n_in != 30 || out_size != S * D || ws_size < WS_END) { fprintf(stderr, "kernel_launch: unexpected shapes: n_in %d out %d ws %zu (need %zu)\n", n_in, out_size, ws_size, (size_t)WS_END); grid = -1; return; }
        int dev = 0, cus = 0, per_cu = 0;
        if (hipGetDevice(&dev) != hipSuccess || hipDeviceGetAttribute(&cus, hipDeviceAttributeMultiprocessorCount, dev) != hipSuccess) { grid = -1; return; }
        if (hipFuncSetAttribute((const void*)fwd, hipFuncAttributeMaxDynamicSharedMemorySize, LDS_BYTES) != hipSuccess) { fprintf(stderr, "kernel_launch: hipFuncSetAttribute failed\n"); grid = -1; return; }
        if (hipOccupancyMaxActiveBlocksPerMultiprocessor(&per_cu, (const void*)fwd, NTHREADS, LDS_BYTES) != hipSuccess || per_cu < 1)
            fprintf(stderr, "kernel_launch: occupancy query reports %d workgroups per CU\n", per_cu);
        (void)hipGetLastError();
        grid = cus;
    }
    if (grid < 0) return;
    (void)hipMemsetAsync((char*)d_ws + WS_CTL, 0, CTL_ZERO_BYTES, stream);
    Args a{};
    for (int i = 0; i < 30; ++i) a.in[i] = (const float*)d_in[i];
    a.out = (float*)d_out; a.ws = (unsigned char*)d_ws;
#if MK_ONE_LAUNCH
    a.ph_lo = 0; a.ph_hi = N_PHASES;
    hipLaunchKernelGGL(fwd, dim3(grid), dim3(NTHREADS), LDS_BYTES, stream, a);
#else
    for (int p = 0; p < N_PHASES; ++p) { a.ph_lo = p; a.ph_hi = p + 1; hipLaunchKernelGGL(fwd, dim3(grid), dim3(NTHREADS), LDS_BYTES, stream, a); }
#endif
    const hipError_t le = hipPeekAtLastError();
    if (le != hipSuccess) fprintf(stderr, "kernel_launch: launch failed: %s\n", hipGetErrorName(le));
}
```

```cpp
#include <hip/hip_runtime.h>
#include <cstdio>
#include <cstdint>
#define MK_ONE_LAUNCH 1
namespace pg8 {
#define PG8_LAS __attribute__((address_space(3)))
typedef unsigned short bf16_t;
typedef short bf16x8 __attribute__((ext_vector_type(8)));
typedef float f32x4 __attribute__((ext_vector_type(4)));
typedef unsigned u32x4 __attribute__((ext_vector_type(4)));
constexpr int BM = 256, BK = 64, HALF = 128, HTB = HALF * BK * 2  , STAGE_BYTES = 8 * HTB, NXCD = 8, WGM = 8;

__host__ __device__ __forceinline__ int lds_byte(int r, int c) { const int st = (r >> 4) * 2 + (c >> 5), rr = r & 15, cc = c & 31, ob = rr * 64 + cc * 2; return st * 1024 + (ob ^ (((ob >> 9) & 1) << 5)); }
__host__ __device__ __forceinline__ void stage_rc(int b, int& R, int& C) { const int st = b / 1024, sb = b % 1024, swz = sb ^ (((sb >> 9) & 1) << 5); R = (st >> 1) * 16 + swz / 64; C = (st & 1) * 32 + (swz % 64) / 2; }
__host__ __device__ __forceinline__ int perm32(int rho) { const int n = rho >> 4, i = rho & 15; return 8 * (i >> 2) + 4 * n + (i & 3); }

struct Unit { int pm, pn; };
struct Gemm { const bf16_t* A; const bf16_t* Bt; int M, N, K; };

struct StaticOrder {
    int nM, nN, nwg, G, c;
    __host__ __device__ void init(int M, int N, int G_, int c_) { nM = M / BM; nN = N / BM; nwg = nM * nN; G = G_; c = c_; }
    __host__ __device__ bool next(int i, Unit& u) const {
        const long L = (long)i * G + c; if (L >= nwg) return false;
        int wgid = (int)L; { const int q = nwg / NXCD, r = nwg % NXCD, xcd = wgid % NXCD, off = wgid / NXCD; wgid = (xcd < r ? xcd * (q + 1) : r * (q + 1) + (xcd - r) * q) + off; }
        const int nig = WGM * nN, gid = wgid / nig, fm = gid * WGM, gsz = (nM - fm) < WGM ? (nM - fm) : WGM;
        u.pm = fm + ((wgid % nig) % gsz); u.pn = (wgid % nig) / gsz; return true;
    }
    __device__ __forceinline__ void a_ready(const Unit&) const {}
    __device__ __forceinline__ void done(const Unit&) const {}
};

__device__ __forceinline__ unsigned cvt_pk_bf16(float lo, float hi) { unsigned r; asm volatile("v_cvt_pk_bf16_f32 %0, %1, %2" : "=v"(r) : "v"(lo), "v"(hi)); return r; }

template <int ACT> struct EpiBf16 {
    static constexpr bool PERM = true, AFTER_DRAIN = false;
    bf16_t* O; int ldc; const float* bias;
    __device__ __forceinline__ void operator()(const f32x4 (&acc)[2][2][4][2], const Unit& u, int wr, int wc, int fr, int fq) const {
        const int row0 = u.pm * BM + wr * 64 + fr; const int col0 = u.pn * BM + wc * 32 + 8 * fq;
        f32x4 bv[2][2];
#pragma unroll
        for (int bj = 0; bj < 2; ++bj)
#pragma unroll
            for (int n = 0; n < 2; ++n) bv[bj][n] = bias ? *(const f32x4*)(bias + col0 + bj * HALF + 4 * n) : (f32x4){0.f, 0.f, 0.f, 0.f};
#pragma unroll
        for (int ai = 0; ai < 2; ++ai)
#pragma unroll
            for (int m = 0; m < 4; ++m) { bf16_t* rowp = O + (size_t)(row0 + ai * HALF + m * 16) * ldc + col0;
#pragma unroll
                for (int bj = 0; bj < 2; ++bj) { f32x4 v0 = acc[ai][bj][m][0] + bv[bj][0], v1 = acc[ai][bj][m][1] + bv[bj][1];
                    if (ACT == 1) {
#pragma unroll
                        for (int j = 0; j < 4; ++j) { const float a = fmaxf(v0[j], 0.f), b = fmaxf(v1[j], 0.f); v0[j] = a * a; v1[j] = b * b; } }
                    u32x4 w; w.x = cvt_pk_bf16(v0[0], v0[1]); w.y = cvt_pk_bf16(v0[2], v0[3]); w.z = cvt_pk_bf16(v1[0], v1[1]); w.w = cvt_pk_bf16(v1[2], v1[3]);
                    *(u32x4*)(rowp + bj * HALF) = w; } }
    }
};
struct EpiResGate {
    static constexpr bool PERM = false, AFTER_DRAIN = false;
    float* X; int ldc; const float* bias; const float* gate_lat; const float* gate_ctx; int ctx_pm;
    __device__ __forceinline__ void operator()(const f32x4 (&acc)[2][2][4][2], const Unit& u, int wr, int wc, int fr, int fq) const {
        const int row0 = u.pm * BM + wr * 64 + fr, col0 = u.pn * BM + wc * 32 + 4 * fq;
        const float* gate = (u.pm >= ctx_pm) ? gate_ctx : gate_lat;
        f32x4 bv[2][2], gv[2][2];
#pragma unroll
        for (int bj = 0; bj < 2; ++bj)
#pragma unroll
            for (int n = 0; n < 2; ++n) { bv[bj][n] = bias ? *(const f32x4*)(bias + col0 + bj * HALF + n * 16) : (f32x4){0.f, 0.f, 0.f, 0.f};
                gv[bj][n] = *(const f32x4*)(gate + col0 + bj * HALF + n * 16); }
#pragma unroll
        for (int ai = 0; ai < 2; ++ai)
#pragma unroll
            for (int m = 0; m < 4; ++m) { float* rowp = X + (size_t)(row0 + ai * HALF + m * 16) * ldc + col0;
#pragma unroll
                for (int bj = 0; bj < 2; ++bj)
#pragma unroll
                    for (int n = 0; n < 2; ++n) { f32x4* p = (f32x4*)(rowp + bj * HALF + n * 16); const f32x4 old = *p; *p = old + gv[bj][n] * (acc[ai][bj][m][n] + bv[bj][n]); } }
    }
};

template <class Epi, class Sched, bool ALIGN_EPI = false, bool SP2 = false>
__device__ __forceinline__ void gemm_phase(PG8_LAS unsigned char* lds, const Gemm g, const Sched& S, const Epi& E, const int tid) {
    const int wid = __builtin_amdgcn_readfirstlane(tid >> 6), lane = tid & 63, wr = wid >> 2, wc = wid & 3, fr = lane & 15, fq = lane >> 4;
    const int K = g.K, nt = K / BK;
    unsigned voffA[2], voffB[2];
#pragma unroll
    for (int i = 0; i < 2; ++i) { int R, C; stage_rc(tid * 16 + i * 8192, R, C); const int Rb = Epi::PERM ? ((R & ~31) + perm32(R & 31)) : R;
        voffA[i] = (unsigned)(R * K + C) * 2u; voffB[i] = (unsigned)(Rb * K + C) * 2u; }
    const size_t kstep = (size_t)(BK * 2);
    const size_t hstep = (size_t)HALF * K * 2;
    const size_t tstep = 2 * hstep;
    const unsigned ldsw = (unsigned)wid * 1024u;
    const int aoff = lds_byte(wr * 64 + fr, fq * 8), boff = lds_byte(wc * 32 + fr, fq * 8);
#define PG8_SA(b, h) (((b) * 2 + (h)) * HTB)
#define PG8_SB(b, h) ((4 + (b) * 2 + (h)) * HTB)
#define PG8_STAGE(bufoff, gbase, voff) do { _Pragma("unroll") for (int _i = 0; _i < 2; ++_i) \
        __builtin_amdgcn_global_load_lds((const unsigned*)((const char*)(gbase) + (voff)[_i]), (PG8_LAS unsigned*)(lds + (bufoff) + ldsw + _i * 8192), 16, 0, 0); } while (0)
#define PG8_LDA(dst, b, h) do { _Pragma("unroll") for (int m = 0; m < 4; ++m) _Pragma("unroll") for (int k = 0; k < 2; ++k) dst[m][k] = *(const PG8_LAS bf16x8*)(lds + PG8_SA(b, h) + aoff + m * 2048 + k * 1024); } while (0)
#define PG8_LDB(dst, b, h) do { _Pragma("unroll") for (int n = 0; n < 2; ++n) _Pragma("unroll") for (int k = 0; k < 2; ++k) dst[n][k] = *(const PG8_LAS bf16x8*)(lds + PG8_SB(b, h) + boff + n * 2048 + k * 1024); } while (0)
#define PG8_MMA(ai, bj, At, Bt) do { __builtin_amdgcn_s_setprio(1); _Pragma("unroll") for (int m = 0; m < 4; ++m) _Pragma("unroll") for (int n = 0; n < 2; ++n) _Pragma("unroll") for (int k = 0; k < 2; ++k) \
        acc[ai][bj][m][n] = __builtin_amdgcn_mfma_f32_16x16x32_bf16(Bt[n][k], At[m][k], acc[ai][bj][m][n], 0, 0, 0); __builtin_amdgcn_s_setprio(0); } while (0)
#define PG8_WAIT_V(n) asm volatile("s_waitcnt vmcnt(" #n ")" ::: "memory")
#define PG8_WAIT_L(n) asm volatile("s_waitcnt lgkmcnt(" #n ")" ::: "memory")
#define PG8_BAR __builtin_amdgcn_s_barrier()
#define PG8_SCHED __builtin_amdgcn_sched_barrier(0)
    Unit cur, nxt; int ui = 0;
    if (!S.next(0, cur)) return;
    f32x4 acc[2][2][4][2];
#pragma unroll
    for (int a = 0; a < 2; ++a)
#pragma unroll
        for (int b = 0; b < 2; ++b)
#pragma unroll
            for (int m = 0; m < 4; ++m)
#pragma unroll
                for (int n = 0; n < 2; ++n) acc[a][b][m][n] = (f32x4){0.f, 0.f, 0.f, 0.f};
    bf16x8 At[4][2], B0[2][2], B1[2][2];
    const char* cA = (const char*)g.A + (size_t)cur.pm * tstep; const char* cB = (const char*)g.Bt + (size_t)cur.pn * tstep;
    S.a_ready(cur);
    if constexpr (SP2) {
        PG8_STAGE(PG8_SB(0, 0), cB, voffB); PG8_STAGE(PG8_SB(0, 1), cB + hstep, voffB); PG8_STAGE(PG8_SA(0, 0), cA, voffA); PG8_STAGE(PG8_SA(0, 1), cA + hstep, voffA);
        if (wr == 1) PG8_BAR;
        PG8_WAIT_V(2); PG8_BAR;
        PG8_STAGE(PG8_SB(1, 0), cB + kstep, voffB); PG8_STAGE(PG8_SA(1, 0), cA + kstep, voffA); PG8_STAGE(PG8_SB(1, 1), cB + hstep + kstep, voffB);
        PG8_WAIT_V(6); PG8_BAR;
    } else {
        PG8_STAGE(PG8_SB(0, 0), cB, voffB); PG8_STAGE(PG8_SA(0, 0), cA, voffA); PG8_STAGE(PG8_SB(0, 1), cB + hstep, voffB); PG8_STAGE(PG8_SA(0, 1), cA + hstep, voffA);
        if (wr == 1) PG8_BAR;
        PG8_WAIT_V(4); PG8_BAR;
        PG8_STAGE(PG8_SB(1, 0), cB + kstep, voffB); PG8_STAGE(PG8_SA(1, 0), cA + kstep, voffA); PG8_STAGE(PG8_SB(1, 1), cB + hstep + kstep, voffB);
        PG8_WAIT_V(6); PG8_BAR;
    }
    for (;;) {
        const bool has_next = S.next(ui + 1, nxt);
        const char* nA = has_next ? (const char*)g.A + (size_t)nxt.pm * tstep : cA; const char* nB = has_next ? (const char*)g.Bt + (size_t)nxt.pn * tstep : cB;
        for (int t = 0; t < nt; t += 2) {
            const bool last = (t == nt - 2);
            const char* a1 = cA + (size_t)(t + 1) * kstep;
            const char* a2 = last ? nA : cA + (size_t)(t + 2) * kstep; const char* b2 = last ? nB : cB + (size_t)(t + 2) * kstep;
            const char* a3 = a2 + kstep; const char* b3 = b2 + kstep;
            if (last && has_next) S.a_ready(nxt);
            if constexpr (SP2) {
            PG8_LDB(B0, 0, 0); PG8_LDB(B1, 0, 1); PG8_SCHED; PG8_LDA(At, 0, 0); PG8_STAGE(PG8_SA(1, 1), a1 + hstep, voffA);
            PG8_WAIT_V(8); PG8_WAIT_L(0); PG8_BAR; PG8_MMA(0, 0, At, B0); PG8_MMA(0, 1, At, B1); PG8_BAR; PG8_SCHED;
            PG8_LDA(At, 0, 1); PG8_STAGE(PG8_SB(0, 0), b2, voffB); PG8_STAGE(PG8_SB(0, 1), b2 + hstep, voffB); PG8_STAGE(PG8_SA(0, 0), a2, voffA);
            PG8_WAIT_V(8); PG8_WAIT_L(0); PG8_BAR; PG8_MMA(1, 0, At, B0); PG8_MMA(1, 1, At, B1); PG8_BAR; PG8_SCHED;
            PG8_LDB(B0, 1, 0); PG8_LDB(B1, 1, 1); PG8_SCHED; PG8_LDA(At, 1, 0); PG8_STAGE(PG8_SA(0, 1), a2 + hstep, voffA);
            PG8_WAIT_V(8); PG8_WAIT_L(0); PG8_BAR; PG8_MMA(0, 0, At, B0); PG8_MMA(0, 1, At, B1); PG8_BAR; PG8_SCHED;
            PG8_LDA(At, 1, 1); PG8_STAGE(PG8_SB(1, 0), b3, voffB); PG8_STAGE(PG8_SB(1, 1), b3 + hstep, voffB); PG8_STAGE(PG8_SA(1, 0), a3, voffA);
            PG8_WAIT_V(8); PG8_WAIT_L(0); PG8_BAR; PG8_MMA(1, 0, At, B0); PG8_MMA(1, 1, At, B1); PG8_BAR; PG8_SCHED;
            } else {
            PG8_LDB(B0, 0, 0); PG8_SCHED; PG8_LDA(At, 0, 0); PG8_STAGE(PG8_SA(1, 1), a1 + hstep, voffA);
            PG8_WAIT_L(8); PG8_BAR; PG8_WAIT_L(0); PG8_MMA(0, 0, At, B0); PG8_BAR; PG8_SCHED;
            PG8_LDB(B1, 0, 1); PG8_STAGE(PG8_SB(0, 0), b2, voffB);
            PG8_BAR; PG8_WAIT_L(0); PG8_MMA(0, 1, At, B1); PG8_BAR;
            PG8_LDA(At, 0, 1); PG8_STAGE(PG8_SA(0, 0), a2, voffA);
            PG8_BAR; PG8_WAIT_L(0); PG8_MMA(1, 0, At, B0); PG8_BAR; PG8_SCHED;
            PG8_STAGE(PG8_SB(0, 1), b2 + hstep, voffB);
            PG8_WAIT_V(6); PG8_BAR; PG8_MMA(1, 1, At, B1); PG8_BAR;
            PG8_LDB(B0, 1, 0); PG8_SCHED; PG8_LDA(At, 1, 0); PG8_STAGE(PG8_SA(0, 1), a2 + hstep, voffA);
            PG8_WAIT_L(8); PG8_BAR; PG8_WAIT_L(0); PG8_MMA(0, 0, At, B0); PG8_BAR; PG8_SCHED;
            PG8_LDB(B1, 1, 1); PG8_STAGE(PG8_SB(1, 0), b3, voffB);
            PG8_BAR; PG8_WAIT_L(0); PG8_MMA(0, 1, At, B1); PG8_BAR;
            PG8_LDA(At, 1, 1); PG8_STAGE(PG8_SA(1, 0), a3, voffA);
            PG8_BAR; PG8_WAIT_L(0); PG8_MMA(1, 0, At, B0); PG8_BAR; PG8_SCHED;
            PG8_STAGE(PG8_SB(1, 1), b3 + hstep, voffB);
            PG8_WAIT_V(6); PG8_BAR; PG8_MMA(1, 1, At, B1); PG8_BAR;
            }
        }
        if constexpr (ALIGN_EPI) { if (wr == 0) PG8_BAR; }
        if constexpr (!Epi::AFTER_DRAIN) { E(acc, cur, wr, wc, fr, fq); S.done(cur); }
        if (!has_next) break;
#pragma unroll
        for (int a = 0; a < 2; ++a)
#pragma unroll
            for (int b = 0; b < 2; ++b)
#pragma unroll
                for (int m = 0; m < 4; ++m)
#pragma unroll
                    for (int n = 0; n < 2; ++n) acc[a][b][m][n] = (f32x4){0.f, 0.f, 0.f, 0.f};
        cur = nxt; cA = nA; cB = nB; ++ui;
        if constexpr (ALIGN_EPI) { if (wr == 1) PG8_BAR; }
    }
    PG8_WAIT_V(0);
    if constexpr (!ALIGN_EPI) { if (wr == 0) PG8_BAR; }
    PG8_BAR;
    if constexpr (Epi::AFTER_DRAIN) { E.fused(acc, cur, wr, wc, fr, fq, lds, wid, lane); S.done(cur); }
#undef PG8_SA
#undef PG8_SB
#undef PG8_STAGE
#undef PG8_LDA
#undef PG8_LDB
#undef PG8_MMA
#undef PG8_WAIT_V
#undef PG8_WAIT_L
#undef PG8_BAR
#undef PG8_SCHED
}
}
#ifndef PG8_SP2
#define PG8_SP2 true
#endif
#ifndef PG8_ALIGN
#define PG8_ALIGN true
#endif
#ifndef MK_ONE_LAUNCH
#define MK_ONE_LAUNCH 0
#endif

constexpr int D = 2048, S = 8192, C = 256, R = S + C, DEPTH = 4, HD = 128;
constexpr int AW = 3072, HW = 6144, FF = 8192, NMODW = 6 * D;
constexpr float EPS = 1e-6f;
constexpr float QSCALE = 0.08838834764831845f;
constexpr float MIN_DECAY = -3.0701134573253944f, MAX_DECAY = -15.350567286626973f;
constexpr int NWAVES = 8, NTHREADS = 512;

constexpr size_t MiB = 1u << 20;
constexpr size_t WS_CTL = 0, CTL_ZERO_BYTES = 1 * MiB;
constexpr size_t WS_WAIN = 1 * MiB;
constexpr size_t WS_WAOUT = WS_WAIN + 24 * MiB;
constexpr size_t WS_WHIN = WS_WAOUT + 16 * MiB;
constexpr size_t WS_WHOUT = WS_WHIN + 48 * MiB;
constexpr size_t WS_WM1 = WS_WHOUT + 16 * MiB;
constexpr size_t WS_WM2 = WS_WM1 + 128 * MiB;
constexpr size_t WS_X = WS_WM2 + 128 * MiB;
constexpr size_t WS_H = WS_X + 66 * MiB;
constexpr size_t WS_QKV = WS_H + 33 * MiB;
constexpr size_t WS_KP = WS_QKV + 50 * MiB;
constexpr size_t WS_VP = WS_KP + 9 * MiB;
constexpr size_t WS_O = WS_VP + 9 * MiB;
constexpr size_t WS_U = WS_O + 33 * MiB;
constexpr size_t WS_UP = WS_U + 132 * MiB;
constexpr size_t WS_XV = WS_UP + 99 * MiB;
constexpr size_t WS_ZC = WS_XV + 99 * MiB;
constexpr size_t WS_FILT = WS_ZC + 33 * MiB;
constexpr size_t WS_FILTC = WS_FILT + 256 * MiB;
constexpr size_t WS_HID = WS_FILTC + 4 * MiB;
constexpr size_t WS_MISC = WS_HID + 5 * MiB;
constexpr size_t WS_END = WS_MISC + 2 * MiB;
constexpr int MO_MOD = 0, MO_MODC = MO_MOD + 4 * NMODW, MO_RCOS = MO_MODC + 4 * NMODW, MO_RSIN = MO_RCOS + 128 * 32, MO_FPART = MO_RSIN + 128 * 32, MO_FPARTC = MO_FPART + 2 * 4096 * 16, MO_END = MO_FPARTC + 4096;
static_assert((size_t)MO_END * 4 <= 2 * MiB, "misc");
constexpr int CW_BAR = 4096;

constexpr int LDS_BYTES = 147456;
constexpr int MISC_OFF = LDS_BYTES - 256;

#define GAS __attribute__((address_space(1)))
#define LAS __attribute__((address_space(3)))
typedef unsigned short bf16;
typedef unsigned v4u __attribute__((ext_vector_type(4)));
typedef unsigned v2u __attribute__((ext_vector_type(2)));
typedef float f32x4 __attribute__((ext_vector_type(4)));
#define LDS_WAIT() asm volatile("s_waitcnt lgkmcnt(0)" ::: "memory")
__device__ __forceinline__ unsigned f2bf(float f) { unsigned u = __builtin_bit_cast(unsigned, f); return (u + 0x7fffu + ((u >> 16) & 1u)) >> 16; }
__device__ __forceinline__ unsigned pk2(float lo, float hi) { return f2bf(lo) | (f2bf(hi) << 16); }
__device__ __forceinline__ float bf2f(unsigned b) { return __builtin_bit_cast(float, b << 16); }
__device__ __forceinline__ float xl_dpp_b1(float v) { return __builtin_bit_cast(float, __builtin_amdgcn_update_dpp(0, __builtin_bit_cast(int, v), 0xB1, 0xF, 0xF, true)); }
__device__ __forceinline__ float xl_dpp_4e(float v) { return __builtin_bit_cast(float, __builtin_amdgcn_update_dpp(0, __builtin_bit_cast(int, v), 0x4E, 0xF, 0xF, true)); }
__device__ __forceinline__ float xl_swz4(float v)  { return __builtin_bit_cast(float, __builtin_amdgcn_ds_swizzle(__builtin_bit_cast(int, v), 0x101F)); }
__device__ __forceinline__ float xl_swz8(float v)  { return __builtin_bit_cast(float, __builtin_amdgcn_ds_swizzle(__builtin_bit_cast(int, v), 0x201F)); }
__device__ __forceinline__ float xl_swz16(float v) { return __builtin_bit_cast(float, __builtin_amdgcn_ds_swizzle(__builtin_bit_cast(int, v), 0x401F)); }
__device__ __forceinline__ float xl_x32(float v) { const unsigned u = __builtin_bit_cast(unsigned, v); auto rr = __builtin_amdgcn_permlane32_swap(u, u, false, false);
    return __builtin_bit_cast(float, (unsigned)((threadIdx.x & 32) ? rr[0] : rr[1])); }
__device__ __forceinline__ float wave_sum(float v) {
    v += xl_dpp_b1(v); v += xl_dpp_4e(v); v += xl_swz4(v); v += xl_swz8(v); v += xl_swz16(v);
    { const unsigned u = __builtin_bit_cast(unsigned, v); auto rr = __builtin_amdgcn_permlane32_swap(u, u, false, false); v = __builtin_bit_cast(float, (unsigned)rr[0]) + __builtin_bit_cast(float, (unsigned)rr[1]); }
    return v;
}
__device__ __forceinline__ float wave_max(float v) {
    v = fmaxf(v, xl_dpp_b1(v)); v = fmaxf(v, xl_dpp_4e(v)); v = fmaxf(v, xl_swz4(v)); v = fmaxf(v, xl_swz8(v)); v = fmaxf(v, xl_swz16(v));
    { const unsigned u = __builtin_bit_cast(unsigned, v); auto rr = __builtin_amdgcn_permlane32_swap(u, u, false, false); v = fmaxf(__builtin_bit_cast(float, (unsigned)rr[0]), __builtin_bit_cast(float, (unsigned)rr[1])); }
    return v;
}
#define XB_SPIN_CAP_OVERRIDE 1
#define XB_TMO      128
#define XB_XCNT(j)  (256  + 64 * (j))
#define XB_XSUB(j)  (1280 + 64 * (j))
#define XB_XGEN(j)  (2304 + 64 * (j))
#define XB_TOP      3328
#define XB_TOPGEN   3392
#define XCD_BAR_WORDS 3456
#define XB_SPIN_CAP (1u << 22)

__device__ __forceinline__ unsigned xb_ld(unsigned* p)              { return __hip_atomic_load(p, __ATOMIC_RELAXED, __HIP_MEMORY_SCOPE_AGENT); }
__device__ __forceinline__ unsigned xb_add(unsigned* p, unsigned v) { return __hip_atomic_fetch_add(p, v, __ATOMIC_RELAXED, __HIP_MEMORY_SCOPE_AGENT); }
__device__ __forceinline__ unsigned xb_xcc_id() { return (unsigned)__builtin_amdgcn_s_getreg((3 << 11) | 20) & 0xFu; }
#define XB_SPIN(cond, bar) do { unsigned _sp = 0; while (cond) { __builtin_amdgcn_s_sleep(1); \
    if ((++_sp & 255u) == 0u) { if (xb_ld(&(bar)[XB_TMO])) break; if (_sp > XB_SPIN_CAP) { atomicAdd(&(bar)[XB_TMO], 1u); break; } } } } while (0)

struct XcdBarrier {
    unsigned* bar; unsigned x;
    volatile LAS unsigned* st;
};

__device__ __forceinline__ XcdBarrier xcd_barrier_post(unsigned* bar, volatile LAS unsigned* st) {
    XcdBarrier b; b.bar = bar; b.x = xb_xcc_id(); b.st = st;
    if (threadIdx.x == 0) (void)xb_add(&bar[XB_XCNT(b.x)], 1u);
    return b;
}
__device__ __forceinline__ void xcd_barrier_complete(unsigned* bar, unsigned x, unsigned& nloc, unsigned& nx) {
    const unsigned G = gridDim.x * gridDim.y * gridDim.z;
    unsigned sum, cnt, mine, sp = 0u;
    for (;;) {
        sum = 0u; cnt = 0u; mine = 0u;
#pragma unroll
        for (unsigned j = 0; j < 16; ++j) { const unsigned c = xb_ld(&bar[XB_XCNT(j)]); sum += c; cnt += (c > 0u) ? 1u : 0u; mine = (j == x) ? c : mine; }
        if (sum == G) break;
        __builtin_amdgcn_s_sleep(1);
        if ((++sp & 255u) == 0u) { if (xb_ld(&bar[XB_TMO])) break; if (sp > XB_SPIN_CAP) { atomicAdd(&bar[XB_TMO], 1u); break; } }
    }
    nloc = mine > 0u ? mine : 1u; nx = cnt > 0u ? cnt : 1u;
}

__device__ __forceinline__ void xcd_barrier(const XcdBarrier& b) {
    asm volatile("s_waitcnt vmcnt(0)" ::: "memory");
    __syncthreads();
    if (threadIdx.x == 0) {
        unsigned* bar = b.bar;
        __builtin_amdgcn_s_waitcnt(0);
        unsigned nloc = b.st[0], nx = b.st[1];
        if (nloc == 0u) { xcd_barrier_complete(bar, b.x, nloc, nx); b.st[0] = nloc; b.st[1] = nx; }
        const unsigned old = xb_add(&bar[XB_XSUB(b.x)], 1u);
        const unsigned gen = old / nloc;
        if (old + 1u == (gen + 1u) * nloc) {
            __builtin_amdgcn_fence(__ATOMIC_RELEASE, "agent");
            asm volatile("s_waitcnt vmcnt(0)" ::: "memory");
            const unsigned og = xb_add(&bar[XB_TOP], 1u);
            const unsigned tg = og / nx;
            if (og + 1u == (tg + 1u) * nx) xb_add(&bar[XB_TOPGEN], 1u);
            else XB_SPIN(xb_ld(&bar[XB_TOPGEN]) == tg, bar);
            __builtin_amdgcn_fence(__ATOMIC_ACQUIRE, "agent");
            xb_add(&bar[XB_XGEN(b.x)], 1u);
            asm volatile("s_waitcnt vmcnt(0)" ::: "memory");
        } else {
            XB_SPIN(xb_ld(&bar[XB_XGEN(b.x)]) == gen, bar);
            __builtin_amdgcn_fence(__ATOMIC_ACQUIRE, "agent");
            asm volatile("s_waitcnt vmcnt(0)" ::: "memory");
        }
    }
    __syncthreads();
}

__device__ __forceinline__ void p0_transpose_item(const float* W, int K, int N, bf16* WT, LAS float* scr, int item, int lane) {
    const int nblk = N / 32, kb = item / nblk, nb = item % nblk, k0 = 64 * kb, n0 = 32 * nb;
#pragma unroll 8
    for (int i = 0; i < 32; ++i) { const int kk = 2 * i + (lane >> 5); scr[kk * 33 + (lane & 31)] = W[(size_t)(k0 + kk) * N + n0 + (lane & 31)]; }
    LDS_WAIT();
    const int c = lane & 7;
#pragma unroll
    for (int j = 0; j < 4; ++j) { const int n = (lane >> 3) + 8 * j; const LAS float* s = scr + (8 * c) * 33 + n;
        v4u o; o.x = pk2(s[0 * 33], s[1 * 33]); o.y = pk2(s[2 * 33], s[3 * 33]); o.z = pk2(s[4 * 33], s[5 * 33]); o.w = pk2(s[6 * 33], s[7 * 33]);
        *(v4u*)(WT + (size_t)(n0 + n) * K + k0 + 8 * c) = o; }
    LDS_WAIT();
}
__device__ __forceinline__ void transpose_mat(const float* W, int K, int N, bf16* WT, LAS float* scr, int gw, int NGW, int lane) {
    const int items = (K / 64) * (N / 32);
    for (int it = gw; it < items; it += NGW) p0_transpose_item(W, K, N, WT, scr, it, lane);
}

struct Ctx {
    LAS unsigned char* lds; int tid, lane, wave, bid, G, gw, NGW;
};

__device__ __forceinline__ void phase_prologue(const Ctx& F, const float* const* in, unsigned char* ws) {
    float* misc = (float*)(ws + WS_MISC);
    LAS float* scr = (LAS float*)(F.lds + F.wave * 16384);
    for (int j = 0; j < 2; ++j) {
        transpose_mat(in[8] + (size_t)j * D * AW, D, AW, (bf16*)(ws + WS_WAIN) + (size_t)j * AW * D, scr, F.gw, F.NGW, F.lane);
        transpose_mat(in[9] + (size_t)j * D * D, D, D, (bf16*)(ws + WS_WAOUT) + (size_t)j * D * D, scr, F.gw, F.NGW, F.lane);
        transpose_mat(in[13] + (size_t)j * D * HW, D, HW, (bf16*)(ws + WS_WHIN) + (size_t)j * HW * D, scr, F.gw, F.NGW, F.lane);
        transpose_mat(in[25] + (size_t)j * D * D, D, D, (bf16*)(ws + WS_WHOUT) + (size_t)j * D * D, scr, F.gw, F.NGW, F.lane);
    }
    for (int i = 0; i < 4; ++i) {
        transpose_mat(in[27] + (size_t)i * D * FF, D, FF, (bf16*)(ws + WS_WM1) + (size_t)i * FF * D, scr, F.gw, F.NGW, F.lane);
        transpose_mat(in[28] + (size_t)i * FF * D, FF, D, (bf16*)(ws + WS_WM2) + (size_t)i * D * FF, scr, F.gw, F.NGW, F.lane);
    }
    {
        f32x4* X4 = (f32x4*)(ws + WS_X); const f32x4* x4 = (const f32x4*)in[0]; const f32x4* c4 = (const f32x4*)in[2];
        const int gt = F.bid * NTHREADS + F.tid, NGT = F.G * NTHREADS;
        for (int i = gt; i < S * D / 4; i += NGT) X4[i] = x4[i];
        for (int i = gt; i < C * D / 4; i += NGT) X4[S * D / 4 + i] = c4[i];
        for (int i = gt; i < 128 * 32; i += NGT) { const int pos = i >> 5, k = i & 31; const float inv = powf(10000.0f, -(float)(2 * k) / 64.0f); const float a = (float)pos * inv;
            misc[MO_RCOS + i] = cosf(a); misc[MO_RSIN + i] = sinf(a); }
    }
    {
        float* HID = (float*)(ws + WS_HID);
        for (int p = F.gw; p < 2 * S + C; p += F.NGW) {
            int j, i, n; if (p < 2 * S) { j = p >> 13; i = p & (S - 1); n = S; } else { j = 0; i = p - 2 * S; n = C; }
            const float tt = (float)i / (float)(n - 1);
            const float w = (6.283185307179586f * (float)i) / (float)n;
            const int k = (F.lane - 1) & 15; const float fk = 1e-4f + (float)k * ((15.0f - 1e-4f) / 15.0f);
            const float feat = F.lane == 0 ? tt : (F.lane <= 16 ? cosf(fk * w) : (F.lane <= 32 ? -sinf(fk * w) : 0.f));
            const float* w1 = in[17] + (size_t)j * 33 * 64; const float* w2 = in[20] + (size_t)j * 64 * 64;
            float a = in[18][j * 64 + F.lane];
            for (int f = 0; f < 33; ++f) a += __builtin_bit_cast(float, __builtin_amdgcn_readlane(__builtin_bit_cast(int, feat), f)) * w1[f * 64 + F.lane];
            const float h1 = sinf(in[19][j * 64 + F.lane] * a);
            float b = in[21][j * 64 + F.lane];
            for (int q = 0; q < 64; ++q) b += __builtin_bit_cast(float, __builtin_amdgcn_readlane(__builtin_bit_cast(int, h1), q)) * w2[q * 64 + F.lane];
            HID[(size_t)p * 64 + F.lane] = sinf(in[22][j * 64 + F.lane] * b);
        }
    }
    __syncthreads();
    {
        LAS float* s_c = (LAS float*)F.lds; LAS float* s_cc = s_c + D; LAS f32x4* red = (LAS f32x4*)(F.lds + 16384);
        for (int k = F.tid; k < D; k += NTHREADS) { const float a = in[1][k], b = in[3][k]; s_c[k] = a / (1.0f + expf(-a)); s_cc[k] = b / (1.0f + expf(-b)); }
        __syncthreads();
        for (int item = F.bid; item < 4 * 48; item += F.G) {
            const int layer = item / 48, chunk = item % 48, col4 = chunk * 64 + F.lane;
            const f32x4* Wp = (const f32x4*)(in[4] + (size_t)layer * D * NMODW) + col4;
            f32x4 a0 = {0.f, 0.f, 0.f, 0.f}, a1 = {0.f, 0.f, 0.f, 0.f};
#pragma unroll 8
            for (int k = F.wave; k < D; k += 8) { const f32x4 w = Wp[(size_t)k * (NMODW / 4)]; a0 += w * s_c[k]; a1 += w * s_cc[k]; }
            red[(F.wave * 2 + 0) * 64 + F.lane] = a0; red[(F.wave * 2 + 1) * 64 + F.lane] = a1;
            __syncthreads();
            if (F.wave < 2) { f32x4 s = {0.f, 0.f, 0.f, 0.f};
#pragma unroll
                for (int w = 0; w < 8; ++w) s += red[(w * 2 + F.wave) * 64 + F.lane];
                s += ((const f32x4*)(in[5] + (size_t)layer * NMODW))[col4];
                ((f32x4*)(misc + (F.wave ? MO_MODC : MO_MOD) + layer * NMODW))[col4] = s; }
            __syncthreads();
        }
    }
}

__device__ __forceinline__ void phase_filters(const Ctx& F, const float* const* in, unsigned char* ws) {
    float* misc = (float*)(ws + WS_MISC); const float* HID = (const float*)(ws + WS_HID);
    LAS float* red = (LAS float*)F.lds;
    {
        bf16* rg = (bf16*)(ws + WS_FILT);
        for (int q = F.bid * NTHREADS + F.tid; q < 2 * 4096 * 128; q += F.G * NTHREADS) { const int row = q >> 7, e = q & 127; rg[(size_t)row * 8320 + (e < 65 ? e : 8192 + e)] = 0; }
    }
    for (int item = F.bid; item < 2048 + 64; item += F.G) {
        const bool isctx = item >= 2048; int j, g, it, n;
        if (!isctx) { j = item >> 10; g = (item >> 4) & 63; it = item & 15; n = S; } else { j = 0; g = item - 2048; it = 0; n = C; }
        const int i = it * 512 + F.wave * 64 + F.lane; const bool act = i < n;
        const f32x4* hp = (const f32x4*)(HID + ((size_t)(isctx ? 2 * S : j * S) + (act ? i : 0)) * 64);
        float hr[64];
#pragma unroll
        for (int k = 0; k < 16; ++k) { const f32x4 t = hp[k]; hr[4 * k] = t.x; hr[4 * k + 1] = t.y; hr[4 * k + 2] = t.z; hr[4 * k + 3] = t.w; }
        const float offs = fabsf((float)(i - n / 2)) * (2.0f / (float)n);
        float* dstc = (float*)(ws + WS_FILTC); bf16* dstr = (bf16*)(ws + WS_FILT) + (size_t)j * 4096 * 8320;
        for (int o = 0; o < 64; ++o) {
            const int od = g * 64 + o; const float* w3p = in[23] + (size_t)j * 64 * 4096 + od;
            float a = 0.f;
#pragma unroll
            for (int k = 0; k < 64; ++k) a += hr[k] * w3p[(size_t)k * 4096];
            const int d = od & (D - 1); const float delta = fabsf(MIN_DECAY + (float)d * ((MAX_DECAY - MIN_DECAY) / (float)(D - 1)));
            const float h = a * expf(-offs * delta);
            if (act) { if (isctx) dstc[(size_t)od * C + i] = h; else dstr[(size_t)od * 8320 + 8256 - i] = (bf16)f2bf(h); }
            const float ss = wave_sum(act ? h * h : 0.f);
            if (F.lane == 0) red[F.wave * 64 + o] = ss;
        }
        __syncthreads();
        if (F.tid < 64) { float s = 0.f;
#pragma unroll
            for (int w = 0; w < 8; ++w) s += red[w * 64 + F.tid];
            const int od = g * 64 + F.tid;
            if (isctx) misc[MO_FPARTC + od] = s; else misc[MO_FPART + (j * 4096 + od) * 16 + it] = s; }
        __syncthreads();
    }
}

__device__ __forceinline__ void phase_norm_mod(const Ctx& F, const float* X, bf16* H, int nrows, const float* g, const float* shL, const float* scL, const float* shC, const float* scC) {
    for (int r = F.gw; r < nrows; r += F.NGW) {
        const f32x4* xr = (const f32x4*)(X + (size_t)r * D) + F.lane;
        const f32x4* sh = (const f32x4*)(r < S ? shL : shC) + F.lane; const f32x4* sc = (const f32x4*)(r < S ? scL : scC) + F.lane; const f32x4* g4 = (const f32x4*)g + F.lane;
        f32x4 v[8]; float ss = 0.f;
#pragma unroll
        for (int j = 0; j < 8; ++j) { v[j] = xr[64 * j]; ss += (v[j].x * v[j].x + v[j].y * v[j].y) + (v[j].z * v[j].z + v[j].w * v[j].w); }
        const float rstd = 1.0f / sqrtf(wave_sum(ss) * (1.0f / D) + EPS);
        v2u* o = (v2u*)(H + (size_t)r * D) + F.lane;
#pragma unroll
        for (int j = 0; j < 8; ++j) { const f32x4 y = (v[j] * rstd) * g4[64 * j]; const f32x4 z = y * (1.0f + sc[64 * j]) + sh[64 * j];
            v2u w; w.x = pk2(z.x, z.y); w.y = pk2(z.z, z.w); o[64 * j] = w; }
    }
}
__device__ __forceinline__ void phase_final_norm(const Ctx& F, const float* X, float* out, const float* g) {
    for (int r = F.gw; r < S; r += F.NGW) {
        const f32x4* xr = (const f32x4*)(X + (size_t)r * D) + F.lane; const f32x4* g4 = (const f32x4*)g + F.lane;
        f32x4 v[8]; float ss = 0.f;
#pragma unroll
        for (int j = 0; j < 8; ++j) { v[j] = xr[64 * j]; ss += (v[j].x * v[j].x + v[j].y * v[j].y) + (v[j].z * v[j].z + v[j].w * v[j].w); }
        const float rstd = 1.0f / sqrtf(wave_sum(ss) * (1.0f / D) + EPS);
        f32x4* o = (f32x4*)(out + (size_t)r * D) + F.lane;
#pragma unroll
        for (int j = 0; j < 8; ++j) o[64 * j] = (v[j] * rstd) * g4[64 * j];
    }
}

__device__ __forceinline__ void phase_kprep(const Ctx& F, const bf16* QKV, bf16* KP, bf16* VP, const float* knorm, const float* rcos, const float* rsin) {
    const int p = F.lane & 31, half = F.lane >> 5, da = half * 64 + p, db = da + 32;
    for (int r = F.gw; r < R; r += F.NGW) {
        const bool lat = r < S; const int kr = lat ? C + r : r - S;
        const int pos = half == 0 ? (r >> 6) : (r & 63);
        const float cs = lat ? rcos[pos * 32 + p] : 1.0f, sn = lat ? rsin[pos * 32 + p] : 0.0f;
#pragma unroll
        for (int h = 0; h < 4; ++h) {
            const bf16* src = QKV + (size_t)r * AW + 2048 + h * HD;
            float a = bf2f(src[da]), b = bf2f(src[db]);
            if (h >= 2) { const float ss = wave_sum(a * a + b * b); const float rstd = 1.0f / sqrtf(ss * (1.0f / HD) + EPS); a = a * rstd * knorm[da]; b = b * rstd * knorm[db]; }
            const float oa = a * cs - b * sn, ob = b * cs + a * sn;
            bf16* dst = KP + (size_t)kr * 512 + h * HD; dst[da] = (bf16)f2bf(oa); dst[db] = (bf16)f2bf(ob);
            ((unsigned*)(VP + (size_t)kr * 512 + h * HD))[F.lane] = ((const unsigned*)(QKV + (size_t)r * AW + 2560 + h * HD))[F.lane];
        }
    }
}

__device__ __forceinline__ void phase_attn_naive(const Ctx& F, const bf16* QKV, const bf16* KP, const bf16* VP, bf16* O, int nq, const float* sink, const float* qnorm, const float* rcos, const float* rsin) {
    LAS float* qs = (LAS float*)(F.lds + F.wave * 1024); LAS float* outs = qs + 128;
    const int p = F.lane & 31, half = F.lane >> 5, da = half * 64 + p, db = da + 32;
    const int ks = F.lane & 31, dh = F.lane >> 5;
    for (int it = F.gw; it < nq * 16; it += F.NGW) {
        const int r = it >> 4, h = it & 15; const bool lat = r < S;
        {
            const bf16* src = QKV + (size_t)r * AW + h * HD;
            float a = bf2f(src[da]), b = bf2f(src[db]);
            if (h >= 8) { const float ss = wave_sum(a * a + b * b); const float rstd = 1.0f / sqrtf(ss * (1.0f / HD) + EPS); a = a * rstd * qnorm[da]; b = b * rstd * qnorm[db]; }
            const int pos = half == 0 ? (r >> 6) : (r & 63);
            const float cs = lat ? rcos[pos * 32 + p] : 1.0f, sn = lat ? rsin[pos * 32 + p] : 0.0f;
            qs[da] = (a * cs - b * sn) * QSCALE; qs[db] = (b * cs + a * sn) * QSCALE;
            LDS_WAIT();
        }
        const int kvh = h < 8 ? (h >> 2) : 2 + ((h - 8) >> 2);
        int lo = 0, nl = 0;
        if (lat) { if (h < 8) { lo = r - 128 < 0 ? 0 : r - 128; const int hi = r + 128 > S - 1 ? S - 1 : r + 128; nl = hi - lo + 1; } else { lo = 0; nl = S; } }
        const int total = C + nl;
        float m = -1e30f, l = 0.f; float o[64];
#pragma unroll
        for (int d = 0; d < 64; ++d) o[d] = 0.f;
        if (h < 8 && ks == 0) { m = sink[h]; l = 1.0f; }
        const int nsteps = (total + 31) >> 5;
        for (int st = 0; st < nsteps; ++st) {
            const int kk = st * 32 + ks; const bool valid = kk < total; const int kc = valid ? kk : 0;
            const int krow = kc < C ? kc : C + lo + (kc - C);
            const v4u* kp = (const v4u*)(KP + (size_t)krow * 512 + kvh * HD + dh * 64); const v4u* vp = (const v4u*)(VP + (size_t)krow * 512 + kvh * HD + dh * 64);
            float s = 0.f;
#pragma unroll
            for (int c = 0; c < 8; ++c) { const v4u kv = kp[c]; const LAS f32x4* q4 = (const LAS f32x4*)(qs + dh * 64) + 2 * c; const f32x4 qa = q4[0], qb = q4[1];
                s += bf2f(kv.x & 0xffffu) * qa.x + bf2f(kv.x >> 16) * qa.y + bf2f(kv.y & 0xffffu) * qa.z + bf2f(kv.y >> 16) * qa.w
                   + bf2f(kv.z & 0xffffu) * qb.x + bf2f(kv.z >> 16) * qb.y + bf2f(kv.w & 0xffffu) * qb.z + bf2f(kv.w >> 16) * qb.w; }
            s += xl_x32(s);
            if (valid) {
                const float mn = fmaxf(m, s), al = expf(m - mn), pp = expf(s - mn); l = l * al + pp; m = mn;
#pragma unroll
                for (int c = 0; c < 8; ++c) { const v4u vv = vp[c];
                    o[8 * c + 0] = o[8 * c + 0] * al + pp * bf2f(vv.x & 0xffffu); o[8 * c + 1] = o[8 * c + 1] * al + pp * bf2f(vv.x >> 16);
                    o[8 * c + 2] = o[8 * c + 2] * al + pp * bf2f(vv.y & 0xffffu); o[8 * c + 3] = o[8 * c + 3] * al + pp * bf2f(vv.y >> 16);
                    o[8 * c + 4] = o[8 * c + 4] * al + pp * bf2f(vv.z & 0xffffu); o[8 * c + 5] = o[8 * c + 5] * al + pp * bf2f(vv.z >> 16);
                    o[8 * c + 6] = o[8 * c + 6] * al + pp * bf2f(vv.w & 0xffffu); o[8 * c + 7] = o[8 * c + 7] * al + pp * bf2f(vv.w >> 16); }
            }
        }
        const float M = wave_max(m), f = expf(m - M); const float L = 0.5f * wave_sum(l * f); const float rl = 1.0f / L;
#pragma unroll
        for (int d = 0; d < 64; ++d) { float sd = o[d] * f;
            sd += xl_dpp_b1(sd); sd += xl_dpp_4e(sd); sd += xl_swz4(sd); sd += xl_swz8(sd); sd += xl_swz16(sd);
            if (ks == 0) outs[dh * 64 + d] = sd * rl; }
        LDS_WAIT();
        ((unsigned*)(O + (size_t)r * D + h * HD))[F.lane] = pk2(outs[2 * F.lane], outs[2 * F.lane + 1]);
        LDS_WAIT();
    }
}

__device__ __forceinline__ void phase_shortconv(const Ctx& F, const bf16* UP, bf16* XV, const float* cw, const float* cb, int nrows) {
    LAS float* scr = (LAS float*)(F.lds + F.wave * 16896);
    const int ntb = nrows / 64;
    for (int it = F.gw; it < ntb * 96; it += F.NGW) {
        const int tb = it / 96, cbk = it % 96, r0 = tb * 64, c0 = cbk * 64;
        const int slo = tb < 128 ? 0 : S, shi = tb < 128 ? S : R;
        const int c = c0 + F.lane; const float w0 = cw[c], w1 = cw[HW + c], w2 = cw[2 * HW + c], bb = cb[c];
        float prev = (r0 - 1 >= slo) ? bf2f(UP[(size_t)(r0 - 1) * HW + c]) : 0.f; float cur = bf2f(UP[(size_t)r0 * HW + c]);
        for (int t = 0; t < 64; ++t) { const int r = r0 + t; const float nxt = (r + 1 < shi) ? bf2f(UP[(size_t)(r + 1) * HW + c]) : 0.f;
            scr[F.lane * 65 + t] = w0 * prev + w1 * cur + w2 * nxt + bb; prev = cur; cur = nxt; }
        LDS_WAIT();
        for (int cc = 0; cc < 64; ++cc) XV[(size_t)(c0 + cc) * R + r0 + F.lane] = (bf16)f2bf(scr[cc * 65 + F.lane]);
        LDS_WAIT();
    }
}

__device__ __forceinline__ void conv_naive(const LAS float* zs, const LAS float* Ts, int n, int tid, float (&acc)[16]) {
#pragma unroll
    for (int q = 0; q < 16; ++q) acc[q] = 0.f;
    const int half = n >> 1;
    for (int s = 0; s < n; ++s) { const float zv = zs[s];
#pragma unroll
        for (int q = 0; q < 16; ++q) { const int t = tid + 512 * q; const int idx = t - s + half; const bool ok = ((unsigned)idx < (unsigned)n) && (t < n);
            const float tv = Ts[ok ? idx : 0]; acc[q] += ok ? zv * tv : 0.f; } }
}
__device__ __forceinline__ void phase_longconv_naive(const Ctx& F, const bf16* XV, bf16* ZC, const float* FILT, const float* FILTC, const float* fpart, const float* fpartc, const float* skip, bool with_ctx, bool with_lat) {
    LAS float* zs = (LAS float*)F.lds; LAS float* Ts = zs + S; LAS float* z2 = Ts + S;
    const int nitems = with_ctx ? 2 * D : D;
    for (int it = (with_lat ? 0 : D) + F.bid; it < nitems; it += F.G) {
        const bool isctx = it >= D; const int c = isctx ? it - D : it, n = isctx ? C : S, base = isctx ? S : 0;
        const bf16* vsrc = XV + (size_t)(2 * D + c) * R + base; const bf16* x1 = XV + (size_t)c * R + base; const bf16* x2 = XV + (size_t)(D + c) * R + base;
        float s0, s1;
        if (isctx) { s0 = 1.0f / sqrtf(fpartc[c] + EPS); s1 = 1.0f / sqrtf(fpartc[D + c] + EPS); }
        else { float a = 0.f, b = 0.f; for (int k = 0; k < 16; ++k) { a += fpart[c * 16 + k]; b += fpart[(D + c) * 16 + k]; } s0 = 1.0f / sqrtf(a + EPS); s1 = 1.0f / sqrtf(b + EPS); }
        const float* T0 = isctx ? FILTC + (size_t)c * C : FILT + (size_t)c * S; const float* T1 = isctx ? FILTC + (size_t)(D + c) * C : FILT + (size_t)(D + c) * S;
        for (int t = F.tid; t < n; t += NTHREADS) { zs[t] = bf2f(vsrc[t]); Ts[t] = T0[t]; }
        __syncthreads();
        float acc[16];
        conv_naive(zs, Ts, n, F.tid, acc);
        const float sk0 = skip[c], sk1 = skip[D + c];
#pragma unroll
        for (int q = 0; q < 16; ++q) { const int t = F.tid + 512 * q; if (t < n) z2[t] = bf2f(x1[t]) * (s0 * acc[q] + zs[t] * sk0); }
        __syncthreads();
        for (int t = F.tid; t < n; t += NTHREADS) Ts[t] = T1[t];
        __syncthreads();
        conv_naive(z2, Ts, n, F.tid, acc);
#pragma unroll
        for (int q = 0; q < 16; ++q) { const int t = F.tid + 512 * q; if (t < n) ZC[(size_t)c * R + base + t] = (bf16)f2bf(bf2f(x2[t]) * (s1 * acc[q] + z2[t] * sk1)); }
        __syncthreads();
    }
}
__device__ __forceinline__ void phase_transpose_zc(const Ctx& F, const bf16* ZC, bf16* O, int nrows) {
    LAS float* scr = (LAS float*)(F.lds + F.wave * 16896);
    const int ntb = nrows / 64;
    for (int it = F.gw; it < ntb * 32; it += F.NGW) {
        const int tb = it / 32, cbk = it % 32, r0 = tb * 64, c0 = cbk * 64;
        for (int cc = 0; cc < 64; ++cc) scr[cc * 65 + F.lane] = bf2f(ZC[(size_t)(c0 + cc) * R + r0 + F.lane]);
        LDS_WAIT();
        for (int t = 0; t < 64; ++t) O[(size_t)(r0 + t) * D + c0 + F.lane] = (bf16)f2bf(scr[F.lane * 65 + t]);
        LDS_WAIT();
    }
}
namespace att {
using bf16x8 = __attribute__((ext_vector_type(8))) short;
using s16x4  = __attribute__((ext_vector_type(4))) short;
using f32x16 = __attribute__((ext_vector_type(16))) float;
using u32x4  = __attribute__((ext_vector_type(4))) unsigned;
constexpr int KVBLK = 64, LDQ = AW, LDK = 512, LDO = D;
constexpr float SCALE = 0.088388347648318440f;
constexpr float THR = 8.f;
constexpr int SDEPTH = 1;
constexpr int SHM_V = KVBLK * 128 * 2, SHM_K = KVBLK * 128 * 2, SHM_ATTN = 2 * SHM_V + 2 * SHM_K + 8 * 64 * 4;
#define KSWZ(row, colB) ((row) * 256 + ((colB) ^ (((row) & 7) << 4)))
#define SBAR() __builtin_amdgcn_sched_barrier(0)
__device__ __forceinline__ int crow(int r, int hi) { return (r & 3) + 8 * (r >> 2) + 4 * hi; }
__device__ __forceinline__ unsigned cvtpk(float lo, float hi) { unsigned r; asm volatile("v_cvt_pk_bf16_f32 %0, %1, %2" : "=v"(r) : "v"(lo), "v"(hi)); return r; }

__device__ __forceinline__ void partialSM(f32x16& p0, f32x16& p1, float& m_reg, float& mn, float& alpha) {
  constexpr float Cc = SCALE * 1.4426950408889634f;
  float pmax = p0[0]; for (int r = 1; r < 16; ++r) pmax = fmaxf(pmax, p0[r]); for (int r = 0; r < 16; ++r) pmax = fmaxf(pmax, p1[r]);
  { auto rr = __builtin_amdgcn_permlane32_swap(__float_as_uint(pmax), __float_as_uint(pmax), false, false);
    pmax = fmaxf(__uint_as_float(rr[0]), __uint_as_float(rr[1])); }
  if (__builtin_expect(__all(pmax - m_reg <= THR / SCALE), 1)) { mn = m_reg; alpha = 1.f; }
  else { mn = fmaxf(m_reg, pmax); alpha = __builtin_amdgcn_exp2f((m_reg - mn) * Cc); m_reg = mn; }
  float mnC = -mn * Cc;
  for (int r = 0; r < 16; ++r) p0[r] = fmaf(p0[r], Cc, mnC); for (int r = 0; r < 16; ++r) p1[r] = fmaf(p1[r], Cc, mnC);
  for (int r = 0; r < 16; ++r) p0[r] = __builtin_amdgcn_exp2f(p0[r]);
}
__device__ __forceinline__ void finishSM(f32x16& p0, f32x16& p1, float alpha, float& l_reg, bf16x8& pa0, bf16x8& pa1, bf16x8& pa2, bf16x8& pa3) {
  for (int r = 0; r < 16; ++r) p1[r] = __builtin_amdgcn_exp2f(p1[r]);
  float ps = 0; for (int r = 0; r < 16; ++r) ps += p0[r]; for (int r = 0; r < 16; ++r) ps += p1[r];
  { auto rr = __builtin_amdgcn_permlane32_swap(__float_as_uint(ps), __float_as_uint(ps), false, false);
    ps = __uint_as_float(rr[0]) + __uint_as_float(rr[1]); }
  l_reg = l_reg * alpha + ps;
#define PK4(P, BASE, OUT) do { unsigned a0 = cvtpk(P[BASE + 0], P[BASE + 1]), a1 = cvtpk(P[BASE + 2], P[BASE + 3]);   \
    unsigned b0 = cvtpk(P[BASE + 4], P[BASE + 5]), b1 = cvtpk(P[BASE + 6], P[BASE + 7]);                              \
    auto r0 = __builtin_amdgcn_permlane32_swap(a0, b0, false, false); auto r1 = __builtin_amdgcn_permlane32_swap(a1, b1, false, false); \
    u32x4 w = {r0[0], r1[0], r0[1], r1[1]}; OUT = *reinterpret_cast<bf16x8*>(&w); } while (0)
  PK4(p0, 0, pa0); PK4(p0, 8, pa1); PK4(p1, 0, pa2); PK4(p1, 8, pa3);
#undef PK4
}
__device__ __forceinline__ void qkt(f32x16& p0, f32x16& p1, const char* Ks, const bf16x8* qr, int r32, int hi) {
  p0 = f32x16{}; p1 = f32x16{};
  for (int d0 = 0; d0 < 8; ++d0) { int cb = (d0 * 16 + hi * 8) * 2;
    bf16x8 b0 = *reinterpret_cast<const bf16x8*>(Ks + KSWZ(r32, cb));
    bf16x8 b1 = *reinterpret_cast<const bf16x8*>(Ks + KSWZ(32 + r32, cb));
    p0 = __builtin_amdgcn_mfma_f32_32x32x16_bf16(b0, qr[d0], p0, 0, 0, 0);
    p1 = __builtin_amdgcn_mfma_f32_32x32x16_bf16(b1, qr[d0], p1, 0, 0, 0); }
}
__device__ __forceinline__ int v_st(int k, int c) { const int kk = (k & ~0xC) | ((k & 4) << 1) | ((k & 8) >> 1); return ((kk >> 3) * 4 + (c >> 5)) * 512 + ((kk & 7) * 32 + (c & 31)) * 2; }
__device__ __forceinline__ int v_rd_base(int lane) { return ((lane & 3) << 3) | (((lane >> 2) & 3) << 6) | (((lane >> 4) & 1) << 5) | (((lane >> 5) & 1) << 8); }
constexpr int v_rd_off(int d0, int ks, int half) { return d0 * 512 + ks * 4096 + half * 2048; }
template <int OFF> __device__ __forceinline__ s16x4 tr_read(int vb) {
  s16x4 r; asm volatile("ds_read_b64_tr_b16 %0, %1 offset:%2" : "=&v"(r) : "v"(vb), "i"(OFF) : "memory"); return r;
}
template <int D0> __device__ __forceinline__ void pv_one(f32x16& od, int vb, bf16x8 pa0, bf16x8 pa1, bf16x8 pa2, bf16x8 pa3) {
  const s16x4 l0 = tr_read<v_rd_off(D0, 0, 0)>(vb), h0 = tr_read<v_rd_off(D0, 0, 1)>(vb), l1 = tr_read<v_rd_off(D0, 1, 0)>(vb), h1 = tr_read<v_rd_off(D0, 1, 1)>(vb);
  const s16x4 l2 = tr_read<v_rd_off(D0, 2, 0)>(vb), h2 = tr_read<v_rd_off(D0, 2, 1)>(vb), l3 = tr_read<v_rd_off(D0, 3, 0)>(vb), h3 = tr_read<v_rd_off(D0, 3, 1)>(vb);
  asm volatile("s_waitcnt lgkmcnt(0)" ::: "memory"); SBAR();
#define PK(L, H) (bf16x8){L[0], L[1], L[2], L[3], H[0], H[1], H[2], H[3]}
  od = __builtin_amdgcn_mfma_f32_32x32x16_bf16(pa0, PK(l0, h0), od, 0, 0, 0);
  od = __builtin_amdgcn_mfma_f32_32x32x16_bf16(pa1, PK(l1, h1), od, 0, 0, 0);
  od = __builtin_amdgcn_mfma_f32_32x32x16_bf16(pa2, PK(l2, h2), od, 0, 0, 0);
  od = __builtin_amdgcn_mfma_f32_32x32x16_bf16(pa3, PK(l3, h3), od, 0, 0, 0);
#undef PK
}
__device__ __forceinline__ void pv_d0(f32x16* o, int vb, bf16x8 pa0, bf16x8 pa1, bf16x8 pa2, bf16x8 pa3) {
  pv_one<0>(o[0], vb, pa0, pa1, pa2, pa3); pv_one<1>(o[1], vb, pa0, pa1, pa2, pa3); pv_one<2>(o[2], vb, pa0, pa1, pa2, pa3); pv_one<3>(o[3], vb, pa0, pa1, pa2, pa3);
}

struct Unit {
    const bf16* Qb;
    const bf16* Kh;
    const bf16* Vh;
    bf16* Ob;
    int NT;
    int lat0;
    int i0;
    int windowed;
    int norm_q;
    float sink; int has_sink;
};

__device__ __forceinline__ void window_mask(f32x16& p0, f32x16& p1, int base, int hi) {
#pragma unroll
  for (int r = 0; r < 16; ++r) { const int d0 = base + crow(r, hi), d1 = d0 + 32;
    p0[r] = (d0 >= -128 && d0 <= 128) ? p0[r] : -__builtin_inff();
    p1[r] = (d1 >= -128 && d1 <= 128) ? p1[r] : -__builtin_inff(); }
}

__device__ __forceinline__ void attn_unit(const Unit u, const float* __restrict__ qn, const float* __restrict__ rcos, const float* __restrict__ rsin, char* lds, const int tid) {
  const int wid = tid >> 6, lane = tid & 63, r32 = lane & 31, hi = lane >> 5;
  char* V_lds = lds; char* K_lds = lds + 2 * SHM_V;
  float* wsx = (float*)(lds + 2 * SHM_V + 2 * SHM_K) + wid * 64; float* li_l = wsx; float* al_l = wsx + 32;
  float m_reg = u.has_sink ? u.sink * (1.0f / SCALE) : -1e30f, l_reg = u.has_sink ? 1.f : 0.f; f32x16 o[4] = {}; bf16x8 qr[8];
  const int qpos = u.i0 + wid * 32 + r32;
  {
    const bf16* Qw = u.Qb + (long)(wid * 32 + r32) * LDQ + hi * 8;
    float qf[8][8];
#pragma unroll
    for (int d0 = 0; d0 < 8; ++d0) { const u32x4 raw = *reinterpret_cast<const u32x4*>(Qw + d0 * 16);
#pragma unroll
      for (int e = 0; e < 4; ++e) { qf[d0][2 * e] = bf2f(raw[e] & 0xffffu); qf[d0][2 * e + 1] = bf2f(raw[e] >> 16); } }
    if (u.norm_q) { float ss = 0.f;
#pragma unroll
      for (int d0 = 0; d0 < 8; ++d0)
#pragma unroll
        for (int e = 0; e < 8; ++e) ss += qf[d0][e] * qf[d0][e];
      ss += xl_x32(ss);
      const float rstd = 1.0f / sqrtf(ss * (1.0f / 128.0f) + EPS);
#pragma unroll
      for (int d0 = 0; d0 < 8; ++d0) { const f32x4 g0 = *(const f32x4*)(qn + d0 * 16 + hi * 8), g1 = *(const f32x4*)(qn + d0 * 16 + hi * 8 + 4);
        qf[d0][0] *= rstd * g0.x; qf[d0][1] *= rstd * g0.y; qf[d0][2] *= rstd * g0.z; qf[d0][3] *= rstd * g0.w;
        qf[d0][4] *= rstd * g1.x; qf[d0][5] *= rstd * g1.y; qf[d0][6] *= rstd * g1.z; qf[d0][7] *= rstd * g1.w; } }
    if (u.i0 >= 0) {
#pragma unroll
      for (int hf = 0; hf < 2; ++hf) { const int pos = hf == 0 ? (qpos >> 6) : (qpos & 63);
#pragma unroll
        for (int dd = 0; dd < 2; ++dd) { const int pb = pos * 32 + dd * 16 + hi * 8;
          const f32x4 c0 = *(const f32x4*)(rcos + pb), c1 = *(const f32x4*)(rcos + pb + 4), s0 = *(const f32x4*)(rsin + pb), s1 = *(const f32x4*)(rsin + pb + 4);
          const float cs[8] = {c0.x, c0.y, c0.z, c0.w, c1.x, c1.y, c1.z, c1.w}, sn[8] = {s0.x, s0.y, s0.z, s0.w, s1.x, s1.y, s1.z, s1.w};
#pragma unroll
          for (int e = 0; e < 8; ++e) { const float a = qf[4 * hf + dd][e], b = qf[4 * hf + dd + 2][e];
            qf[4 * hf + dd][e] = a * cs[e] - b * sn[e]; qf[4 * hf + dd + 2][e] = b * cs[e] + a * sn[e]; } } } }
#pragma unroll
    for (int d0 = 0; d0 < 8; ++d0) { u32x4 w = {cvtpk(qf[d0][0], qf[d0][1]), cvtpk(qf[d0][2], qf[d0][3]), cvtpk(qf[d0][4], qf[d0][5]), cvtpk(qf[d0][6], qf[d0][7])}; qr[d0] = *reinterpret_cast<bf16x8*>(&w); }
  }
  const int sr = tid >> 4, sc = (tid & 15) * 8, vst0 = v_st(sr, sc), vst1 = v_st(32 + sr, sc);
  const int vb0 = (int)(uintptr_t)V_lds + v_rd_base(lane);
  const bf16* Kh = u.Kh; const bf16* Vh = u.Vh; const int lat0 = u.lat0;
  struct { bf16x8 vs0, vs1, ks0, ks1; } sr_[SDEPTH];
#define KOFF(t) (64 * (t) + ((t) >= 4 ? lat0 : 0))
#define SLOAD(i, k0) do { const long _k = (k0); sr_[i].vs0 = *reinterpret_cast<const bf16x8*>(&Vh[(_k + sr) * LDK + sc]); sr_[i].vs1 = *reinterpret_cast<const bf16x8*>(&Vh[(_k + 32 + sr) * LDK + sc]); \
    sr_[i].ks0 = *reinterpret_cast<const bf16x8*>(&Kh[(_k + sr) * LDK + sc]); sr_[i].ks1 = *reinterpret_cast<const bf16x8*>(&Kh[(_k + 32 + sr) * LDK + sc]); } while (0)
#define SWRITE(b, i) do { *(bf16x8*)(V_lds + (b) * SHM_V + vst0) = sr_[i].vs0;          \
    *(bf16x8*)(V_lds + (b) * SHM_V + vst1) = sr_[i].vs1; int kc = sc * 2;               \
    *(bf16x8*)(K_lds + (b) * SHM_K + KSWZ(sr, kc)) = sr_[i].ks0;                       \
    *(bf16x8*)(K_lds + (b) * SHM_K + KSWZ(32 + sr, kc)) = sr_[i].ks1; } while (0)
#define SWAIT() do { if constexpr (SDEPTH == 2) asm volatile("s_waitcnt vmcnt(4)" ::: "memory"); else asm volatile("s_waitcnt vmcnt(0)" ::: "memory"); } while (0)
#define RESC(a) do { if (__any((a) < 1.f)) { if (hi == 0) al_l[r32] = (a); asm volatile("s_waitcnt lgkmcnt(0)" ::: "memory"); \
    for (int d = 0; d < 4; ++d) for (int r = 0; r < 16; ++r) o[d][r] *= al_l[crow(r, hi)]; } } while (0)
#define WMASK(P0, P1, t) do { if (u.windowed && (t) >= 4) { const int _b = KOFF(t) - C - qpos; if (__any(_b < -128 || _b + 63 > 128)) window_mask(P0, P1, _b, hi); } } while (0)
  f32x16 pA0, pA1, pB0, pB1; float mnA, mnB, alA, alB; bf16x8 pa0, pa1, pa2, pa3; const int NT = u.NT;
  constexpr int SE = 0, SO = SDEPTH - 1;
  SLOAD(SE, KOFF(0)); asm volatile("s_waitcnt vmcnt(0)" ::: "memory"); SWRITE(0, SE); __syncthreads();
  qkt(pA0, pA1, K_lds, qr, r32, hi); WMASK(pA0, pA1, 0); partialSM(pA0, pA1, m_reg, mnA, alA);
  SLOAD(SO, KOFF(1)); if constexpr (SDEPTH == 2) { if (2 < NT) SLOAD(SE, KOFF(2)); }
  SWAIT(); SWRITE(1, SO); __syncthreads();
  for (int j = 1; j + 1 < NT; j += 2) {
    SBAR(); qkt(pB0, pB1, K_lds + SHM_K, qr, r32, hi);
    finishSM(pA0, pA1, alA, l_reg, pa0, pa1, pa2, pa3); SBAR();
    SLOAD(SO, KOFF(j + SDEPTH)); SBAR();
    pv_d0(o, vb0, pa0, pa1, pa2, pa3); WMASK(pB0, pB1, j); partialSM(pB0, pB1, m_reg, mnB, alB);
    __syncthreads(); SWAIT(); SWRITE(0, SE);
    RESC(alB); __syncthreads();
    SBAR(); qkt(pA0, pA1, K_lds, qr, r32, hi);
    finishSM(pB0, pB1, alB, l_reg, pa0, pa1, pa2, pa3); SBAR();
    if (SDEPTH == 1 || j + 3 < NT) SLOAD(SE, KOFF(j + 1 + SDEPTH)); SBAR();
    pv_d0(o, vb0 + (int)SHM_V, pa0, pa1, pa2, pa3); WMASK(pA0, pA1, j + 1); partialSM(pA0, pA1, m_reg, mnA, alA);
    __syncthreads(); SWAIT(); SWRITE(1, SO);
    RESC(alA); __syncthreads();
  }
  SBAR(); qkt(pB0, pB1, K_lds + SHM_K, qr, r32, hi);
  finishSM(pA0, pA1, alA, l_reg, pa0, pa1, pa2, pa3); SBAR();
  pv_d0(o, vb0, pa0, pa1, pa2, pa3); WMASK(pB0, pB1, NT - 1); partialSM(pB0, pB1, m_reg, mnB, alB);
  __syncthreads(); RESC(alB);
  finishSM(pB0, pB1, alB, l_reg, pa0, pa1, pa2, pa3); SBAR();
  pv_d0(o, vb0 + (int)SHM_V, pa0, pa1, pa2, pa3);
  if (hi == 0) li_l[r32] = l_reg; asm volatile("s_waitcnt lgkmcnt(0)" ::: "memory");
  float rli[16];
#pragma unroll
  for (int r = 0; r < 16; ++r) rli[r] = __builtin_amdgcn_rcpf(li_l[crow(r, hi)]);
  bf16* Ow = u.Ob + (long)(wid * 32) * LDO;
#pragma unroll
  for (int r = 0; r < 16; ++r) { const int orow = crow(r, hi);
#pragma unroll
    for (int d0 = 0; d0 < 4; ++d0) Ow[(long)orow * LDO + d0 * 32 + r32] = (bf16)f2bf(o[d0][r] * rli[r]); }
  __syncthreads();
#undef KOFF
#undef SLOAD
#undef SWRITE
#undef SWAIT
#undef RESC
#undef WMASK
}
#undef KSWZ
#undef SBAR
}

__device__ __forceinline__ void phase_attn(const Ctx& F, const bf16* QKV, const bf16* KP, const bf16* VP, bf16* O, bool ctx_out, const float* sink, const float* qnorm, const float* rcos, const float* rsin) {
    const int nunits = 256 + 256 + (ctx_out ? 16 : 0);
    for (int un = F.bid; un < nunits; un += F.G) {
        att::Unit u;
        int h, qb, isctx = 0;
        if (un < 256) { h = 8 + (un >> 5); qb = un & 31; }
        else if (un < 512) { h = (un - 256) >> 5; qb = un & 31; }
        else { h = un - 512; qb = 32; isctx = 1; }
        const int kvh = h < 8 ? (h >> 2) : 2 + ((h - 8) >> 2);
        const int row0 = qb * 256;
        u.Qb = QKV + (size_t)row0 * AW + h * HD; u.Kh = KP + kvh * HD; u.Vh = VP + kvh * HD; u.Ob = O + (size_t)row0 * D + h * HD;
        u.i0 = isctx ? -1 : row0; u.norm_q = h >= 8; u.has_sink = h < 8; u.sink = h < 8 ? sink[h] : 0.f;
        if (isctx) { u.NT = 4; u.lat0 = 0; u.windowed = 0; }
        else if (h >= 8) { u.NT = R / 64; u.lat0 = 0; u.windowed = 0; }
        else { const int l0 = row0 - 128 < 0 ? 0 : row0 - 128, l1 = row0 + 384 > S ? S : row0 + 384; u.lat0 = l0; u.NT = 4 + (l1 - l0) / 64; u.windowed = 1; }
        att::attn_unit(u, qnorm, rcos, rsin, (char*)F.lds, F.tid);
    }
}
namespace hconv {
using bf16x8 = __attribute__((ext_vector_type(8))) short;
using f32x16 = __attribute__((ext_vector_type(16))) float;
using u32x4  = __attribute__((ext_vector_type(4))) unsigned;
constexpr int RLEN = 8320, ROFF = 4160;
constexpr int ZPITCH = 144, ZBYTES = 128 * ZPITCH, RBYTES = RLEN * 2, CHBYTES = ZBYTES + RBYTES, ZERO_OFF = 4 * CHBYTES;
static_assert(ZERO_OFF + 128 <= LDS_BYTES - 256, "conv LDS map");
__device__ __forceinline__ int crow(int r, int hi) { return (r & 3) + 8 * (r >> 2) + 4 * hi; }

__device__ __forceinline__ void conv_wave(const LAS unsigned char* zl, const LAS unsigned char* rl, const LAS unsigned char* zero, int nh, int lane, f32x16 (&acc)[2][2]) {
    const int n = lane & 31, hi = lane >> 5;
#pragma unroll
    for (int a = 0; a < 2; ++a)
#pragma unroll
        for (int b = 0; b < 2; ++b) acc[a][b] = f32x16{};
    const int dlo = nh ? -63 : -64, dhi = nh ? 64 : 63;
    const LAS unsigned char* ap = rl + 2 * (8 * hi - 2 * n - 2 + ROFF) - 128 * dlo;
    const int zlane = ZPITCH * n + 16 * hi;
    for (int dl = dlo; dl <= dhi; ++dl, ap -= 128) {
        bf16x8 AE[4], AO[4];
#pragma unroll
        for (int kb = 0; kb < 4; ++kb) {
            const LAS unsigned* p = (const LAS unsigned*)(ap + 32 * kb);
            const unsigned d0 = p[0], d1 = p[1], d2 = p[2], d3 = p[3], d4 = p[4];
            u32x4 e = {d1, d2, d3, d4};
            u32x4 o = {__builtin_amdgcn_alignbit(d1, d0, 16), __builtin_amdgcn_alignbit(d2, d1, 16), __builtin_amdgcn_alignbit(d3, d2, 16), __builtin_amdgcn_alignbit(d4, d3, 16)};
            AE[kb] = *reinterpret_cast<bf16x8*>(&e); AO[kb] = *reinterpret_cast<bf16x8*>(&o);
        }
#pragma unroll
        for (int nt = 0; nt < 2; ++nt) {
            const int lo = 64 * nh + 32 * nt - dl;
            if (lo + 31 < 0 || lo > 127) continue;
            const int sb = lo + n; const bool ok = (unsigned)sb < 128u;
            const LAS unsigned char* bp = ok ? zl + ZPITCH * lo + zlane : zero;
#pragma unroll
            for (int kb = 0; kb < 4; ++kb) {
                const bf16x8 b = *(const LAS bf16x8*)(bp + 32 * kb);
                acc[nt][0] = __builtin_amdgcn_mfma_f32_32x32x16_bf16(AE[kb], b, acc[nt][0], 0, 0, 0);
                acc[nt][1] = __builtin_amdgcn_mfma_f32_32x32x16_bf16(AO[kb], b, acc[nt][1], 0, 0, 0);
            }
        }
    }
}
}

__device__ __forceinline__ void phase_longconv_mfma(const Ctx& F, const bf16* XV, bf16* ZC, const bf16* RG, const float* fpart, const float* skip) {
    using namespace hconv;
    const int chs = F.wave >> 1, nh = F.wave & 1, n = F.lane & 31, hi = F.lane >> 5;
    LAS unsigned char* zl = F.lds + chs * CHBYTES; LAS unsigned char* rl = zl + ZBYTES; LAS unsigned char* zero = F.lds + ZERO_OFF;
    if (F.tid < 32) ((LAS unsigned*)zero)[F.tid] = 0u;
    for (int grp = F.bid; grp < D / 4; grp += F.G) {
        const int c0 = grp * 4, c = c0 + chs;
        for (int q = F.tid; q < 4 * 1024; q += NTHREADS) { const int cc = q >> 10, qq = q & 1023;
            const v4u v = *(const v4u*)(XV + (size_t)(2 * D + c0 + cc) * R + qq * 8);
            *(LAS v4u*)(F.lds + cc * CHBYTES + (qq >> 3) * ZPITCH + (qq & 7) * 16) = v; }
        for (int q = F.tid; q < 4 * (RLEN / 8); q += NTHREADS) { const int cc = q / (RLEN / 8), qq = q % (RLEN / 8);
            *(LAS v4u*)(F.lds + cc * CHBYTES + ZBYTES + qq * 16) = *(const v4u*)(RG + (size_t)(c0 + cc) * RLEN + qq * 8); }
        float s0, s1;
        { const float a = F.lane < 16 ? fpart[c * 16 + F.lane] : 0.f, b = F.lane < 16 ? fpart[(D + c) * 16 + F.lane] : 0.f;
          s0 = 1.0f / sqrtf(wave_sum(a) + EPS); s1 = 1.0f / sqrtf(wave_sum(b) + EPS); }
        const float sk0 = skip[c], sk1 = skip[D + c];
        __syncthreads();
        f32x16 acc[2][2];
        conv_wave(zl, rl, zero, nh, F.lane, acc);
        __syncthreads();
#pragma unroll
        for (int nt = 0; nt < 2; ++nt) { const int tb = 64 * nh + 32 * nt + n;
#pragma unroll
            for (int g = 0; g < 4; ++g) { LAS v4u* zp = (LAS v4u*)(zl + ZPITCH * tb + 2 * (16 * g + 8 * hi));
                const v4u vv = *zp; const v4u xx = *(const v4u*)(XV + (size_t)c * R + 64 * tb + 16 * g + 8 * hi);
                v4u w;
#pragma unroll
                for (int q = 0; q < 4; ++q) { const float ye = acc[nt][0][4 * g + q], yo = acc[nt][1][4 * g + q];
                    const float ze = bf2f(xx[q] & 0xffffu) * (s0 * ye + bf2f(vv[q] & 0xffffu) * sk0), zo = bf2f(xx[q] >> 16) * (s0 * yo + bf2f(vv[q] >> 16) * sk0);
                    w[q] = pk2(ze, zo); }
                *zp = w; } }
        for (int q = F.tid; q < 4 * (RLEN / 8); q += NTHREADS) { const int cc = q / (RLEN / 8), qq = q % (RLEN / 8);
            *(LAS v4u*)(F.lds + cc * CHBYTES + ZBYTES + qq * 16) = *(const v4u*)(RG + (size_t)(D + c0 + cc) * RLEN + qq * 8); }
        __syncthreads();
        conv_wave(zl, rl, zero, nh, F.lane, acc);
#pragma unroll
        for (int nt = 0; nt < 2; ++nt) { const int tb = 64 * nh + 32 * nt + n;
#pragma unroll
            for (int g = 0; g < 4; ++g) { const v4u vv = *(const LAS v4u*)(zl + ZPITCH * tb + 2 * (16 * g + 8 * hi));
                const v4u xx = *(const v4u*)(XV + (size_t)(D + c) * R + 64 * tb + 16 * g + 8 * hi);
                v4u w;
#pragma unroll
                for (int q = 0; q < 4; ++q) { const float ye = acc[nt][0][4 * g + q], yo = acc[nt][1][4 * g + q];
                    const float ze = bf2f(xx[q] & 0xffffu) * (s1 * ye + bf2f(vv[q] & 0xffffu) * sk1), zo = bf2f(xx[q] >> 16) * (s1 * yo + bf2f(vv[q] >> 16) * sk1);
                    w[q] = pk2(ze, zo); }
                *(v4u*)(ZC + (size_t)c * R + 64 * tb + 16 * g + 8 * hi) = w; } }
        __syncthreads();
    }
}

__device__ __forceinline__ void phase_ctxconv(const Ctx& F, const bf16* XV, bf16* ZC, const float* FILTC, const float* fpartc, const float* skip) {
    LAS float* zs = (LAS float*)(F.lds + F.wave * 4096); LAS float* Tp = zs + 256;
    for (int c = F.gw; c < D; c += F.NGW) {
        const bf16* v = XV + (size_t)(2 * D + c) * R + S; const bf16* x1 = XV + (size_t)c * R + S; const bf16* x2 = XV + (size_t)(D + c) * R + S;
        const float s0 = 1.0f / sqrtf(fpartc[c] + EPS), s1 = 1.0f / sqrtf(fpartc[D + c] + EPS), sk0 = skip[c], sk1 = skip[D + c];
        float vv[4], acc[4], z2[4];
#pragma unroll
        for (int q = 0; q < 4; ++q) { vv[q] = bf2f(v[F.lane + 64 * q]); zs[F.lane + 64 * q] = vv[q]; }
#pragma unroll
        for (int q = 0; q < 8; ++q) { const int src = F.lane + 64 * q - 128; Tp[F.lane + 64 * q] = (unsigned)src < 256u ? FILTC[(size_t)c * C + src] : 0.f; }
        LDS_WAIT();
#pragma unroll
        for (int q = 0; q < 4; ++q) acc[q] = 0.f;
        for (int s = 0; s < C; ++s) { const float zv = zs[s];
#pragma unroll
            for (int q = 0; q < 4; ++q) acc[q] += zv * Tp[F.lane + 64 * q - s + 256]; }
#pragma unroll
        for (int q = 0; q < 4; ++q) z2[q] = bf2f(x1[F.lane + 64 * q]) * (s0 * acc[q] + vv[q] * sk0);
        LDS_WAIT();
#pragma unroll
        for (int q = 0; q < 4; ++q) zs[F.lane + 64 * q] = z2[q];
#pragma unroll
        for (int q = 0; q < 8; ++q) { const int src = F.lane + 64 * q - 128; Tp[F.lane + 64 * q] = (unsigned)src < 256u ? FILTC[(size_t)(D + c) * C + src] : 0.f; }
        LDS_WAIT();
#pragma unroll
        for (int q = 0; q < 4; ++q) acc[q] = 0.f;
        for (int s = 0; s < C; ++s) { const float zv = zs[s];
#pragma unroll
            for (int q = 0; q < 4; ++q) acc[q] += zv * Tp[F.lane + 64 * q - s + 256]; }
#pragma unroll
        for (int q = 0; q < 4; ++q) ZC[(size_t)c * R + S + F.lane + 64 * q] = (bf16)f2bf(bf2f(x2[F.lane + 64 * q]) * (s1 * acc[q] + z2[q] * sk1));
        LDS_WAIT();
    }
}
#ifndef RP_PRO
#define RP_PRO 1
#endif
#ifndef RP_FIL
#define RP_FIL 1
#endif
#ifndef RP_THIN
#define RP_THIN 1
#endif
#ifndef RP_ATT
#define RP_ATT 1
#endif
#ifndef RP_CONV
#define RP_CONV 1
#endif
#ifndef RP_GIN
#define RP_GIN 1
#endif
#ifndef RP_GUP
#define RP_GUP 1
#endif
#define REP(n) for (int rep_ = 0; rep_ < (n); ++rep_)
#define REPSYNC __syncthreads();
struct Args { const float* in[30]; float* out; unsigned char* ws; int ph_lo, ph_hi; };
constexpr int N_PHASES = 2 + 4 * 9 + 1;

__global__ void __launch_bounds__(NTHREADS, 2) fwd(Args args) {
    extern __shared__ __attribute__((aligned(16))) unsigned char lds_raw[];
    Ctx F;
    F.lds = (LAS unsigned char*)lds_raw;
    F.tid = threadIdx.x; F.lane = F.tid & 63; F.wave = __builtin_amdgcn_readfirstlane(F.tid >> 6);
    F.bid = blockIdx.x; F.G = gridDim.x; F.gw = F.bid * NWAVES + F.wave; F.NGW = F.G * NWAVES;
    unsigned char* ws = args.ws;
    volatile LAS unsigned* MISC = (volatile LAS unsigned*)(F.lds + MISC_OFF);
    if (F.tid < 32) MISC[F.tid] = 0u;
    __syncthreads();
    XcdBarrier bar; bar.bar = (unsigned*)(ws + WS_CTL) + CW_BAR; bar.x = 0; bar.st = nullptr;
#if MK_ONE_LAUNCH
    bar = xcd_barrier_post((unsigned*)(ws + WS_CTL) + CW_BAR, MISC + 8);
#endif
    const int lo = args.ph_lo, hi = args.ph_hi;
    int ph = 0;
#define PH_BEGIN if (ph >= lo && ph < hi) { int tid_ = threadIdx.x; asm volatile("" : "+v"(tid_)); F.tid = tid_; F.lane = tid_ & 63;
#if MK_ONE_LAUNCH
#define PH_END if (ph + 1 < hi) xcd_barrier(bar); } ++ph;
#else
#define PH_END } ++ph;
#endif
    const float* const* in = args.in;
    float* misc = (float*)(ws + WS_MISC);
    float* X = (float*)(ws + WS_X); bf16* H = (bf16*)(ws + WS_H); bf16* QKV = (bf16*)(ws + WS_QKV); bf16* KP = (bf16*)(ws + WS_KP); bf16* VP = (bf16*)(ws + WS_VP);
    bf16* O = (bf16*)(ws + WS_O); bf16* U = (bf16*)(ws + WS_U); bf16* UP = (bf16*)(ws + WS_UP); bf16* XV = (bf16*)(ws + WS_XV); bf16* ZC = (bf16*)(ws + WS_ZC);
    const float* rcos = misc + MO_RCOS; const float* rsin = misc + MO_RSIN;

    PH_BEGIN REP(RP_PRO) { phase_prologue(F, in, ws); REPSYNC } PH_END
    PH_BEGIN REP(RP_FIL) { phase_filters(F, in, ws); REPSYNC } PH_END

    for (int i = 0; i < DEPTH; ++i) {
        const int j = i >> 1; const bool is_attn = (i & 1) == 0, ctx_upd = i < 2, has_ctx = is_attn || ctx_upd;
        const int nrows1 = has_ctx ? R : S, nrows2 = ctx_upd ? R : S;
        const float* mod = misc + MO_MOD + i * NMODW; const float* modc = misc + MO_MODC + i * NMODW;
        PH_BEGIN REP(RP_THIN) { phase_norm_mod(F, X, H, nrows1, in[6] + i * D, mod, mod + D, modc, modc + D); REPSYNC } PH_END
        PH_BEGIN REP(RP_GIN) { const int N = is_attn ? AW : HW;
            pg8::Gemm g{H, is_attn ? (const bf16*)(ws + WS_WAIN) + (size_t)j * AW * D : (const bf16*)(ws + WS_WHIN) + (size_t)j * HW * D, nrows1, N, D};
            pg8::StaticOrder So; So.init(nrows1, N, F.G, F.bid);
            pg8::EpiBf16<0> E{is_attn ? QKV : UP, N, is_attn ? nullptr : in[14] + j * HW};
            pg8::gemm_phase<pg8::EpiBf16<0>, pg8::StaticOrder, PG8_ALIGN, PG8_SP2>(F.lds, g, So, E, F.tid); REPSYNC } PH_END
        if (is_attn) {
            PH_BEGIN REP(RP_THIN) { phase_kprep(F, QKV, KP, VP, in[12] + j * HD, rcos, rsin); REPSYNC } PH_END
            PH_BEGIN REP(RP_ATT) { phase_attn(F, QKV, KP, VP, O, ctx_upd, in[10] + j * 8, in[11] + j * HD, rcos, rsin); REPSYNC } PH_END
            ++ph;
        } else {
            PH_BEGIN REP(RP_THIN) { phase_shortconv(F, UP, XV, in[15] + (size_t)j * 3 * HW, in[16] + j * HW, nrows2); REPSYNC } PH_END
            PH_BEGIN REP(RP_CONV) { phase_longconv_mfma(F, XV, ZC, (const bf16*)(ws + WS_FILT) + (size_t)j * 4096 * 8320, misc + MO_FPART + j * 4096 * 16, in[24] + j * 2 * D);
                if (ctx_upd) { __syncthreads(); phase_ctxconv(F, XV, ZC, (const float*)(ws + WS_FILTC), misc + MO_FPARTC, in[24] + j * 2 * D); } REPSYNC } PH_END
            PH_BEGIN REP(RP_THIN) { phase_transpose_zc(F, ZC, O, nrows2); REPSYNC } PH_END
        }
        PH_BEGIN { pg8::Gemm g{O, is_attn ? (const bf16*)(ws + WS_WAOUT) + (size_t)j * D * D : (const bf16*)(ws + WS_WHOUT) + (size_t)j * D * D, nrows2, D, D};
            pg8::StaticOrder So; So.init(nrows2, D, F.G, F.bid);
            pg8::EpiResGate E{X, D, is_attn ? nullptr : in[26] + j * D, mod + 2 * D, modc + 2 * D, S / 256};
            pg8::gemm_phase<pg8::EpiResGate, pg8::StaticOrder, PG8_ALIGN, PG8_SP2>(F.lds, g, So, E, F.tid); } PH_END
        PH_BEGIN REP(RP_THIN) { phase_norm_mod(F, X, H, nrows2, in[7] + i * D, mod + 3 * D, mod + 4 * D, modc + 3 * D, modc + 4 * D); REPSYNC } PH_END
        PH_BEGIN REP(RP_GUP) { pg8::Gemm g{H, (const bf16*)(ws + WS_WM1) + (size_t)i * FF * D, nrows2, FF, D}; pg8::StaticOrder So; So.init(nrows2, FF, F.G, F.bid);
            pg8::EpiBf16<1> E{U, FF, nullptr};
            pg8::gemm_phase<pg8::EpiBf16<1>, pg8::StaticOrder, PG8_ALIGN, PG8_SP2>(F.lds, g, So, E, F.tid); REPSYNC } PH_END
        PH_BEGIN { pg8::Gemm g{U, (const bf16*)(ws + WS_WM2) + (size_t)i * D * FF, nrows2, D, FF}; pg8::StaticOrder So; So.init(nrows2, D, F.G, F.bid);
            pg8::EpiResGate E{X, D, nullptr, mod + 5 * D, modc + 5 * D, S / 256};
            pg8::gemm_phase<pg8::EpiResGate, pg8::StaticOrder, PG8_ALIGN, PG8_SP2>(F.lds, g, So, E, F.tid); } PH_END
    }
    PH_BEGIN REP(RP_THIN) { phase_final_norm(F, X, args.out, in[29]); REPSYNC } PH_END
#undef PH_BEGIN
#undef PH_END
}

extern "C" void kernel_launch(void* const* d_in, const int* in_sizes, int n_in, void* d_out, int out_size, void* d_ws, size_t ws_size, hipStream_t stream) {
    static int grid = 0;
    if (grid == 0) {
        if (n_in != 30 || out_size != S * D || ws_size < WS_END) { fprintf(stderr, "kernel_launch: unexpected shapes: n_in %d out %d ws %zu (need %zu)\n", n_in, out_size, ws_size, (size_t)WS_END); grid = -1; return; }
        int dev = 0, cus = 0, per_cu = 0;
        if (hipGetDevice(&dev) != hipSuccess || hipDeviceGetAttribute(&cus, hipDeviceAttributeMultiprocessorCount, dev) != hipSuccess) { grid = -1; return; }
        if (hipFuncSetAttribute((const void*)fwd, hipFuncAttributeMaxDynamicSharedMemorySize, LDS_BYTES) != hipSuccess) { fprintf(stderr, "kernel_launch: hipFuncSetAttribute failed\n"); grid = -1; return; }
        if (hipOccupancyMaxActiveBlocksPerMultiprocessor(&per_cu, (const void*)fwd, NTHREADS, LDS_BYTES) != hipSuccess || per_cu < 1)
            fprintf(stderr, "kernel_launch: occupancy query reports %d workgroups per CU\n", per_cu);
        (void)hipGetLastError();
        grid = cus;
    }
    if (grid < 0) return;
    (void)hipMemsetAsync((char*)d_ws + WS_CTL, 0, CTL_ZERO_BYTES, stream);
    Args a{};
    for (int i = 0; i < 30; ++i) a.in[i] = (const float*)d_in[i];
    a.out = (float*)d_out; a.ws = (unsigned char*)d_ws;
#if MK_ONE_LAUNCH
    a.ph_lo = 0; a.ph_hi = N_PHASES;
    hipLaunchKernelGGL(fwd, dim3(grid), dim3(NTHREADS), LDS_BYTES, stream, a);
#else
    for (int p = 0; p < N_PHASES; ++p) { a.ph_lo = p; a.ph_hi = p + 1; hipLaunchKernelGGL(fwd, dim3(grid), dim3(NTHREADS), LDS_BYTES, stream, a); }
#endif
    const hipError_t le = hipPeekAtLastError();
    if (le != hipSuccess) fprintf(stderr, "kernel_launch: launch failed: %s\n", hipGetErrorName(le));
}
```

```cpp
#include <hip/hip_runtime.h>
#include <cstdio>
#include <cstdint>
#define MK_ONE_LAUNCH 1
namespace pg8 {
#define PG8_LAS __attribute__((address_space(3)))
typedef unsigned short bf16_t;
typedef short bf16x8 __attribute__((ext_vector_type(8)));
typedef float f32x4 __attribute__((ext_vector_type(4)));
typedef unsigned u32x4 __attribute__((ext_vector_type(4)));
constexpr int BM = 256, BK = 64, HALF = 128, HTB = HALF * BK * 2  , STAGE_BYTES = 8 * HTB, NXCD = 8, WGM = 8;

__host__ __device__ __forceinline__ int lds_byte(int r, int c) { const int st = (r >> 4) * 2 + (c >> 5), rr = r & 15, cc = c & 31, ob = rr * 64 + cc * 2; return st * 1024 + (ob ^ (((ob >> 9) & 1) << 5)); }
__host__ __device__ __forceinline__ void stage_rc(int b, int& R, int& C) { const int st = b / 1024, sb = b % 1024, swz = sb ^ (((sb >> 9) & 1) << 5); R = (st >> 1) * 16 + swz / 64; C = (st & 1) * 32 + (swz % 64) / 2; }
__host__ __device__ __forceinline__ int perm32(int rho) { const int n = rho >> 4, i = rho & 15; return 8 * (i >> 2) + 4 * n + (i & 3); }

struct Unit { int pm, pn; int ko, nt, split; };
struct Gemm { const bf16_t* A; const bf16_t* Bt; int M, N, K; };

struct StaticOrder {
    int nM, nN, nwg, G, c, ntk;
    int xpm, xks, xnt;
    __host__ __device__ void init(int M, int N, int K, int G_, int c_) { nM = M / BM; nN = N / BM; nwg = nM * nN; G = G_; c = c_; ntk = K / BK; xpm = 0; xks = 0; xnt = 0; }
    __host__ __device__ void extend(int pm, int ks) { xpm = pm; xks = ks; xnt = ntk / ks; }
    __host__ __device__ bool next(int i, Unit& u) const {
        const long L = (long)i * G + c; if (L >= nwg + xks * nN) return false;
        const bool ext = L >= nwg;
        int wgid = ext ? 0 : (int)L; { const int q = nwg / NXCD, r = nwg % NXCD, xcd = wgid % NXCD, off = wgid / NXCD; wgid = (xcd < r ? xcd * (q + 1) : r * (q + 1) + (xcd - r) * q) + off; }
        const int nig = WGM * nN, gid = wgid / nig, fm = gid * WGM, gsz = (nM - fm) < WGM ? (nM - fm) : WGM;
        const int pm_s = fm + ((wgid % nig) % gsz), pn_s = (wgid % nig) / gsz;
        const int q = ext ? (int)(L - nwg) : 0, ks = q / nN;
        u.pm = ext ? xpm : pm_s; u.pn = ext ? q - ks * nN : pn_s; u.ko = ext ? ks * xnt : 0; u.nt = ext ? xnt : ntk; u.split = ext ? 1 + ks : 0;
        return true;
    }
    __device__ __forceinline__ void a_ready(const Unit&) const {}
    __device__ __forceinline__ void done(const Unit&) const {}
};

__device__ __forceinline__ unsigned cvt_pk_bf16(float lo, float hi) { unsigned r; asm volatile("v_cvt_pk_bf16_f32 %0, %1, %2" : "=v"(r) : "v"(lo), "v"(hi)); return r; }

template <int ACT> struct EpiBf16 {
    static constexpr bool PERM = true, AFTER_DRAIN = false;
    bf16_t* O; int ldc; const float* bias;
    __device__ __forceinline__ void operator()(const f32x4 (&acc)[2][2][4][2], const Unit& u, int wr, int wc, int fr, int fq) const {
        const int row0 = u.pm * BM + wr * 64 + fr; const int col0 = u.pn * BM + wc * 32 + 8 * fq;
        f32x4 bv[2][2];
#pragma unroll
        for (int bj = 0; bj < 2; ++bj)
#pragma unroll
            for (int n = 0; n < 2; ++n) bv[bj][n] = bias ? *(const f32x4*)(bias + col0 + bj * HALF + 4 * n) : (f32x4){0.f, 0.f, 0.f, 0.f};
#pragma unroll
        for (int ai = 0; ai < 2; ++ai)
#pragma unroll
            for (int m = 0; m < 4; ++m) { bf16_t* rowp = O + (size_t)(row0 + ai * HALF + m * 16) * ldc + col0;
#pragma unroll
                for (int bj = 0; bj < 2; ++bj) { f32x4 v0 = acc[ai][bj][m][0] + bv[bj][0], v1 = acc[ai][bj][m][1] + bv[bj][1];
                    if (ACT == 1) {
#pragma unroll
                        for (int j = 0; j < 4; ++j) { const float a = fmaxf(v0[j], 0.f), b = fmaxf(v1[j], 0.f); v0[j] = a * a; v1[j] = b * b; } }
                    u32x4 w; w.x = cvt_pk_bf16(v0[0], v0[1]); w.y = cvt_pk_bf16(v0[2], v0[3]); w.z = cvt_pk_bf16(v1[0], v1[1]); w.w = cvt_pk_bf16(v1[2], v1[3]);
                    *(u32x4*)(rowp + bj * HALF) = w; } }
    }
};
struct EpiResGate {
    static constexpr bool PERM = false, AFTER_DRAIN = false;
    float* X; int ldc; const float* bias; const float* gate_lat; const float* gate_ctx; int ctx_pm; float* P;
    __device__ __forceinline__ void operator()(const f32x4 (&acc)[2][2][4][2], const Unit& u, int wr, int wc, int fr, int fq) const {
        const int col0 = u.pn * BM + wc * 32 + 4 * fq;
        if (u.split) {
            float* base = P + ((size_t)(u.split - 1) * BM + wr * 64 + fr) * ldc + col0;
#pragma unroll
            for (int ai = 0; ai < 2; ++ai)
#pragma unroll
                for (int m = 0; m < 4; ++m) { float* rowp = base + (size_t)(ai * HALF + m * 16) * ldc;
#pragma unroll
                    for (int bj = 0; bj < 2; ++bj)
#pragma unroll
                        for (int n = 0; n < 2; ++n) *(f32x4*)(rowp + bj * HALF + n * 16) = acc[ai][bj][m][n]; }
            return;
        }
        const int row0 = u.pm * BM + wr * 64 + fr;
        const float* gate = (u.pm >= ctx_pm) ? gate_ctx : gate_lat;
        f32x4 bv[2][2], gv[2][2];
#pragma unroll
        for (int bj = 0; bj < 2; ++bj)
#pragma unroll
            for (int n = 0; n < 2; ++n) { bv[bj][n] = bias ? *(const f32x4*)(bias + col0 + bj * HALF + n * 16) : (f32x4){0.f, 0.f, 0.f, 0.f};
                gv[bj][n] = *(const f32x4*)(gate + col0 + bj * HALF + n * 16); }
#pragma unroll
        for (int ai = 0; ai < 2; ++ai)
#pragma unroll
            for (int m = 0; m < 4; ++m) { float* rowp = X + (size_t)(row0 + ai * HALF + m * 16) * ldc + col0;
#pragma unroll
                for (int bj = 0; bj < 2; ++bj)
#pragma unroll
                    for (int n = 0; n < 2; ++n) { f32x4* p = (f32x4*)(rowp + bj * HALF + n * 16); const f32x4 old = *p; *p = old + gv[bj][n] * (acc[ai][bj][m][n] + bv[bj][n]); } }
    }
};

template <class Epi, class Sched, bool ALIGN_EPI = false, bool SP2 = false>
__device__ __forceinline__ void gemm_phase(PG8_LAS unsigned char* lds, const Gemm g, const Sched& S, const Epi& E, const int tid) {
    const int wid = __builtin_amdgcn_readfirstlane(tid >> 6), lane = tid & 63, wr = wid >> 2, wc = wid & 3, fr = lane & 15, fq = lane >> 4;
    const int K = g.K;
    unsigned voffA[2], voffB[2];
#pragma unroll
    for (int i = 0; i < 2; ++i) { int R, C; stage_rc(tid * 16 + i * 8192, R, C); const int Rb = Epi::PERM ? ((R & ~31) + perm32(R & 31)) : R;
        voffA[i] = (unsigned)(R * K + C) * 2u; voffB[i] = (unsigned)(Rb * K + C) * 2u; }
    const size_t kstep = (size_t)(BK * 2);
    const size_t hstep = (size_t)HALF * K * 2;
    const size_t tstep = 2 * hstep;
    const unsigned ldsw = (unsigned)wid * 1024u;
    const int aoff = lds_byte(wr * 64 + fr, fq * 8), boff = lds_byte(wc * 32 + fr, fq * 8);
#define PG8_SA(b, h) (((b) * 2 + (h)) * HTB)
#define PG8_SB(b, h) ((4 + (b) * 2 + (h)) * HTB)
#define PG8_STAGE(bufoff, gbase, voff) do { _Pragma("unroll") for (int _i = 0; _i < 2; ++_i) \
        __builtin_amdgcn_global_load_lds((const unsigned*)((const char*)(gbase) + (voff)[_i]), (PG8_LAS unsigned*)(lds + (bufoff) + ldsw + _i * 8192), 16, 0, 0); } while (0)
#define PG8_LDA(dst, b, h) do { _Pragma("unroll") for (int m = 0; m < 4; ++m) _Pragma("unroll") for (int k = 0; k < 2; ++k) dst[m][k] = *(const PG8_LAS bf16x8*)(lds + PG8_SA(b, h) + aoff + m * 2048 + k * 1024); } while (0)
#define PG8_LDB(dst, b, h) do { _Pragma("unroll") for (int n = 0; n < 2; ++n) _Pragma("unroll") for (int k = 0; k < 2; ++k) dst[n][k] = *(const PG8_LAS bf16x8*)(lds + PG8_SB(b, h) + boff + n * 2048 + k * 1024); } while (0)
#define PG8_MMA(ai, bj, At, Bt) do { __builtin_amdgcn_s_setprio(1); _Pragma("unroll") for (int m = 0; m < 4; ++m) _Pragma("unroll") for (int n = 0; n < 2; ++n) _Pragma("unroll") for (int k = 0; k < 2; ++k) \
        acc[ai][bj][m][n] = __builtin_amdgcn_mfma_f32_16x16x32_bf16(Bt[n][k], At[m][k], acc[ai][bj][m][n], 0, 0, 0); __builtin_amdgcn_s_setprio(0); } while (0)
#define PG8_WAIT_V(n) asm volatile("s_waitcnt vmcnt(" #n ")" ::: "memory")
#define PG8_WAIT_L(n) asm volatile("s_waitcnt lgkmcnt(" #n ")" ::: "memory")
#define PG8_BAR __builtin_amdgcn_s_barrier()
#define PG8_SCHED __builtin_amdgcn_sched_barrier(0)
    Unit cur, nxt; int ui = 0;
    if (!S.next(0, cur)) return;
    f32x4 acc[2][2][4][2];
#pragma unroll
    for (int a = 0; a < 2; ++a)
#pragma unroll
        for (int b = 0; b < 2; ++b)
#pragma unroll
            for (int m = 0; m < 4; ++m)
#pragma unroll
                for (int n = 0; n < 2; ++n) acc[a][b][m][n] = (f32x4){0.f, 0.f, 0.f, 0.f};
    bf16x8 At[4][2], B0[2][2], B1[2][2];
    const char* cA = (const char*)g.A + (size_t)cur.pm * tstep + (size_t)cur.ko * (BK * 2); const char* cB = (const char*)g.Bt + (size_t)cur.pn * tstep + (size_t)cur.ko * (BK * 2);
    S.a_ready(cur);
    if constexpr (SP2) {
        PG8_STAGE(PG8_SB(0, 0), cB, voffB); PG8_STAGE(PG8_SB(0, 1), cB + hstep, voffB); PG8_STAGE(PG8_SA(0, 0), cA, voffA); PG8_STAGE(PG8_SA(0, 1), cA + hstep, voffA);
        if (wr == 1) PG8_BAR;
        PG8_WAIT_V(2); PG8_BAR;
        PG8_STAGE(PG8_SB(1, 0), cB + kstep, voffB); PG8_STAGE(PG8_SA(1, 0), cA + kstep, voffA); PG8_STAGE(PG8_SB(1, 1), cB + hstep + kstep, voffB);
        PG8_WAIT_V(6); PG8_BAR;
    } else {
        PG8_STAGE(PG8_SB(0, 0), cB, voffB); PG8_STAGE(PG8_SA(0, 0), cA, voffA); PG8_STAGE(PG8_SB(0, 1), cB + hstep, voffB); PG8_STAGE(PG8_SA(0, 1), cA + hstep, voffA);
        if (wr == 1) PG8_BAR;
        PG8_WAIT_V(4); PG8_BAR;
        PG8_STAGE(PG8_SB(1, 0), cB + kstep, voffB); PG8_STAGE(PG8_SA(1, 0), cA + kstep, voffA); PG8_STAGE(PG8_SB(1, 1), cB + hstep + kstep, voffB);
        PG8_WAIT_V(6); PG8_BAR;
    }
    for (;;) {
        const bool has_next = S.next(ui + 1, nxt);
        const char* nA = has_next ? (const char*)g.A + (size_t)nxt.pm * tstep + (size_t)nxt.ko * (BK * 2) : cA; const char* nB = has_next ? (const char*)g.Bt + (size_t)nxt.pn * tstep + (size_t)nxt.ko * (BK * 2) : cB;
        const int nt = cur.nt;
        for (int t = 0; t < nt; t += 2) {
            const bool last = (t == nt - 2);
            const char* a1 = cA + (size_t)(t + 1) * kstep;
            const char* a2 = last ? nA : cA + (size_t)(t + 2) * kstep; const char* b2 = last ? nB : cB + (size_t)(t + 2) * kstep;
            const char* a3 = a2 + kstep; const char* b3 = b2 + kstep;
            if (last && has_next) S.a_ready(nxt);
            if constexpr (SP2) {
            PG8_LDB(B0, 0, 0); PG8_LDB(B1, 0, 1); PG8_SCHED; PG8_LDA(At, 0, 0); PG8_STAGE(PG8_SA(1, 1), a1 + hstep, voffA);
            PG8_WAIT_V(8); PG8_WAIT_L(0); PG8_BAR; PG8_MMA(0, 0, At, B0); PG8_MMA(0, 1, At, B1); PG8_BAR; PG8_SCHED;
            PG8_LDA(At, 0, 1); PG8_STAGE(PG8_SB(0, 0), b2, voffB); PG8_STAGE(PG8_SB(0, 1), b2 + hstep, voffB); PG8_STAGE(PG8_SA(0, 0), a2, voffA);
            PG8_WAIT_V(8); PG8_WAIT_L(0); PG8_BAR; PG8_MMA(1, 0, At, B0); PG8_MMA(1, 1, At, B1); PG8_BAR; PG8_SCHED;
            PG8_LDB(B0, 1, 0); PG8_LDB(B1, 1, 1); PG8_SCHED; PG8_LDA(At, 1, 0); PG8_STAGE(PG8_SA(0, 1), a2 + hstep, voffA);
            PG8_WAIT_V(8); PG8_WAIT_L(0); PG8_BAR; PG8_MMA(0, 0, At, B0); PG8_MMA(0, 1, At, B1); PG8_BAR; PG8_SCHED;
            PG8_LDA(At, 1, 1); PG8_STAGE(PG8_SB(1, 0), b3, voffB); PG8_STAGE(PG8_SB(1, 1), b3 + hstep, voffB); PG8_STAGE(PG8_SA(1, 0), a3, voffA);
            PG8_WAIT_V(8); PG8_WAIT_L(0); PG8_BAR; PG8_MMA(1, 0, At, B0); PG8_MMA(1, 1, At, B1); PG8_BAR; PG8_SCHED;
            } else {
            PG8_LDB(B0, 0, 0); PG8_SCHED; PG8_LDA(At, 0, 0); PG8_STAGE(PG8_SA(1, 1), a1 + hstep, voffA);
            PG8_WAIT_L(8); PG8_BAR; PG8_WAIT_L(0); PG8_MMA(0, 0, At, B0); PG8_BAR; PG8_SCHED;
            PG8_LDB(B1, 0, 1); PG8_STAGE(PG8_SB(0, 0), b2, voffB);
            PG8_BAR; PG8_WAIT_L(0); PG8_MMA(0, 1, At, B1); PG8_BAR;
            PG8_LDA(At, 0, 1); PG8_STAGE(PG8_SA(0, 0), a2, voffA);
            PG8_BAR; PG8_WAIT_L(0); PG8_MMA(1, 0, At, B0); PG8_BAR; PG8_SCHED;
            PG8_STAGE(PG8_SB(0, 1), b2 + hstep, voffB);
            PG8_WAIT_V(6); PG8_BAR; PG8_MMA(1, 1, At, B1); PG8_BAR;
            PG8_LDB(B0, 1, 0); PG8_SCHED; PG8_LDA(At, 1, 0); PG8_STAGE(PG8_SA(0, 1), a2 + hstep, voffA);
            PG8_WAIT_L(8); PG8_BAR; PG8_WAIT_L(0); PG8_MMA(0, 0, At, B0); PG8_BAR; PG8_SCHED;
            PG8_LDB(B1, 1, 1); PG8_STAGE(PG8_SB(1, 0), b3, voffB);
            PG8_BAR; PG8_WAIT_L(0); PG8_MMA(0, 1, At, B1); PG8_BAR;
            PG8_LDA(At, 1, 1); PG8_STAGE(PG8_SA(1, 0), a3, voffA);
            PG8_BAR; PG8_WAIT_L(0); PG8_MMA(1, 0, At, B0); PG8_BAR; PG8_SCHED;
            PG8_STAGE(PG8_SB(1, 1), b3 + hstep, voffB);
            PG8_WAIT_V(6); PG8_BAR; PG8_MMA(1, 1, At, B1); PG8_BAR;
            }
        }
        if constexpr (ALIGN_EPI) { if (wr == 0) PG8_BAR; }
        if constexpr (!Epi::AFTER_DRAIN) { E(acc, cur, wr, wc, fr, fq); S.done(cur); }
        if (!has_next) break;
#pragma unroll
        for (int a = 0; a < 2; ++a)
#pragma unroll
            for (int b = 0; b < 2; ++b)
#pragma unroll
                for (int m = 0; m < 4; ++m)
#pragma unroll
                    for (int n = 0; n < 2; ++n) acc[a][b][m][n] = (f32x4){0.f, 0.f, 0.f, 0.f};
        cur = nxt; cA = nA; cB = nB; ++ui;
        if constexpr (ALIGN_EPI) { if (wr == 1) PG8_BAR; }
    }
    PG8_WAIT_V(0);
    if constexpr (!ALIGN_EPI) { if (wr == 0) PG8_BAR; }
    PG8_BAR;
    if constexpr (Epi::AFTER_DRAIN) { E.fused(acc, cur, wr, wc, fr, fq, lds, wid, lane); S.done(cur); }
#undef PG8_SA
#undef PG8_SB
#undef PG8_STAGE
#undef PG8_LDA
#undef PG8_LDB
#undef PG8_MMA
#undef PG8_WAIT_V
#undef PG8_WAIT_L
#undef PG8_BAR
#undef PG8_SCHED
}
}
#ifndef PG8_SP2
#define PG8_SP2 true
#endif
#ifndef PG8_ALIGN
#define PG8_ALIGN true
#endif
#ifndef MK_ONE_LAUNCH
#define MK_ONE_LAUNCH 0
#endif

constexpr int D = 2048, S = 8192, C = 256, R = S + C, DEPTH = 4, HD = 128;
constexpr int AW = 3072, HW = 6144, FF = 8192, NMODW = 6 * D;
constexpr float EPS = 1e-6f;
constexpr float QSCALE = 0.08838834764831845f;
constexpr float MIN_DECAY = -3.0701134573253944f, MAX_DECAY = -15.350567286626973f;
constexpr int NWAVES = 8, NTHREADS = 512;
constexpr int KS_OUT = 4, KS_DOWN = 16;

constexpr size_t MiB = 1u << 20;
constexpr size_t WS_CTL = 0, CTL_ZERO_BYTES = 1 * MiB;
constexpr size_t WS_WAIN = 1 * MiB;
constexpr size_t WS_WAOUT = WS_WAIN + 24 * MiB;
constexpr size_t WS_WHIN = WS_WAOUT + 16 * MiB;
constexpr size_t WS_WHOUT = WS_WHIN + 48 * MiB;
constexpr size_t WS_WM1 = WS_WHOUT + 16 * MiB;
constexpr size_t WS_WM2 = WS_WM1 + 128 * MiB;
constexpr size_t WS_X = WS_WM2 + 128 * MiB;
constexpr size_t WS_H = WS_X + 66 * MiB;
constexpr size_t WS_QKV = WS_H + 33 * MiB;
constexpr size_t WS_KP = WS_QKV + 50 * MiB;
constexpr size_t WS_VP = WS_KP + 9 * MiB;
constexpr size_t WS_O = WS_VP + 9 * MiB;
constexpr size_t WS_U = WS_O + 33 * MiB;
constexpr size_t WS_UP = WS_U + 132 * MiB;
constexpr size_t WS_XV = WS_UP + 99 * MiB;
constexpr size_t WS_ZC = WS_XV + 99 * MiB;
constexpr size_t WS_FILT = WS_ZC + 33 * MiB;
constexpr size_t WS_FILTC = WS_FILT + 256 * MiB;
constexpr size_t WS_HID = WS_FILTC + 4 * MiB;
constexpr size_t WS_MISC = WS_HID + 5 * MiB;
constexpr size_t WS_PART = WS_MISC + 2 * MiB;
constexpr size_t WS_END = WS_PART + 32 * MiB;
constexpr int MO_MOD = 0, MO_MODC = MO_MOD + 4 * NMODW, MO_RCOS = MO_MODC + 4 * NMODW, MO_RSIN = MO_RCOS + 128 * 32, MO_FPART = MO_RSIN + 128 * 32, MO_FPARTC = MO_FPART + 2 * 4096 * 16, MO_END = MO_FPARTC + 4096;
static_assert((size_t)MO_END * 4 <= 2 * MiB, "misc");
constexpr int CW_BAR = 4096;

constexpr int LDS_BYTES = 147456;
constexpr int MISC_OFF = LDS_BYTES - 256;

#define GAS __attribute__((address_space(1)))
#define LAS __attribute__((address_space(3)))
typedef unsigned short bf16;
typedef unsigned v4u __attribute__((ext_vector_type(4)));
typedef unsigned v2u __attribute__((ext_vector_type(2)));
typedef float f32x4 __attribute__((ext_vector_type(4)));
#define LDS_WAIT() asm volatile("s_waitcnt lgkmcnt(0)" ::: "memory")
__device__ __forceinline__ unsigned f2bf(float f) { unsigned u = __builtin_bit_cast(unsigned, f); return (u + 0x7fffu + ((u >> 16) & 1u)) >> 16; }
__device__ __forceinline__ unsigned pk2(float lo, float hi) { return f2bf(lo) | (f2bf(hi) << 16); }
__device__ __forceinline__ float bf2f(unsigned b) { return __builtin_bit_cast(float, b << 16); }
__device__ __forceinline__ float xl_dpp_b1(float v) { return __builtin_bit_cast(float, __builtin_amdgcn_update_dpp(0, __builtin_bit_cast(int, v), 0xB1, 0xF, 0xF, true)); }
__device__ __forceinline__ float xl_dpp_4e(float v) { return __builtin_bit_cast(float, __builtin_amdgcn_update_dpp(0, __builtin_bit_cast(int, v), 0x4E, 0xF, 0xF, true)); }
__device__ __forceinline__ float xl_swz4(float v)  { return __builtin_bit_cast(float, __builtin_amdgcn_ds_swizzle(__builtin_bit_cast(int, v), 0x101F)); }
__device__ __forceinline__ float xl_swz8(float v)  { return __builtin_bit_cast(float, __builtin_amdgcn_ds_swizzle(__builtin_bit_cast(int, v), 0x201F)); }
__device__ __forceinline__ float xl_swz16(float v) { return __builtin_bit_cast(float, __builtin_amdgcn_ds_swizzle(__builtin_bit_cast(int, v), 0x401F)); }
__device__ __forceinline__ float xl_x32(float v) { const unsigned u = __builtin_bit_cast(unsigned, v); auto rr = __builtin_amdgcn_permlane32_swap(u, u, false, false);
    return __builtin_bit_cast(float, (unsigned)((threadIdx.x & 32) ? rr[0] : rr[1])); }
__device__ __forceinline__ float wave_sum(float v) {
    v += xl_dpp_b1(v); v += xl_dpp_4e(v); v += xl_swz4(v); v += xl_swz8(v); v += xl_swz16(v);
    { const unsigned u = __builtin_bit_cast(unsigned, v); auto rr = __builtin_amdgcn_permlane32_swap(u, u, false, false); v = __builtin_bit_cast(float, (unsigned)rr[0]) + __builtin_bit_cast(float, (unsigned)rr[1]); }
    return v;
}
__device__ __forceinline__ float wave_max(float v) {
    v = fmaxf(v, xl_dpp_b1(v)); v = fmaxf(v, xl_dpp_4e(v)); v = fmaxf(v, xl_swz4(v)); v = fmaxf(v, xl_swz8(v)); v = fmaxf(v, xl_swz16(v));
    { const unsigned u = __builtin_bit_cast(unsigned, v); auto rr = __builtin_amdgcn_permlane32_swap(u, u, false, false); v = fmaxf(__builtin_bit_cast(float, (unsigned)rr[0]), __builtin_bit_cast(float, (unsigned)rr[1])); }
    return v;
}
#define XB_SPIN_CAP_OVERRIDE 1
#define XB_TMO      128
#define XB_XCNT(j)  (256  + 64 * (j))
#define XB_XSUB(j)  (1280 + 64 * (j))
#define XB_XGEN(j)  (2304 + 64 * (j))
#define XB_TOP      3328
#define XB_TOPGEN   3392
#define XCD_BAR_WORDS 3456
#define XB_SPIN_CAP (1u << 22)

__device__ __forceinline__ unsigned xb_ld(unsigned* p)              { return __hip_atomic_load(p, __ATOMIC_RELAXED, __HIP_MEMORY_SCOPE_AGENT); }
__device__ __forceinline__ unsigned xb_add(unsigned* p, unsigned v) { return __hip_atomic_fetch_add(p, v, __ATOMIC_RELAXED, __HIP_MEMORY_SCOPE_AGENT); }
__device__ __forceinline__ unsigned xb_xcc_id() { return (unsigned)__builtin_amdgcn_s_getreg((3 << 11) | 20) & 0xFu; }
#define XB_SPIN(cond, bar) do { unsigned _sp = 0; while (cond) { __builtin_amdgcn_s_sleep(1); \
    if ((++_sp & 255u) == 0u) { if (xb_ld(&(bar)[XB_TMO])) break; if (_sp > XB_SPIN_CAP) { atomicAdd(&(bar)[XB_TMO], 1u); break; } } } } while (0)

struct XcdBarrier {
    unsigned* bar; unsigned x;
    volatile LAS unsigned* st;
};

__device__ __forceinline__ XcdBarrier xcd_barrier_post(unsigned* bar, volatile LAS unsigned* st) {
    XcdBarrier b; b.bar = bar; b.x = xb_xcc_id(); b.st = st;
    if (threadIdx.x == 0) (void)xb_add(&bar[XB_XCNT(b.x)], 1u);
    return b;
}
__device__ __forceinline__ void xcd_barrier_complete(unsigned* bar, unsigned x, unsigned& nloc, unsigned& nx) {
    const unsigned G = gridDim.x * gridDim.y * gridDim.z;
    unsigned sum, cnt, mine, sp = 0u;
    for (;;) {
        sum = 0u; cnt = 0u; mine = 0u;
#pragma unroll
        for (unsigned j = 0; j < 16; ++j) { const unsigned c = xb_ld(&bar[XB_XCNT(j)]); sum += c; cnt += (c > 0u) ? 1u : 0u; mine = (j == x) ? c : mine; }
        if (sum == G) break;
        __builtin_amdgcn_s_sleep(1);
        if ((++sp & 255u) == 0u) { if (xb_ld(&bar[XB_TMO])) break; if (sp > XB_SPIN_CAP) { atomicAdd(&bar[XB_TMO], 1u); break; } }
    }
    nloc = mine > 0u ? mine : 1u; nx = cnt > 0u ? cnt : 1u;
}

__device__ __forceinline__ void xcd_barrier(const XcdBarrier& b) {
    asm volatile("s_waitcnt vmcnt(0)" ::: "memory");
    __syncthreads();
    if (threadIdx.x == 0) {
        unsigned* bar = b.bar;
        __builtin_amdgcn_s_waitcnt(0);
        unsigned nloc = b.st[0], nx = b.st[1];
        if (nloc == 0u) { xcd_barrier_complete(bar, b.x, nloc, nx); b.st[0] = nloc; b.st[1] = nx; }
        const unsigned old = xb_add(&bar[XB_XSUB(b.x)], 1u);
        const unsigned gen = old / nloc;
        if (old + 1u == (gen + 1u) * nloc) {
            __builtin_amdgcn_fence(__ATOMIC_RELEASE, "agent");
            asm volatile("s_waitcnt vmcnt(0)" ::: "memory");
            const unsigned og = xb_add(&bar[XB_TOP], 1u);
            const unsigned tg = og / nx;
            if (og + 1u == (tg + 1u) * nx) xb_add(&bar[XB_TOPGEN], 1u);
            else XB_SPIN(xb_ld(&bar[XB_TOPGEN]) == tg, bar);
            __builtin_amdgcn_fence(__ATOMIC_ACQUIRE, "agent");
            xb_add(&bar[XB_XGEN(b.x)], 1u);
            asm volatile("s_waitcnt vmcnt(0)" ::: "memory");
        } else {
            XB_SPIN(xb_ld(&bar[XB_XGEN(b.x)]) == gen, bar);
            __builtin_amdgcn_fence(__ATOMIC_ACQUIRE, "agent");
            asm volatile("s_waitcnt vmcnt(0)" ::: "memory");
        }
    }
    __syncthreads();
}

__device__ __forceinline__ void p0_transpose_item(const float* W, int K, int N, bf16* WT, LAS float* scr, int item, int lane) {
    const int nblk = N / 32, kb = item / nblk, nb = item % nblk, k0 = 64 * kb, n0 = 32 * nb;
#pragma unroll 8
    for (int i = 0; i < 32; ++i) { const int kk = 2 * i + (lane >> 5); scr[kk * 33 + (lane & 31)] = W[(size_t)(k0 + kk) * N + n0 + (lane & 31)]; }
    LDS_WAIT();
    const int c = lane & 7;
#pragma unroll
    for (int j = 0; j < 4; ++j) { const int n = (lane >> 3) + 8 * j; const LAS float* s = scr + (8 * c) * 33 + n;
        v4u o; o.x = pk2(s[0 * 33], s[1 * 33]); o.y = pk2(s[2 * 33], s[3 * 33]); o.z = pk2(s[4 * 33], s[5 * 33]); o.w = pk2(s[6 * 33], s[7 * 33]);
        *(v4u*)(WT + (size_t)(n0 + n) * K + k0 + 8 * c) = o; }
    LDS_WAIT();
}
__device__ __forceinline__ void transpose_mat(const float* W, int K, int N, bf16* WT, LAS float* scr, int gw, int NGW, int lane) {
    const int items = (K / 64) * (N / 32);
    for (int it = gw; it < items; it += NGW) p0_transpose_item(W, K, N, WT, scr, it, lane);
}

struct Ctx {
    LAS unsigned char* lds; int tid, lane, wave, bid, G, gw, NGW;
};

__device__ __forceinline__ void phase_prologue(const Ctx& F, const float* const* in, unsigned char* ws) {
    float* misc = (float*)(ws + WS_MISC);
    LAS float* scr = (LAS float*)(F.lds + F.wave * 16384);
    for (int j = 0; j < 2; ++j) {
        transpose_mat(in[8] + (size_t)j * D * AW, D, AW, (bf16*)(ws + WS_WAIN) + (size_t)j * AW * D, scr, F.gw, F.NGW, F.lane);
        transpose_mat(in[9] + (size_t)j * D * D, D, D, (bf16*)(ws + WS_WAOUT) + (size_t)j * D * D, scr, F.gw, F.NGW, F.lane);
        transpose_mat(in[13] + (size_t)j * D * HW, D, HW, (bf16*)(ws + WS_WHIN) + (size_t)j * HW * D, scr, F.gw, F.NGW, F.lane);
        transpose_mat(in[25] + (size_t)j * D * D, D, D, (bf16*)(ws + WS_WHOUT) + (size_t)j * D * D, scr, F.gw, F.NGW, F.lane);
    }
    for (int i = 0; i < 4; ++i) {
        transpose_mat(in[27] + (size_t)i * D * FF, D, FF, (bf16*)(ws + WS_WM1) + (size_t)i * FF * D, scr, F.gw, F.NGW, F.lane);
        transpose_mat(in[28] + (size_t)i * FF * D, FF, D, (bf16*)(ws + WS_WM2) + (size_t)i * D * FF, scr, F.gw, F.NGW, F.lane);
    }
    {
        f32x4* X4 = (f32x4*)(ws + WS_X); const f32x4* x4 = (const f32x4*)in[0]; const f32x4* c4 = (const f32x4*)in[2];
        const int gt = F.bid * NTHREADS + F.tid, NGT = F.G * NTHREADS;
        for (int i = gt; i < S * D / 4; i += NGT) X4[i] = x4[i];
        for (int i = gt; i < C * D / 4; i += NGT) X4[S * D / 4 + i] = c4[i];
        for (int i = gt; i < 128 * 32; i += NGT) { const int pos = i >> 5, k = i & 31; const float inv = powf(10000.0f, -(float)(2 * k) / 64.0f); const float a = (float)pos * inv;
            misc[MO_RCOS + i] = cosf(a); misc[MO_RSIN + i] = sinf(a); }
    }
    {
        float* HID = (float*)(ws + WS_HID);
        for (int p = F.gw; p < 2 * S + C; p += F.NGW) {
            int j, i, n; if (p < 2 * S) { j = p >> 13; i = p & (S - 1); n = S; } else { j = 0; i = p - 2 * S; n = C; }
            const float tt = (float)i / (float)(n - 1);
            const float w = (6.283185307179586f * (float)i) / (float)n;
            const int k = (F.lane - 1) & 15; const float fk = 1e-4f + (float)k * ((15.0f - 1e-4f) / 15.0f);
            const float feat = F.lane == 0 ? tt : (F.lane <= 16 ? cosf(fk * w) : (F.lane <= 32 ? -sinf(fk * w) : 0.f));
            const float* w1 = in[17] + (size_t)j * 33 * 64; const float* w2 = in[20] + (size_t)j * 64 * 64;
            float a = in[18][j * 64 + F.lane];
            for (int f = 0; f < 33; ++f) a += __builtin_bit_cast(float, __builtin_amdgcn_readlane(__builtin_bit_cast(int, feat), f)) * w1[f * 64 + F.lane];
            const float h1 = sinf(in[19][j * 64 + F.lane] * a);
            float b = in[21][j * 64 + F.lane];
            for (int q = 0; q < 64; ++q) b += __builtin_bit_cast(float, __builtin_amdgcn_readlane(__builtin_bit_cast(int, h1), q)) * w2[q * 64 + F.lane];
            HID[(size_t)p * 64 + F.lane] = sinf(in[22][j * 64 + F.lane] * b);
        }
    }
    __syncthreads();
    {
        LAS float* s_c = (LAS float*)F.lds; LAS float* s_cc = s_c + D; LAS f32x4* red = (LAS f32x4*)(F.lds + 16384);
        for (int k = F.tid; k < D; k += NTHREADS) { const float a = in[1][k], b = in[3][k]; s_c[k] = a / (1.0f + expf(-a)); s_cc[k] = b / (1.0f + expf(-b)); }
        __syncthreads();
        for (int item = F.bid; item < 4 * 48; item += F.G) {
            const int layer = item / 48, chunk = item % 48, col4 = chunk * 64 + F.lane;
            const f32x4* Wp = (const f32x4*)(in[4] + (size_t)layer * D * NMODW) + col4;
            f32x4 a0 = {0.f, 0.f, 0.f, 0.f}, a1 = {0.f, 0.f, 0.f, 0.f};
#pragma unroll 8
            for (int k = F.wave; k < D; k += 8) { const f32x4 w = Wp[(size_t)k * (NMODW / 4)]; a0 += w * s_c[k]; a1 += w * s_cc[k]; }
            red[(F.wave * 2 + 0) * 64 + F.lane] = a0; red[(F.wave * 2 + 1) * 64 + F.lane] = a1;
            __syncthreads();
            if (F.wave < 2) { f32x4 s = {0.f, 0.f, 0.f, 0.f};
#pragma unroll
                for (int w = 0; w < 8; ++w) s += red[(w * 2 + F.wave) * 64 + F.lane];
                s += ((const f32x4*)(in[5] + (size_t)layer * NMODW))[col4];
                ((f32x4*)(misc + (F.wave ? MO_MODC : MO_MOD) + layer * NMODW))[col4] = s; }
            __syncthreads();
        }
    }
}

__device__ __forceinline__ void phase_filters(const Ctx& F, const float* const* in, unsigned char* ws) {
    float* misc = (float*)(ws + WS_MISC); const float* HID = (const float*)(ws + WS_HID);
    LAS float* red = (LAS float*)F.lds;
    {
        bf16* rg = (bf16*)(ws + WS_FILT);
        for (int q = F.bid * NTHREADS + F.tid; q < 2 * 4096 * 128; q += F.G * NTHREADS) { const int row = q >> 7, e = q & 127; rg[(size_t)row * 8320 + (e < 65 ? e : 8192 + e)] = 0; }
    }
    for (int item = F.bid; item < 2048 + 64; item += F.G) {
        const bool isctx = item >= 2048; int j, g, it, n;
        if (!isctx) { j = item >> 10; g = (item >> 4) & 63; it = item & 15; n = S; } else { j = 0; g = item - 2048; it = 0; n = C; }
        const int i = it * 512 + F.wave * 64 + F.lane; const bool act = i < n;
        const f32x4* hp = (const f32x4*)(HID + ((size_t)(isctx ? 2 * S : j * S) + (act ? i : 0)) * 64);
        float hr[64];
#pragma unroll
        for (int k = 0; k < 16; ++k) { const f32x4 t = hp[k]; hr[4 * k] = t.x; hr[4 * k + 1] = t.y; hr[4 * k + 2] = t.z; hr[4 * k + 3] = t.w; }
        const float offs = fabsf((float)(i - n / 2)) * (2.0f / (float)n);
        float* dstc = (float*)(ws + WS_FILTC); bf16* dstr = (bf16*)(ws + WS_FILT) + (size_t)j * 4096 * 8320;
        { LAS float* wt = (LAS float*)(F.lds + 4096);
          for (int q = F.tid; q < 64 * 64; q += NTHREADS) { const int k = q >> 6, o = q & 63; wt[o * 64 + k] = in[23][(size_t)j * 64 * 4096 + (size_t)k * 4096 + g * 64 + o]; }
          __syncthreads();
          for (int o = 0; o < 64; ++o) {
            const int od = g * 64 + o; const LAS f32x4* w4 = (const LAS f32x4*)(wt + o * 64);
            float a = 0.f;
#pragma unroll
            for (int k = 0; k < 16; ++k) { const f32x4 w = w4[k]; a += hr[4 * k] * w.x + hr[4 * k + 1] * w.y + hr[4 * k + 2] * w.z + hr[4 * k + 3] * w.w; }
            const int d = od & (D - 1); const float delta = fabsf(MIN_DECAY + (float)d * ((MAX_DECAY - MIN_DECAY) / (float)(D - 1)));
            const float h = a * expf(-offs * delta);
            if (act) { if (isctx) dstc[(size_t)od * C + i] = h; else dstr[(size_t)od * 8320 + 8256 - i] = (bf16)f2bf(h); }
            const float ss = wave_sum(act ? h * h : 0.f);
            if (F.lane == 0) red[F.wave * 64 + o] = ss;
          } }
        __syncthreads();
        if (F.tid < 64) { float s = 0.f;
#pragma unroll
            for (int w = 0; w < 8; ++w) s += red[w * 64 + F.tid];
            const int od = g * 64 + F.tid;
            if (isctx) misc[MO_FPARTC + od] = s; else misc[MO_FPART + (j * 4096 + od) * 16 + it] = s; }
        __syncthreads();
    }
}

__device__ __forceinline__ void phase_norm_mod(const Ctx& F, float* X, bf16* H, int nrows, const float* g, const float* shL, const float* scL, const float* shC, const float* scC,
                                               const float* P, int fn, const float* fgate, const float* fbias) {
    for (int r = F.gw; r < nrows; r += F.NGW) {
        f32x4* xr = (f32x4*)(X + (size_t)r * D) + F.lane;
        const f32x4* sh = (const f32x4*)(r < S ? shL : shC) + F.lane; const f32x4* sc = (const f32x4*)(r < S ? scL : scC) + F.lane; const f32x4* g4 = (const f32x4*)g + F.lane;
        f32x4 v[8]; float ss = 0.f;
#pragma unroll
        for (int j = 0; j < 8; ++j) v[j] = xr[64 * j];
        if (r >= S && fn > 0) {
            const f32x4* fg = (const f32x4*)fgate + F.lane;
#pragma unroll
            for (int j = 0; j < 8; ++j) { f32x4 a = fbias ? ((const f32x4*)fbias)[F.lane + 64 * j] : (f32x4){0.f, 0.f, 0.f, 0.f};
                for (int s = 0; s < fn; ++s) a += ((const f32x4*)(P + ((size_t)s * 256 + (r - S)) * D))[F.lane + 64 * j];
                v[j] += fg[64 * j] * a; xr[64 * j] = v[j]; }
        }
#pragma unroll
        for (int j = 0; j < 8; ++j) ss += (v[j].x * v[j].x + v[j].y * v[j].y) + (v[j].z * v[j].z + v[j].w * v[j].w);
        const float rstd = 1.0f / sqrtf(wave_sum(ss) * (1.0f / D) + EPS);
        v2u* o = (v2u*)(H + (size_t)r * D) + F.lane;
#pragma unroll
        for (int j = 0; j < 8; ++j) { const f32x4 y = (v[j] * rstd) * g4[64 * j]; const f32x4 z = y * (1.0f + sc[64 * j]) + sh[64 * j];
            v2u w; w.x = pk2(z.x, z.y); w.y = pk2(z.z, z.w); o[64 * j] = w; }
    }
}
__device__ __forceinline__ void phase_final_norm(const Ctx& F, const float* X, float* out, const float* g) {
    for (int r = F.gw; r < S; r += F.NGW) {
        const f32x4* xr = (const f32x4*)(X + (size_t)r * D) + F.lane; const f32x4* g4 = (const f32x4*)g + F.lane;
        f32x4 v[8]; float ss = 0.f;
#pragma unroll
        for (int j = 0; j < 8; ++j) { v[j] = xr[64 * j]; ss += (v[j].x * v[j].x + v[j].y * v[j].y) + (v[j].z * v[j].z + v[j].w * v[j].w); }
        const float rstd = 1.0f / sqrtf(wave_sum(ss) * (1.0f / D) + EPS);
        f32x4* o = (f32x4*)(out + (size_t)r * D) + F.lane;
#pragma unroll
        for (int j = 0; j < 8; ++j) o[64 * j] = (v[j] * rstd) * g4[64 * j];
    }
}

__device__ __forceinline__ void phase_kprep(const Ctx& F, const bf16* QKV, bf16* KP, bf16* VP, const float* knorm, const float* rcos, const float* rsin) {
    const int p = F.lane & 31, half = F.lane >> 5, da = half * 64 + p, db = da + 32;
    for (int r = F.gw; r < R; r += F.NGW) {
        const bool lat = r < S; const int kr = lat ? C + r : r - S;
        const int pos = half == 0 ? (r >> 6) : (r & 63);
        const float cs = lat ? rcos[pos * 32 + p] : 1.0f, sn = lat ? rsin[pos * 32 + p] : 0.0f;
#pragma unroll
        for (int h = 0; h < 4; ++h) {
            const bf16* src = QKV + (size_t)r * AW + 2048 + h * HD;
            float a = bf2f(src[da]), b = bf2f(src[db]);
            if (h >= 2) { const float ss = wave_sum(a * a + b * b); const float rstd = 1.0f / sqrtf(ss * (1.0f / HD) + EPS); a = a * rstd * knorm[da]; b = b * rstd * knorm[db]; }
            const float oa = a * cs - b * sn, ob = b * cs + a * sn;
            bf16* dst = KP + (size_t)kr * 512 + h * HD; dst[da] = (bf16)f2bf(oa); dst[db] = (bf16)f2bf(ob);
            ((unsigned*)(VP + (size_t)kr * 512 + h * HD))[F.lane] = ((const unsigned*)(QKV + (size_t)r * AW + 2560 + h * HD))[F.lane];
        }
    }
}

__device__ __forceinline__ void phase_attn_naive(const Ctx& F, const bf16* QKV, const bf16* KP, const bf16* VP, bf16* O, int nq, const float* sink, const float* qnorm, const float* rcos, const float* rsin) {
    LAS float* qs = (LAS float*)(F.lds + F.wave * 1024); LAS float* outs = qs + 128;
    const int p = F.lane & 31, half = F.lane >> 5, da = half * 64 + p, db = da + 32;
    const int ks = F.lane & 31, dh = F.lane >> 5;
    for (int it = F.gw; it < nq * 16; it += F.NGW) {
        const int r = it >> 4, h = it & 15; const bool lat = r < S;
        {
            const bf16* src = QKV + (size_t)r * AW + h * HD;
            float a = bf2f(src[da]), b = bf2f(src[db]);
            if (h >= 8) { const float ss = wave_sum(a * a + b * b); const float rstd = 1.0f / sqrtf(ss * (1.0f / HD) + EPS); a = a * rstd * qnorm[da]; b = b * rstd * qnorm[db]; }
            const int pos = half == 0 ? (r >> 6) : (r & 63);
            const float cs = lat ? rcos[pos * 32 + p] : 1.0f, sn = lat ? rsin[pos * 32 + p] : 0.0f;
            qs[da] = (a * cs - b * sn) * QSCALE; qs[db] = (b * cs + a * sn) * QSCALE;
            LDS_WAIT();
        }
        const int kvh = h < 8 ? (h >> 2) : 2 + ((h - 8) >> 2);
        int lo = 0, nl = 0;
        if (lat) { if (h < 8) { lo = r - 128 < 0 ? 0 : r - 128; const int hi = r + 128 > S - 1 ? S - 1 : r + 128; nl = hi - lo + 1; } else { lo = 0; nl = S; } }
        const int total = C + nl;
        float m = -1e30f, l = 0.f; float o[64];
#pragma unroll
        for (int d = 0; d < 64; ++d) o[d] = 0.f;
        if (h < 8 && ks == 0) { m = sink[h]; l = 1.0f; }
        const int nsteps = (total + 31) >> 5;
        for (int st = 0; st < nsteps; ++st) {
            const int kk = st * 32 + ks; const bool valid = kk < total; const int kc = valid ? kk : 0;
            const int krow = kc < C ? kc : C + lo + (kc - C);
            const v4u* kp = (const v4u*)(KP + (size_t)krow * 512 + kvh * HD + dh * 64); const v4u* vp = (const v4u*)(VP + (size_t)krow * 512 + kvh * HD + dh * 64);
            float s = 0.f;
#pragma unroll
            for (int c = 0; c < 8; ++c) { const v4u kv = kp[c]; const LAS f32x4* q4 = (const LAS f32x4*)(qs + dh * 64) + 2 * c; const f32x4 qa = q4[0], qb = q4[1];
                s += bf2f(kv.x & 0xffffu) * qa.x + bf2f(kv.x >> 16) * qa.y + bf2f(kv.y & 0xffffu) * qa.z + bf2f(kv.y >> 16) * qa.w
                   + bf2f(kv.z & 0xffffu) * qb.x + bf2f(kv.z >> 16) * qb.y + bf2f(kv.w & 0xffffu) * qb.z + bf2f(kv.w >> 16) * qb.w; }
            s += xl_x32(s);
            if (valid) {
                const float mn = fmaxf(m, s), al = expf(m - mn), pp = expf(s - mn); l = l * al + pp; m = mn;
#pragma unroll
                for (int c = 0; c < 8; ++c) { const v4u vv = vp[c];
                    o[8 * c + 0] = o[8 * c + 0] * al + pp * bf2f(vv.x & 0xffffu); o[8 * c + 1] = o[8 * c + 1] * al + pp * bf2f(vv.x >> 16);
                    o[8 * c + 2] = o[8 * c + 2] * al + pp * bf2f(vv.y & 0xffffu); o[8 * c + 3] = o[8 * c + 3] * al + pp * bf2f(vv.y >> 16);
                    o[8 * c + 4] = o[8 * c + 4] * al + pp * bf2f(vv.z & 0xffffu); o[8 * c + 5] = o[8 * c + 5] * al + pp * bf2f(vv.z >> 16);
                    o[8 * c + 6] = o[8 * c + 6] * al + pp * bf2f(vv.w & 0xffffu); o[8 * c + 7] = o[8 * c + 7] * al + pp * bf2f(vv.w >> 16); }
            }
        }
        const float M = wave_max(m), f = expf(m - M); const float L = 0.5f * wave_sum(l * f); const float rl = 1.0f / L;
#pragma unroll
        for (int d = 0; d < 64; ++d) { float sd = o[d] * f;
            sd += xl_dpp_b1(sd); sd += xl_dpp_4e(sd); sd += xl_swz4(sd); sd += xl_swz8(sd); sd += xl_swz16(sd);
            if (ks == 0) outs[dh * 64 + d] = sd * rl; }
        LDS_WAIT();
        ((unsigned*)(O + (size_t)r * D + h * HD))[F.lane] = pk2(outs[2 * F.lane], outs[2 * F.lane + 1]);
        LDS_WAIT();
    }
}

__device__ __forceinline__ void phase_shortconv(const Ctx& F, const bf16* UP, bf16* XV, const float* cw, const float* cb, int nrows) {
    const int ntb = nrows / 64, tg = F.lane >> 3, cg = F.lane & 7;
    for (int it = F.gw; it < ntb * 96; it += F.NGW) {
        const int cbk = it / ntb, tb = it % ntb, r0 = tb * 64 + 8 * tg, c0 = cbk * 64 + 8 * cg;
        const int slo = tb < 128 ? 0 : S, shi = tb < 128 ? S : R;
        v4u raw[10];
#pragma unroll
        for (int k = 0; k < 10; ++k) { const int r = r0 - 1 + k; raw[k] = (r >= slo && r < shi) ? *(const v4u*)(UP + (size_t)r * HW + c0) : (v4u){0u, 0u, 0u, 0u}; }
        const f32x4 w0a = *(const f32x4*)(cw + c0), w0b = *(const f32x4*)(cw + c0 + 4), w1a = *(const f32x4*)(cw + HW + c0), w1b = *(const f32x4*)(cw + HW + c0 + 4);
        const f32x4 w2a = *(const f32x4*)(cw + 2 * HW + c0), w2b = *(const f32x4*)(cw + 2 * HW + c0 + 4), ba = *(const f32x4*)(cb + c0), bb = *(const f32x4*)(cb + c0 + 4);
        const float w0[8] = {w0a.x, w0a.y, w0a.z, w0a.w, w0b.x, w0b.y, w0b.z, w0b.w}, w1[8] = {w1a.x, w1a.y, w1a.z, w1a.w, w1b.x, w1b.y, w1b.z, w1b.w};
        const float w2[8] = {w2a.x, w2a.y, w2a.z, w2a.w, w2b.x, w2b.y, w2b.z, w2b.w}, bs[8] = {ba.x, ba.y, ba.z, ba.w, bb.x, bb.y, bb.z, bb.w};
#pragma unroll
        for (int cc = 0; cc < 8; ++cc) {
            float x[10];
#pragma unroll
            for (int k = 0; k < 10; ++k) { const unsigned d = raw[k][cc >> 1]; x[k] = (cc & 1) ? bf2f(d >> 16) : bf2f(d & 0xffffu); }
            float u[8];
#pragma unroll
            for (int j = 0; j < 8; ++j) u[j] = w0[cc] * x[j] + w1[cc] * x[j + 1] + w2[cc] * x[j + 2] + bs[cc];
            v4u o; o.x = pk2(u[0], u[1]); o.y = pk2(u[2], u[3]); o.z = pk2(u[4], u[5]); o.w = pk2(u[6], u[7]);
            *(v4u*)(XV + (size_t)(c0 + cc) * R + r0) = o;
        }
    }
}

__device__ __forceinline__ void conv_naive(const LAS float* zs, const LAS float* Ts, int n, int tid, float (&acc)[16]) {
#pragma unroll
    for (int q = 0; q < 16; ++q) acc[q] = 0.f;
    const int half = n >> 1;
    for (int s = 0; s < n; ++s) { const float zv = zs[s];
#pragma unroll
        for (int q = 0; q < 16; ++q) { const int t = tid + 512 * q; const int idx = t - s + half; const bool ok = ((unsigned)idx < (unsigned)n) && (t < n);
            const float tv = Ts[ok ? idx : 0]; acc[q] += ok ? zv * tv : 0.f; } }
}
__device__ __forceinline__ void phase_longconv_naive(const Ctx& F, const bf16* XV, bf16* ZC, const float* FILT, const float* FILTC, const float* fpart, const float* fpartc, const float* skip, bool with_ctx, bool with_lat) {
    LAS float* zs = (LAS float*)F.lds; LAS float* Ts = zs + S; LAS float* z2 = Ts + S;
    const int nitems = with_ctx ? 2 * D : D;
    for (int it = (with_lat ? 0 : D) + F.bid; it < nitems; it += F.G) {
        const bool isctx = it >= D; const int c = isctx ? it - D : it, n = isctx ? C : S, base = isctx ? S : 0;
        const bf16* vsrc = XV + (size_t)(2 * D + c) * R + base; const bf16* x1 = XV + (size_t)c * R + base; const bf16* x2 = XV + (size_t)(D + c) * R + base;
        float s0, s1;
        if (isctx) { s0 = 1.0f / sqrtf(fpartc[c] + EPS); s1 = 1.0f / sqrtf(fpartc[D + c] + EPS); }
        else { float a = 0.f, b = 0.f; for (int k = 0; k < 16; ++k) { a += fpart[c * 16 + k]; b += fpart[(D + c) * 16 + k]; } s0 = 1.0f / sqrtf(a + EPS); s1 = 1.0f / sqrtf(b + EPS); }
        const float* T0 = isctx ? FILTC + (size_t)c * C : FILT + (size_t)c * S; const float* T1 = isctx ? FILTC + (size_t)(D + c) * C : FILT + (size_t)(D + c) * S;
        for (int t = F.tid; t < n; t += NTHREADS) { zs[t] = bf2f(vsrc[t]); Ts[t] = T0[t]; }
        __syncthreads();
        float acc[16];
        conv_naive(zs, Ts, n, F.tid, acc);
        const float sk0 = skip[c], sk1 = skip[D + c];
#pragma unroll
        for (int q = 0; q < 16; ++q) { const int t = F.tid + 512 * q; if (t < n) z2[t] = bf2f(x1[t]) * (s0 * acc[q] + zs[t] * sk0); }
        __syncthreads();
        for (int t = F.tid; t < n; t += NTHREADS) Ts[t] = T1[t];
        __syncthreads();
        conv_naive(z2, Ts, n, F.tid, acc);
#pragma unroll
        for (int q = 0; q < 16; ++q) { const int t = F.tid + 512 * q; if (t < n) ZC[(size_t)c * R + base + t] = (bf16)f2bf(bf2f(x2[t]) * (s1 * acc[q] + z2[t] * sk1)); }
        __syncthreads();
    }
}
__device__ __forceinline__ void phase_transpose_zc(const Ctx& F, const bf16* ZC, bf16* O, int nrows) {
    LAS unsigned char* scr = F.lds + F.wave * 9216;
    const int ntb = nrows / 64;
    for (int it = F.gw; it < ntb * 32; it += F.NGW) {
        const int cbk = it / ntb, tb = it % ntb, r0 = tb * 64, c0 = cbk * 64;
        v4u raw[8];
#pragma unroll
        for (int k = 0; k < 8; ++k) raw[k] = *(const v4u*)(ZC + (size_t)(c0 + F.lane) * R + r0 + 8 * k);
#pragma unroll
        for (int k = 0; k < 8; ++k)
#pragma unroll
            for (int e = 0; e < 4; ++e) { const unsigned d = raw[k][e]; const int t = 8 * k + 2 * e;
                *(LAS bf16*)(scr + t * 144 + 2 * F.lane) = (bf16)(d & 0xffffu); *(LAS bf16*)(scr + (t + 1) * 144 + 2 * F.lane) = (bf16)(d >> 16); }
        LDS_WAIT();
#pragma unroll
        for (int k = 0; k < 8; ++k) { const int t = 8 * k + (F.lane >> 3), ch = (F.lane & 7) * 8;
            *(v4u*)(O + (size_t)(r0 + t) * D + c0 + ch) = *(const LAS v4u*)(scr + t * 144 + 2 * ch); }
        LDS_WAIT();
    }
}
namespace att {
using bf16x8 = __attribute__((ext_vector_type(8))) short;
using s16x4  = __attribute__((ext_vector_type(4))) short;
using f32x16 = __attribute__((ext_vector_type(16))) float;
using u32x4  = __attribute__((ext_vector_type(4))) unsigned;
constexpr int KVBLK = 64, LDQ = AW, LDK = 512, LDO = D;
constexpr float SCALE = 0.088388347648318440f;
constexpr float THR = 8.f;
constexpr int SDEPTH = 1;
constexpr int SHM_V = KVBLK * 128 * 2, SHM_K = KVBLK * 128 * 2, SHM_ATTN = 2 * SHM_V + 2 * SHM_K + 8 * 64 * 4;
#define KSWZ(row, colB) ((row) * 256 + ((colB) ^ (((row) & 7) << 4)))
#define SBAR() __builtin_amdgcn_sched_barrier(0)
__device__ __forceinline__ int crow(int r, int hi) { return (r & 3) + 8 * (r >> 2) + 4 * hi; }
__device__ __forceinline__ unsigned cvtpk(float lo, float hi) { unsigned r; asm volatile("v_cvt_pk_bf16_f32 %0, %1, %2" : "=v"(r) : "v"(lo), "v"(hi)); return r; }

__device__ __forceinline__ void partialSM(f32x16& p0, f32x16& p1, float& m_reg, float& mn, float& alpha) {
  constexpr float Cc = SCALE * 1.4426950408889634f;
  float pmax = p0[0]; for (int r = 1; r < 16; ++r) pmax = fmaxf(pmax, p0[r]); for (int r = 0; r < 16; ++r) pmax = fmaxf(pmax, p1[r]);
  { auto rr = __builtin_amdgcn_permlane32_swap(__float_as_uint(pmax), __float_as_uint(pmax), false, false);
    pmax = fmaxf(__uint_as_float(rr[0]), __uint_as_float(rr[1])); }
  if (__builtin_expect(__all(pmax - m_reg <= THR / SCALE), 1)) { mn = m_reg; alpha = 1.f; }
  else { mn = fmaxf(m_reg, pmax); alpha = __builtin_amdgcn_exp2f((m_reg - mn) * Cc); m_reg = mn; }
  float mnC = -mn * Cc;
  for (int r = 0; r < 16; ++r) p0[r] = fmaf(p0[r], Cc, mnC); for (int r = 0; r < 16; ++r) p1[r] = fmaf(p1[r], Cc, mnC);
  for (int r = 0; r < 16; ++r) p0[r] = __builtin_amdgcn_exp2f(p0[r]);
}
__device__ __forceinline__ void finishSM(f32x16& p0, f32x16& p1, float alpha, float& l_reg, bf16x8& pa0, bf16x8& pa1, bf16x8& pa2, bf16x8& pa3) {
  for (int r = 0; r < 16; ++r) p1[r] = __builtin_amdgcn_exp2f(p1[r]);
  float ps = 0; for (int r = 0; r < 16; ++r) ps += p0[r]; for (int r = 0; r < 16; ++r) ps += p1[r];
  { auto rr = __builtin_amdgcn_permlane32_swap(__float_as_uint(ps), __float_as_uint(ps), false, false);
    ps = __uint_as_float(rr[0]) + __uint_as_float(rr[1]); }
  l_reg = l_reg * alpha + ps;
#define PK4(P, BASE, OUT) do { unsigned a0 = cvtpk(P[BASE + 0], P[BASE + 1]), a1 = cvtpk(P[BASE + 2], P[BASE + 3]);   \
    unsigned b0 = cvtpk(P[BASE + 4], P[BASE + 5]), b1 = cvtpk(P[BASE + 6], P[BASE + 7]);                              \
    auto r0 = __builtin_amdgcn_permlane32_swap(a0, b0, false, false); auto r1 = __builtin_amdgcn_permlane32_swap(a1, b1, false, false); \
    u32x4 w = {r0[0], r1[0], r0[1], r1[1]}; OUT = *reinterpret_cast<bf16x8*>(&w); } while (0)
  PK4(p0, 0, pa0); PK4(p0, 8, pa1); PK4(p1, 0, pa2); PK4(p1, 8, pa3);
#undef PK4
}
__device__ __forceinline__ void qkt(f32x16& p0, f32x16& p1, const char* Ks, const bf16x8* qr, int r32, int hi) {
  p0 = f32x16{}; p1 = f32x16{};
  for (int d0 = 0; d0 < 8; ++d0) { int cb = (d0 * 16 + hi * 8) * 2;
    bf16x8 b0 = *reinterpret_cast<const bf16x8*>(Ks + KSWZ(r32, cb));
    bf16x8 b1 = *reinterpret_cast<const bf16x8*>(Ks + KSWZ(32 + r32, cb));
    p0 = __builtin_amdgcn_mfma_f32_32x32x16_bf16(b0, qr[d0], p0, 0, 0, 0);
    p1 = __builtin_amdgcn_mfma_f32_32x32x16_bf16(b1, qr[d0], p1, 0, 0, 0); }
}
__device__ __forceinline__ int v_st(int k, int c) { const int kk = (k & ~0xC) | ((k & 4) << 1) | ((k & 8) >> 1); return ((kk >> 3) * 4 + (c >> 5)) * 512 + ((kk & 7) * 32 + (c & 31)) * 2; }
__device__ __forceinline__ int v_rd_base(int lane) { return ((lane & 3) << 3) | (((lane >> 2) & 3) << 6) | (((lane >> 4) & 1) << 5) | (((lane >> 5) & 1) << 8); }
constexpr int v_rd_off(int d0, int ks, int half) { return d0 * 512 + ks * 4096 + half * 2048; }
template <int OFF> __device__ __forceinline__ s16x4 tr_read(int vb) {
  s16x4 r; asm volatile("ds_read_b64_tr_b16 %0, %1 offset:%2" : "=&v"(r) : "v"(vb), "i"(OFF) : "memory"); return r;
}
template <int D0> __device__ __forceinline__ void pv_one(f32x16& od, int vb, bf16x8 pa0, bf16x8 pa1, bf16x8 pa2, bf16x8 pa3) {
  const s16x4 l0 = tr_read<v_rd_off(D0, 0, 0)>(vb), h0 = tr_read<v_rd_off(D0, 0, 1)>(vb), l1 = tr_read<v_rd_off(D0, 1, 0)>(vb), h1 = tr_read<v_rd_off(D0, 1, 1)>(vb);
  const s16x4 l2 = tr_read<v_rd_off(D0, 2, 0)>(vb), h2 = tr_read<v_rd_off(D0, 2, 1)>(vb), l3 = tr_read<v_rd_off(D0, 3, 0)>(vb), h3 = tr_read<v_rd_off(D0, 3, 1)>(vb);
  asm volatile("s_waitcnt lgkmcnt(0)" ::: "memory"); SBAR();
#define PK(L, H) (bf16x8){L[0], L[1], L[2], L[3], H[0], H[1], H[2], H[3]}
  od = __builtin_amdgcn_mfma_f32_32x32x16_bf16(pa0, PK(l0, h0), od, 0, 0, 0);
  od = __builtin_amdgcn_mfma_f32_32x32x16_bf16(pa1, PK(l1, h1), od, 0, 0, 0);
  od = __builtin_amdgcn_mfma_f32_32x32x16_bf16(pa2, PK(l2, h2), od, 0, 0, 0);
  od = __builtin_amdgcn_mfma_f32_32x32x16_bf16(pa3, PK(l3, h3), od, 0, 0, 0);
#undef PK
}
__device__ __forceinline__ void pv_d0(f32x16* o, int vb, bf16x8 pa0, bf16x8 pa1, bf16x8 pa2, bf16x8 pa3) {
  pv_one<0>(o[0], vb, pa0, pa1, pa2, pa3); pv_one<1>(o[1], vb, pa0, pa1, pa2, pa3); pv_one<2>(o[2], vb, pa0, pa1, pa2, pa3); pv_one<3>(o[3], vb, pa0, pa1, pa2, pa3);
}

struct Unit {
    const bf16* Qb;
    const bf16* Kh;
    const bf16* Vh;
    bf16* Ob;
    int NT;
    int lat0;
    int i0;
    int windowed;
    int norm_q;
    float sink; int has_sink;
};

__device__ __forceinline__ void window_mask(f32x16& p0, f32x16& p1, int base, int hi) {
#pragma unroll
  for (int r = 0; r < 16; ++r) { const int d0 = base + crow(r, hi), d1 = d0 + 32;
    p0[r] = (d0 >= -128 && d0 <= 128) ? p0[r] : -__builtin_inff();
    p1[r] = (d1 >= -128 && d1 <= 128) ? p1[r] : -__builtin_inff(); }
}

__device__ __forceinline__ void attn_unit(const Unit u, const float* __restrict__ qn, const float* __restrict__ rcos, const float* __restrict__ rsin, char* lds, const int tid) {
  const int wid = tid >> 6, lane = tid & 63, r32 = lane & 31, hi = lane >> 5;
  char* V_lds = lds; char* K_lds = lds + 2 * SHM_V;
  float* wsx = (float*)(lds + 2 * SHM_V + 2 * SHM_K) + wid * 64; float* li_l = wsx; float* al_l = wsx + 32;
  float m_reg = u.has_sink ? u.sink * (1.0f / SCALE) : -1e30f, l_reg = u.has_sink ? 1.f : 0.f; f32x16 o[4] = {}; bf16x8 qr[8];
  const int qpos = u.i0 + wid * 32 + r32;
  {
    const bf16* Qw = u.Qb + (long)(wid * 32 + r32) * LDQ + hi * 8;
    float qf[8][8];
#pragma unroll
    for (int d0 = 0; d0 < 8; ++d0) { const u32x4 raw = *reinterpret_cast<const u32x4*>(Qw + d0 * 16);
#pragma unroll
      for (int e = 0; e < 4; ++e) { qf[d0][2 * e] = bf2f(raw[e] & 0xffffu); qf[d0][2 * e + 1] = bf2f(raw[e] >> 16); } }
    if (u.norm_q) { float ss = 0.f;
#pragma unroll
      for (int d0 = 0; d0 < 8; ++d0)
#pragma unroll
        for (int e = 0; e < 8; ++e) ss += qf[d0][e] * qf[d0][e];
      ss += xl_x32(ss);
      const float rstd = 1.0f / sqrtf(ss * (1.0f / 128.0f) + EPS);
#pragma unroll
      for (int d0 = 0; d0 < 8; ++d0) { const f32x4 g0 = *(const f32x4*)(qn + d0 * 16 + hi * 8), g1 = *(const f32x4*)(qn + d0 * 16 + hi * 8 + 4);
        qf[d0][0] *= rstd * g0.x; qf[d0][1] *= rstd * g0.y; qf[d0][2] *= rstd * g0.z; qf[d0][3] *= rstd * g0.w;
        qf[d0][4] *= rstd * g1.x; qf[d0][5] *= rstd * g1.y; qf[d0][6] *= rstd * g1.z; qf[d0][7] *= rstd * g1.w; } }
    if (u.i0 >= 0) {
#pragma unroll
      for (int hf = 0; hf < 2; ++hf) { const int pos = hf == 0 ? (qpos >> 6) : (qpos & 63);
#pragma unroll
        for (int dd = 0; dd < 2; ++dd) { const int pb = pos * 32 + dd * 16 + hi * 8;
          const f32x4 c0 = *(const f32x4*)(rcos + pb), c1 = *(const f32x4*)(rcos + pb + 4), s0 = *(const f32x4*)(rsin + pb), s1 = *(const f32x4*)(rsin + pb + 4);
          const float cs[8] = {c0.x, c0.y, c0.z, c0.w, c1.x, c1.y, c1.z, c1.w}, sn[8] = {s0.x, s0.y, s0.z, s0.w, s1.x, s1.y, s1.z, s1.w};
#pragma unroll
          for (int e = 0; e < 8; ++e) { const float a = qf[4 * hf + dd][e], b = qf[4 * hf + dd + 2][e];
            qf[4 * hf + dd][e] = a * cs[e] - b * sn[e]; qf[4 * hf + dd + 2][e] = b * cs[e] + a * sn[e]; } } } }
#pragma unroll
    for (int d0 = 0; d0 < 8; ++d0) { u32x4 w = {cvtpk(qf[d0][0], qf[d0][1]), cvtpk(qf[d0][2], qf[d0][3]), cvtpk(qf[d0][4], qf[d0][5]), cvtpk(qf[d0][6], qf[d0][7])}; qr[d0] = *reinterpret_cast<bf16x8*>(&w); }
  }
  const int sr = tid >> 4, sc = (tid & 15) * 8, vst0 = v_st(sr, sc), vst1 = v_st(32 + sr, sc);
  const int vb0 = (int)(uintptr_t)V_lds + v_rd_base(lane);
  const bf16* Kh = u.Kh; const bf16* Vh = u.Vh; const int lat0 = u.lat0;
  struct { bf16x8 vs0, vs1, ks0, ks1; } sr_[SDEPTH];
#define KOFF(t) (64 * (t) + ((t) >= 4 ? lat0 : 0))
#define SLOAD(i, k0) do { const long _k = (k0); sr_[i].vs0 = *reinterpret_cast<const bf16x8*>(&Vh[(_k + sr) * LDK + sc]); sr_[i].vs1 = *reinterpret_cast<const bf16x8*>(&Vh[(_k + 32 + sr) * LDK + sc]); \
    sr_[i].ks0 = *reinterpret_cast<const bf16x8*>(&Kh[(_k + sr) * LDK + sc]); sr_[i].ks1 = *reinterpret_cast<const bf16x8*>(&Kh[(_k + 32 + sr) * LDK + sc]); } while (0)
#define SWRITE(b, i) do { *(bf16x8*)(V_lds + (b) * SHM_V + vst0) = sr_[i].vs0;          \
    *(bf16x8*)(V_lds + (b) * SHM_V + vst1) = sr_[i].vs1; int kc = sc * 2;               \
    *(bf16x8*)(K_lds + (b) * SHM_K + KSWZ(sr, kc)) = sr_[i].ks0;                       \
    *(bf16x8*)(K_lds + (b) * SHM_K + KSWZ(32 + sr, kc)) = sr_[i].ks1; } while (0)
#define SWAIT() do { if constexpr (SDEPTH == 2) asm volatile("s_waitcnt vmcnt(4)" ::: "memory"); else asm volatile("s_waitcnt vmcnt(0)" ::: "memory"); } while (0)
#define RESC(a) do { if (__any((a) < 1.f)) { if (hi == 0) al_l[r32] = (a); asm volatile("s_waitcnt lgkmcnt(0)" ::: "memory"); \
    for (int d = 0; d < 4; ++d) for (int r = 0; r < 16; ++r) o[d][r] *= al_l[crow(r, hi)]; } } while (0)
#define WMASK(P0, P1, t) do { if (u.windowed && (t) >= 4) { const int _b = KOFF(t) - C - qpos; if (__any(_b < -128 || _b + 63 > 128)) window_mask(P0, P1, _b, hi); } } while (0)
  f32x16 pA0, pA1, pB0, pB1; float mnA, mnB, alA, alB; bf16x8 pa0, pa1, pa2, pa3; const int NT = u.NT;
  constexpr int SE = 0, SO = SDEPTH - 1;
  SLOAD(SE, KOFF(0)); asm volatile("s_waitcnt vmcnt(0)" ::: "memory"); SWRITE(0, SE); __syncthreads();
  qkt(pA0, pA1, K_lds, qr, r32, hi); WMASK(pA0, pA1, 0); partialSM(pA0, pA1, m_reg, mnA, alA);
  SLOAD(SO, KOFF(1)); if constexpr (SDEPTH == 2) { if (2 < NT) SLOAD(SE, KOFF(2)); }
  SWAIT(); SWRITE(1, SO); __syncthreads();
  for (int j = 1; j + 1 < NT; j += 2) {
    SBAR(); qkt(pB0, pB1, K_lds + SHM_K, qr, r32, hi);
    finishSM(pA0, pA1, alA, l_reg, pa0, pa1, pa2, pa3); SBAR();
    SLOAD(SO, KOFF(j + SDEPTH)); SBAR();
    pv_d0(o, vb0, pa0, pa1, pa2, pa3); WMASK(pB0, pB1, j); partialSM(pB0, pB1, m_reg, mnB, alB);
    __syncthreads(); SWAIT(); SWRITE(0, SE);
    RESC(alB); __syncthreads();
    SBAR(); qkt(pA0, pA1, K_lds, qr, r32, hi);
    finishSM(pB0, pB1, alB, l_reg, pa0, pa1, pa2, pa3); SBAR();
    if (SDEPTH == 1 || j + 3 < NT) SLOAD(SE, KOFF(j + 1 + SDEPTH)); SBAR();
    pv_d0(o, vb0 + (int)SHM_V, pa0, pa1, pa2, pa3); WMASK(pA0, pA1, j + 1); partialSM(pA0, pA1, m_reg, mnA, alA);
    __syncthreads(); SWAIT(); SWRITE(1, SO);
    RESC(alA); __syncthreads();
  }
  SBAR(); qkt(pB0, pB1, K_lds + SHM_K, qr, r32, hi);
  finishSM(pA0, pA1, alA, l_reg, pa0, pa1, pa2, pa3); SBAR();
  pv_d0(o, vb0, pa0, pa1, pa2, pa3); WMASK(pB0, pB1, NT - 1); partialSM(pB0, pB1, m_reg, mnB, alB);
  __syncthreads(); RESC(alB);
  finishSM(pB0, pB1, alB, l_reg, pa0, pa1, pa2, pa3); SBAR();
  pv_d0(o, vb0 + (int)SHM_V, pa0, pa1, pa2, pa3);
  if (hi == 0) li_l[r32] = l_reg; asm volatile("s_waitcnt lgkmcnt(0)" ::: "memory");
  float rli[16];
#pragma unroll
  for (int r = 0; r < 16; ++r) rli[r] = __builtin_amdgcn_rcpf(li_l[crow(r, hi)]);
  bf16* Ow = u.Ob + (long)(wid * 32) * LDO;
#pragma unroll
  for (int r = 0; r < 16; ++r) { const int orow = crow(r, hi);
#pragma unroll
    for (int d0 = 0; d0 < 4; ++d0) Ow[(long)orow * LDO + d0 * 32 + r32] = (bf16)f2bf(o[d0][r] * rli[r]); }
  __syncthreads();
#undef KOFF
#undef SLOAD
#undef SWRITE
#undef SWAIT
#undef RESC
#undef WMASK
}
#undef KSWZ
#undef SBAR
}

__device__ __forceinline__ void phase_attn(const Ctx& F, const bf16* QKV, const bf16* KP, const bf16* VP, bf16* O, bool ctx_out, const float* sink, const float* qnorm, const float* rcos, const float* rsin) {
    const int nunits = 256 + 256 + (ctx_out ? 16 : 0);
    for (int un = F.bid; un < nunits; un += F.G) {
        att::Unit u;
        int h, qb, isctx = 0;
        if (un < 256) { h = 8 + (un >> 5); qb = un & 31; }
        else if (un < 512) { h = (un - 256) >> 5; qb = un & 31; }
        else { h = un - 512; qb = 32; isctx = 1; }
        const int kvh = h < 8 ? (h >> 2) : 2 + ((h - 8) >> 2);
        const int row0 = qb * 256;
        u.Qb = QKV + (size_t)row0 * AW + h * HD; u.Kh = KP + kvh * HD; u.Vh = VP + kvh * HD; u.Ob = O + (size_t)row0 * D + h * HD;
        u.i0 = isctx ? -1 : row0; u.norm_q = h >= 8; u.has_sink = h < 8; u.sink = h < 8 ? sink[h] : 0.f;
        if (isctx) { u.NT = 4; u.lat0 = 0; u.windowed = 0; }
        else if (h >= 8) { u.NT = R / 64; u.lat0 = 0; u.windowed = 0; }
        else { const int l0 = row0 - 128 < 0 ? 0 : row0 - 128, l1 = row0 + 384 > S ? S : row0 + 384; u.lat0 = l0; u.NT = 4 + (l1 - l0) / 64; u.windowed = 1; }
        att::attn_unit(u, qnorm, rcos, rsin, (char*)F.lds, F.tid);
    }
}
namespace hconv {
using bf16x8 = __attribute__((ext_vector_type(8))) short;
using f32x16 = __attribute__((ext_vector_type(16))) float;
using u32x4  = __attribute__((ext_vector_type(4))) unsigned;
constexpr int RLEN = 8320, ROFF = 4160;
constexpr int ZPITCH = 144, ZBYTES = 128 * ZPITCH, RBYTES = RLEN * 2, CHBYTES = ZBYTES + RBYTES, ZERO_OFF = 4 * CHBYTES;
static_assert(ZERO_OFF + 128 <= LDS_BYTES - 256, "conv LDS map");
__device__ __forceinline__ int crow(int r, int hi) { return (r & 3) + 8 * (r >> 2) + 4 * hi; }

__device__ __forceinline__ void conv_wave(const LAS unsigned char* zl, const LAS unsigned char* rl, const LAS unsigned char* zero, int nh, int lane, f32x16 (&acc)[2][2]) {
    const int n = lane & 31, hi = lane >> 5;
#pragma unroll
    for (int a = 0; a < 2; ++a)
#pragma unroll
        for (int b = 0; b < 2; ++b) acc[a][b] = f32x16{};
    const int dlo = nh ? -63 : -64, dhi = nh ? 64 : 63;
    const LAS unsigned char* ap = rl + 2 * (8 * hi - 2 * n - 2 + ROFF) - 128 * dlo;
    const int zlane = ZPITCH * n + 16 * hi;
    for (int dl = dlo; dl <= dhi; ++dl, ap -= 128) {
        bf16x8 AE[4], AO[4];
#pragma unroll
        for (int kb = 0; kb < 4; ++kb) {
            const LAS unsigned* p = (const LAS unsigned*)(ap + 32 * kb);
            const unsigned d0 = p[0], d1 = p[1], d2 = p[2], d3 = p[3], d4 = p[4];
            u32x4 e = {d1, d2, d3, d4};
            u32x4 o = {__builtin_amdgcn_alignbit(d1, d0, 16), __builtin_amdgcn_alignbit(d2, d1, 16), __builtin_amdgcn_alignbit(d3, d2, 16), __builtin_amdgcn_alignbit(d4, d3, 16)};
            AE[kb] = *reinterpret_cast<bf16x8*>(&e); AO[kb] = *reinterpret_cast<bf16x8*>(&o);
        }
#pragma unroll
        for (int nt = 0; nt < 2; ++nt) {
            const int lo = 64 * nh + 32 * nt - dl;
            if (lo + 31 < 0 || lo > 127) continue;
            const int sb = lo + n; const bool ok = (unsigned)sb < 128u;
            const LAS unsigned char* bp = ok ? zl + ZPITCH * lo + zlane : zero;
#pragma unroll
            for (int kb = 0; kb < 4; ++kb) {
                const bf16x8 b = *(const LAS bf16x8*)(bp + 32 * kb);
                acc[nt][0] = __builtin_amdgcn_mfma_f32_32x32x16_bf16(AE[kb], b, acc[nt][0], 0, 0, 0);
                acc[nt][1] = __builtin_amdgcn_mfma_f32_32x32x16_bf16(AO[kb], b, acc[nt][1], 0, 0, 0);
            }
        }
    }
}
}

__device__ __forceinline__ void phase_longconv_mfma(const Ctx& F, const bf16* XV, bf16* ZC, const bf16* RG, const float* fpart, const float* skip) {
    using namespace hconv;
    const int chs = F.wave >> 1, nh = F.wave & 1, n = F.lane & 31, hi = F.lane >> 5;
    LAS unsigned char* zl = F.lds + chs * CHBYTES; LAS unsigned char* rl = zl + ZBYTES; LAS unsigned char* zero = F.lds + ZERO_OFF;
    if (F.tid < 32) ((LAS unsigned*)zero)[F.tid] = 0u;
    for (int grp = F.bid; grp < D / 4; grp += F.G) {
        const int c0 = grp * 4, c = c0 + chs;
        for (int q = F.tid; q < 4 * 1024; q += NTHREADS) { const int cc = q >> 10, qq = q & 1023;
            const v4u v = *(const v4u*)(XV + (size_t)(2 * D + c0 + cc) * R + qq * 8);
            *(LAS v4u*)(F.lds + cc * CHBYTES + (qq >> 3) * ZPITCH + (qq & 7) * 16) = v; }
        for (int q = F.tid; q < 4 * (RLEN / 8); q += NTHREADS) { const int cc = q / (RLEN / 8), qq = q % (RLEN / 8);
            *(LAS v4u*)(F.lds + cc * CHBYTES + ZBYTES + qq * 16) = *(const v4u*)(RG + (size_t)(c0 + cc) * RLEN + qq * 8); }
        float s0, s1;
        { const float a = F.lane < 16 ? fpart[c * 16 + F.lane] : 0.f, b = F.lane < 16 ? fpart[(D + c) * 16 + F.lane] : 0.f;
          s0 = 1.0f / sqrtf(wave_sum(a) + EPS); s1 = 1.0f / sqrtf(wave_sum(b) + EPS); }
        const float sk0 = skip[c], sk1 = skip[D + c];
        __syncthreads();
        f32x16 acc[2][2];
        conv_wave(zl, rl, zero, nh, F.lane, acc);
        __syncthreads();
#pragma unroll
        for (int nt = 0; nt < 2; ++nt) { const int tb = 64 * nh + 32 * nt + n;
#pragma unroll
            for (int g = 0; g < 4; ++g) { LAS v4u* zp = (LAS v4u*)(zl + ZPITCH * tb + 2 * (16 * g + 8 * hi));
                const v4u vv = *zp; const v4u xx = *(const v4u*)(XV + (size_t)c * R + 64 * tb + 16 * g + 8 * hi);
                v4u w;
#pragma unroll
                for (int q = 0; q < 4; ++q) { const float ye = acc[nt][0][4 * g + q], yo = acc[nt][1][4 * g + q];
                    const float ze = bf2f(xx[q] & 0xffffu) * (s0 * ye + bf2f(vv[q] & 0xffffu) * sk0), zo = bf2f(xx[q] >> 16) * (s0 * yo + bf2f(vv[q] >> 16) * sk0);
                    w[q] = pk2(ze, zo); }
                *zp = w; } }
        for (int q = F.tid; q < 4 * (RLEN / 8); q += NTHREADS) { const int cc = q / (RLEN / 8), qq = q % (RLEN / 8);
            *(LAS v4u*)(F.lds + cc * CHBYTES + ZBYTES + qq * 16) = *(const v4u*)(RG + (size_t)(D + c0 + cc) * RLEN + qq * 8); }
        __syncthreads();
        conv_wave(zl, rl, zero, nh, F.lane, acc);
#pragma unroll
        for (int nt = 0; nt < 2; ++nt) { const int tb = 64 * nh + 32 * nt + n;
#pragma unroll
            for (int g = 0; g < 4; ++g) { const v4u vv = *(const LAS v4u*)(zl + ZPITCH * tb + 2 * (16 * g + 8 * hi));
                const v4u xx = *(const v4u*)(XV + (size_t)(D + c) * R + 64 * tb + 16 * g + 8 * hi);
                v4u w;
#pragma unroll
                for (int q = 0; q < 4; ++q) { const float ye = acc[nt][0][4 * g + q], yo = acc[nt][1][4 * g + q];
                    const float ze = bf2f(xx[q] & 0xffffu) * (s1 * ye + bf2f(vv[q] & 0xffffu) * sk1), zo = bf2f(xx[q] >> 16) * (s1 * yo + bf2f(vv[q] >> 16) * sk1);
                    w[q] = pk2(ze, zo); }
                *(v4u*)(ZC + (size_t)c * R + 64 * tb + 16 * g + 8 * hi) = w; } }
        __syncthreads();
    }
}

__device__ __forceinline__ void phase_ctxconv(const Ctx& F, const bf16* XV, bf16* ZC, const float* FILTC, const float* fpartc, const float* skip) {
    LAS float* zs = (LAS float*)(F.lds + F.wave * 4096); LAS float* Tp = zs + 256;
    for (int c = F.gw; c < D; c += F.NGW) {
        const bf16* v = XV + (size_t)(2 * D + c) * R + S; const bf16* x1 = XV + (size_t)c * R + S; const bf16* x2 = XV + (size_t)(D + c) * R + S;
        const float s0 = 1.0f / sqrtf(fpartc[c] + EPS), s1 = 1.0f / sqrtf(fpartc[D + c] + EPS), sk0 = skip[c], sk1 = skip[D + c];
        float vv[4], acc[4], z2[4];
#pragma unroll
        for (int q = 0; q < 4; ++q) { vv[q] = bf2f(v[F.lane + 64 * q]); zs[F.lane + 64 * q] = vv[q]; }
#pragma unroll
        for (int q = 0; q < 8; ++q) { const int src = F.lane + 64 * q - 128; Tp[F.lane + 64 * q] = (unsigned)src < 256u ? FILTC[(size_t)c * C + src] : 0.f; }
        LDS_WAIT();
#pragma unroll
        for (int q = 0; q < 4; ++q) acc[q] = 0.f;
        for (int s = 0; s < C; ++s) { const float zv = zs[s];
#pragma unroll
            for (int q = 0; q < 4; ++q) acc[q] += zv * Tp[F.lane + 64 * q - s + 256]; }
#pragma unroll
        for (int q = 0; q < 4; ++q) z2[q] = bf2f(x1[F.lane + 64 * q]) * (s0 * acc[q] + vv[q] * sk0);
        LDS_WAIT();
#pragma unroll
        for (int q = 0; q < 4; ++q) zs[F.lane + 64 * q] = z2[q];
#pragma unroll
        for (int q = 0; q < 8; ++q) { const int src = F.lane + 64 * q - 128; Tp[F.lane + 64 * q] = (unsigned)src < 256u ? FILTC[(size_t)(D + c) * C + src] : 0.f; }
        LDS_WAIT();
#pragma unroll
        for (int q = 0; q < 4; ++q) acc[q] = 0.f;
        for (int s = 0; s < C; ++s) { const float zv = zs[s];
#pragma unroll
            for (int q = 0; q < 4; ++q) acc[q] += zv * Tp[F.lane + 64 * q - s + 256]; }
#pragma unroll
        for (int q = 0; q < 4; ++q) ZC[(size_t)c * R + S + F.lane + 64 * q] = (bf16)f2bf(bf2f(x2[F.lane + 64 * q]) * (s1 * acc[q] + z2[q] * sk1));
        LDS_WAIT();
    }
}
#ifndef RP_PRO
#define RP_PRO 1
#endif
#ifndef RP_FIL
#define RP_FIL 1
#endif
#ifndef RP_THIN
#define RP_THIN 1
#endif
#ifndef RP_ATT
#define RP_ATT 1
#endif
#ifndef RP_CONV
#define RP_CONV 1
#endif
#ifndef RP_GIN
#define RP_GIN 1
#endif
#ifndef RP_GUP
#define RP_GUP 1
#endif
#define REP(n) for (int rep_ = 0; rep_ < (n); ++rep_)
#define REPSYNC __syncthreads();
struct Args { const float* in[30]; float* out; unsigned char* ws; int ph_lo, ph_hi; };
constexpr int N_PHASES = 2 + 4 * 9 + 1;

__global__ void __launch_bounds__(NTHREADS, 2) fwd(Args args) {
    extern __shared__ __attribute__((aligned(16))) unsigned char lds_raw[];
    Ctx F;
    F.lds = (LAS unsigned char*)lds_raw;
    F.tid = threadIdx.x; F.lane = F.tid & 63; F.wave = __builtin_amdgcn_readfirstlane(F.tid >> 6);
    F.bid = blockIdx.x; F.G = gridDim.x; F.gw = F.bid * NWAVES + F.wave; F.NGW = F.G * NWAVES;
    unsigned char* ws = args.ws;
    volatile LAS unsigned* MISC = (volatile LAS unsigned*)(F.lds + MISC_OFF);
    if (F.tid < 32) MISC[F.tid] = 0u;
    __syncthreads();
    XcdBarrier bar; bar.bar = (unsigned*)(ws + WS_CTL) + CW_BAR; bar.x = 0; bar.st = nullptr;
#if MK_ONE_LAUNCH
    bar = xcd_barrier_post((unsigned*)(ws + WS_CTL) + CW_BAR, MISC + 8);
#endif
    const int lo = args.ph_lo, hi = args.ph_hi;
    int ph = 0;
#define PH_BEGIN if (ph >= lo && ph < hi) { int tid_ = threadIdx.x; asm volatile("" : "+v"(tid_)); F.tid = tid_; F.lane = tid_ & 63;
#if MK_ONE_LAUNCH
#define PH_END if (ph + 1 < hi) xcd_barrier(bar); } ++ph;
#else
#define PH_END } ++ph;
#endif
    const float* const* in = args.in;
    float* misc = (float*)(ws + WS_MISC);
    float* X = (float*)(ws + WS_X); bf16* H = (bf16*)(ws + WS_H); bf16* QKV = (bf16*)(ws + WS_QKV); bf16* KP = (bf16*)(ws + WS_KP); bf16* VP = (bf16*)(ws + WS_VP);
    bf16* O = (bf16*)(ws + WS_O); bf16* U = (bf16*)(ws + WS_U); bf16* UP = (bf16*)(ws + WS_UP); bf16* XV = (bf16*)(ws + WS_XV); bf16* ZC = (bf16*)(ws + WS_ZC);
    const float* rcos = misc + MO_RCOS; const float* rsin = misc + MO_RSIN; float* PART = (float*)(ws + WS_PART);

    PH_BEGIN REP(RP_PRO) { phase_prologue(F, in, ws); REPSYNC } PH_END
    PH_BEGIN REP(RP_FIL) { phase_filters(F, in, ws); REPSYNC } PH_END

    for (int i = 0; i < DEPTH; ++i) {
        const int j = i >> 1; const bool is_attn = (i & 1) == 0, ctx_upd = i < 2, has_ctx = is_attn || ctx_upd;
        const int nrows1 = has_ctx ? R : S, nrows2 = ctx_upd ? R : S;
        const float* mod = misc + MO_MOD + i * NMODW; const float* modc = misc + MO_MODC + i * NMODW;
        PH_BEGIN REP(RP_THIN) { phase_norm_mod(F, X, H, nrows1, in[6] + i * D, mod, mod + D, modc, modc + D, PART, (i == 1 || i == 2) ? KS_DOWN : 0, modc - NMODW + 5 * D, nullptr); REPSYNC } PH_END
        PH_BEGIN REP(RP_GIN) { const int N = is_attn ? AW : HW;
            pg8::Gemm g{H, is_attn ? (const bf16*)(ws + WS_WAIN) + (size_t)j * AW * D : (const bf16*)(ws + WS_WHIN) + (size_t)j * HW * D, nrows1, N, D};
            pg8::StaticOrder So; So.init(nrows1, N, D, F.G, F.bid);
            pg8::EpiBf16<0> E{is_attn ? QKV : UP, N, is_attn ? nullptr : in[14] + j * HW};
            pg8::gemm_phase<pg8::EpiBf16<0>, pg8::StaticOrder, PG8_ALIGN, PG8_SP2>(F.lds, g, So, E, F.tid); REPSYNC } PH_END
        if (is_attn) {
            PH_BEGIN REP(RP_THIN) { phase_kprep(F, QKV, KP, VP, in[12] + j * HD, rcos, rsin); REPSYNC } PH_END
            PH_BEGIN REP(RP_ATT) { phase_attn(F, QKV, KP, VP, O, ctx_upd, in[10] + j * 8, in[11] + j * HD, rcos, rsin); REPSYNC } PH_END
            ++ph;
        } else {
            PH_BEGIN REP(RP_THIN) { phase_shortconv(F, UP, XV, in[15] + (size_t)j * 3 * HW, in[16] + j * HW, nrows2); REPSYNC } PH_END
            PH_BEGIN REP(RP_CONV) { phase_longconv_mfma(F, XV, ZC, (const bf16*)(ws + WS_FILT) + (size_t)j * 4096 * 8320, misc + MO_FPART + j * 4096 * 16, in[24] + j * 2 * D);
                if (ctx_upd) { __syncthreads(); phase_ctxconv(F, XV, ZC, (const float*)(ws + WS_FILTC), misc + MO_FPARTC, in[24] + j * 2 * D); } REPSYNC } PH_END
            PH_BEGIN REP(RP_THIN) { phase_transpose_zc(F, ZC, O, nrows2); REPSYNC } PH_END
        }
        PH_BEGIN { pg8::Gemm g{O, is_attn ? (const bf16*)(ws + WS_WAOUT) + (size_t)j * D * D : (const bf16*)(ws + WS_WHOUT) + (size_t)j * D * D, S, D, D};
            pg8::StaticOrder So; So.init(S, D, D, F.G, F.bid); if (ctx_upd) So.extend(S / 256, KS_OUT);
            pg8::EpiResGate E{X, D, is_attn ? nullptr : in[26] + j * D, mod + 2 * D, modc + 2 * D, S / 256, PART};
            pg8::gemm_phase<pg8::EpiResGate, pg8::StaticOrder, PG8_ALIGN, PG8_SP2>(F.lds, g, So, E, F.tid); } PH_END
        PH_BEGIN REP(RP_THIN) { phase_norm_mod(F, X, H, nrows2, in[7] + i * D, mod + 3 * D, mod + 4 * D, modc + 3 * D, modc + 4 * D, PART, ctx_upd ? KS_OUT : 0, modc + 2 * D, is_attn ? nullptr : in[26] + j * D); REPSYNC } PH_END
        PH_BEGIN REP(RP_GUP) { pg8::Gemm g{H, (const bf16*)(ws + WS_WM1) + (size_t)i * FF * D, nrows2, FF, D}; pg8::StaticOrder So; So.init(nrows2, FF, D, F.G, F.bid);
            pg8::EpiBf16<1> E{U, FF, nullptr};
            pg8::gemm_phase<pg8::EpiBf16<1>, pg8::StaticOrder, PG8_ALIGN, PG8_SP2>(F.lds, g, So, E, F.tid); REPSYNC } PH_END
        PH_BEGIN { pg8::Gemm g{U, (const bf16*)(ws + WS_WM2) + (size_t)i * D * FF, S, D, FF}; pg8::StaticOrder So; So.init(S, D, FF, F.G, F.bid); if (ctx_upd) So.extend(S / 256, KS_DOWN);
            pg8::EpiResGate E{X, D, nullptr, mod + 5 * D, modc + 5 * D, S / 256, PART};
            pg8::gemm_phase<pg8::EpiResGate, pg8::StaticOrder, PG8_ALIGN, PG8_SP2>(F.lds, g, So, E, F.tid); } PH_END
    }
    PH_BEGIN REP(RP_THIN) { phase_final_norm(F, X, args.out, in[29]); REPSYNC } PH_END
#undef PH_BEGIN
#undef PH_END
}

extern "C" void kernel_launch(void* const* d_in, const int* in_sizes, int n_in, void* d_out, int out_size, void* d_ws, size_t ws_size, hipStream_t stream) {
    static int grid = 0;
    if (grid == 0) {
        if (n_in != 30 || out_size != S * D || ws_size < WS_END) { fprintf(stderr, "kernel_launch: unexpected shapes: n_in %d out %d ws %zu (need %zu)\n", n_in, out_size, ws_size, (size_t)WS_END); grid = -1; return; }
        int dev = 0, cus = 0, per_cu = 0;
        if (hipGetDevice(&dev) != hipSuccess || hipDeviceGetAttribute(&cus, hipDeviceAttributeMultiprocessorCount, dev) != hipSuccess) { grid = -1; return; }
        if (hipFuncSetAttribute((const void*)fwd, hipFuncAttributeMaxDynamicSharedMemorySize, LDS_BYTES) != hipSuccess) { fprintf(stderr, "kernel_launch: hipFuncSetAttribute failed\n"); grid = -1; return; }
        if (hipOccupancyMaxActiveBlocksPerMultiprocessor(&per_cu, (const void*)fwd, NTHREADS, LDS_BYTES) != hipSuccess || per_cu < 1)
            fprintf(stderr, "kernel_launch: occupancy query reports %d workgroups per CU\n", per_cu);
        (void)hipGetLastError();
        grid = cus;
    }
    if (grid < 0) return;
    (void)hipMemsetAsync((char*)d_ws + WS_CTL, 0, CTL_ZERO_BYTES, stream);
    Args a{};
    for (int i = 0; i < 30; ++i) a.in[i] = (const float*)d_in[i];
    a.out = (float*)d_out; a.ws = (unsigned char*)d_ws;
#if MK_ONE_LAUNCH
    a.ph_lo = 0; a.ph_hi = N_PHASES;
    hipLaunchKernelGGL(fwd, dim3(grid), dim3(NTHREADS), LDS_BYTES, stream, a);
#else
    for (int p = 0; p < N_PHASES; ++p) { a.ph_lo = p; a.ph_hi = p + 1; hipLaunchKernelGGL(fwd, dim3(grid), dim3(NTHREADS), LDS_BYTES, stream, a); }
#endif
    const hipError_t le = hipPeekAtLastError();
    if (le != hipSuccess) fprintf(stderr, "kernel_launch: launch failed: %s\n", hipGetErrorName(le));
}
```

```cpp
#include <hip/hip_runtime.h>
#include <cstdio>
#include <cstdint>
#define MK_ONE_LAUNCH 1
#ifndef ATT16
#define ATT16 0
#endif
#ifndef PG8_WGM
#define PG8_WGM 4
#endif
namespace pg8 {
#define PG8_LAS __attribute__((address_space(3)))
typedef unsigned short bf16_t;
typedef short bf16x8 __attribute__((ext_vector_type(8)));
typedef float f32x4 __attribute__((ext_vector_type(4)));
typedef unsigned u32x4 __attribute__((ext_vector_type(4)));
constexpr int BM = 256, BK = 64, HALF = 128, HTB = HALF * BK * 2  , STAGE_BYTES = 8 * HTB, NXCD = 8, WGM = PG8_WGM;

__host__ __device__ __forceinline__ int lds_byte(int r, int c) { const int st = (r >> 4) * 2 + (c >> 5), rr = r & 15, cc = c & 31, ob = rr * 64 + cc * 2; return st * 1024 + (ob ^ (((ob >> 9) & 1) << 5)); }
__host__ __device__ __forceinline__ void stage_rc(int b, int& R, int& C) { const int st = b / 1024, sb = b % 1024, swz = sb ^ (((sb >> 9) & 1) << 5); R = (st >> 1) * 16 + swz / 64; C = (st & 1) * 32 + (swz % 64) / 2; }
__host__ __device__ __forceinline__ int perm32(int rho) { const int n = rho >> 4, i = rho & 15; return 8 * (i >> 2) + 4 * n + (i & 3); }

struct Unit { int pm, pn; int ko, nt, split; };
struct Gemm { const bf16_t* A; const bf16_t* Bt; int M, N, K; };

struct StaticOrder {
    int nM, nN, nwg, G, c, ntk;
    int xpm, xks, xnt;
    __host__ __device__ void init(int M, int N, int K, int G_, int c_) { nM = M / BM; nN = N / BM; nwg = nM * nN; G = G_; c = c_; ntk = K / BK; xpm = 0; xks = 0; xnt = 0; }
    __host__ __device__ void extend(int pm, int ks) { xpm = pm; xks = ks; xnt = ntk / ks; }
    __host__ __device__ bool next(int i, Unit& u) const {
        const long L = (long)i * G + c; if (L >= nwg + xks * nN) return false;
        const bool ext = L >= nwg;
        int wgid = ext ? 0 : (int)L; { const int q = nwg / NXCD, r = nwg % NXCD, xcd = wgid % NXCD, off = wgid / NXCD; wgid = (xcd < r ? xcd * (q + 1) : r * (q + 1) + (xcd - r) * q) + off; }
        const int nig = WGM * nN, gid = wgid / nig, fm = gid * WGM, gsz = (nM - fm) < WGM ? (nM - fm) : WGM;
        const int pm_s = fm + ((wgid % nig) % gsz), pn_s = (wgid % nig) / gsz;
        const int q = ext ? (int)(L - nwg) : 0, ks = q / nN;
        u.pm = ext ? xpm : pm_s; u.pn = ext ? q - ks * nN : pn_s; u.ko = ext ? ks * xnt : 0; u.nt = ext ? xnt : ntk; u.split = ext ? 1 + ks : 0;
        return true;
    }
    __device__ __forceinline__ void a_ready(const Unit&) const {}
    __device__ __forceinline__ void done(const Unit&) const {}
};

__device__ __forceinline__ unsigned cvt_pk_bf16(float lo, float hi) { unsigned r; asm("v_cvt_pk_bf16_f32 %0, %1, %2" : "=v"(r) : "v"(lo), "v"(hi)); return r; }

template <int ACT> struct EpiBf16 {
    static constexpr bool PERM = true, AFTER_DRAIN = false;
    bf16_t* O; int ldc; const float* bias;
    __device__ __forceinline__ void operator()(const f32x4 (&acc)[2][2][4][2], const Unit& u, int wr, int wc, int fr, int fq) const {
        const int row0 = u.pm * BM + wr * 64 + fr; const int col0 = u.pn * BM + wc * 32 + 8 * fq;
        f32x4 bv[2][2];
#pragma unroll
        for (int bj = 0; bj < 2; ++bj)
#pragma unroll
            for (int n = 0; n < 2; ++n) bv[bj][n] = bias ? *(const f32x4*)(bias + col0 + bj * HALF + 4 * n) : (f32x4){0.f, 0.f, 0.f, 0.f};
#pragma unroll
        for (int ai = 0; ai < 2; ++ai)
#pragma unroll
            for (int m = 0; m < 4; ++m) { bf16_t* rowp = O + (size_t)(row0 + ai * HALF + m * 16) * ldc + col0;
#pragma unroll
                for (int bj = 0; bj < 2; ++bj) { f32x4 v0 = acc[ai][bj][m][0] + bv[bj][0], v1 = acc[ai][bj][m][1] + bv[bj][1];
                    if (ACT == 1) {
#pragma unroll
                        for (int j = 0; j < 4; ++j) { const float a = fmaxf(v0[j], 0.f), b = fmaxf(v1[j], 0.f); v0[j] = a * a; v1[j] = b * b; } }
                    u32x4 w; w.x = cvt_pk_bf16(v0[0], v0[1]); w.y = cvt_pk_bf16(v0[2], v0[3]); w.z = cvt_pk_bf16(v1[0], v1[1]); w.w = cvt_pk_bf16(v1[2], v1[3]);
                    *(u32x4*)(rowp + bj * HALF) = w; } }
    }
};
struct EpiResGate {
    static constexpr bool PERM = true, AFTER_DRAIN = false;
    bf16_t* X; int ldc; const float* bias; const float* gate_lat; const float* gate_ctx; int ctx_pm; float* P;
    __device__ __forceinline__ void operator()(const f32x4 (&acc)[2][2][4][2], const Unit& u, int wr, int wc, int fr, int fq) const {
        const int col0 = u.pn * BM + wc * 32 + 8 * fq;
        if (u.split) {
            float* base = P + ((size_t)(u.split - 1) * BM + wr * 64 + fr) * ldc + col0;
#pragma unroll
            for (int ai = 0; ai < 2; ++ai)
#pragma unroll
                for (int m = 0; m < 4; ++m) { float* rowp = base + (size_t)(ai * HALF + m * 16) * ldc;
#pragma unroll
                    for (int bj = 0; bj < 2; ++bj)
#pragma unroll
                        for (int n = 0; n < 2; ++n) *(f32x4*)(rowp + bj * HALF + n * 4) = acc[ai][bj][m][n]; }
            return;
        }
        const int row0 = u.pm * BM + wr * 64 + fr;
        const float* gate = (u.pm >= ctx_pm) ? gate_ctx : gate_lat;
        f32x4 bv[2][2], gv[2][2];
#pragma unroll
        for (int bj = 0; bj < 2; ++bj)
#pragma unroll
            for (int n = 0; n < 2; ++n) { bv[bj][n] = bias ? *(const f32x4*)(bias + col0 + bj * HALF + n * 4) : (f32x4){0.f, 0.f, 0.f, 0.f};
                gv[bj][n] = *(const f32x4*)(gate + col0 + bj * HALF + n * 4); }
#pragma unroll
        for (int ai = 0; ai < 2; ++ai)
#pragma unroll
            for (int m = 0; m < 4; ++m) { bf16_t* rowp = X + (size_t)(row0 + ai * HALF + m * 16) * ldc + col0;
#pragma unroll
                for (int bj = 0; bj < 2; ++bj) { u32x4* p = (u32x4*)(rowp + bj * HALF); const u32x4 old = *p;
                    const f32x4 v0 = gv[bj][0] * (acc[ai][bj][m][0] + bv[bj][0]), v1 = gv[bj][1] * (acc[ai][bj][m][1] + bv[bj][1]);
                    u32x4 w;
                    w.x = cvt_pk_bf16(__builtin_bit_cast(float, old.x << 16) + v0[0], __builtin_bit_cast(float, old.x & 0xffff0000u) + v0[1]);
                    w.y = cvt_pk_bf16(__builtin_bit_cast(float, old.y << 16) + v0[2], __builtin_bit_cast(float, old.y & 0xffff0000u) + v0[3]);
                    w.z = cvt_pk_bf16(__builtin_bit_cast(float, old.z << 16) + v1[0], __builtin_bit_cast(float, old.z & 0xffff0000u) + v1[1]);
                    w.w = cvt_pk_bf16(__builtin_bit_cast(float, old.w << 16) + v1[2], __builtin_bit_cast(float, old.w & 0xffff0000u) + v1[3]);
                    *p = w; } }
    }
};

struct EpiNull {
    static constexpr bool PERM = true, AFTER_DRAIN = false;
    __device__ __forceinline__ void operator()(const f32x4 (&acc)[2][2][4][2], const Unit&, int, int, int, int) const {
#pragma unroll
        for (int ai = 0; ai < 2; ++ai)
#pragma unroll
            for (int bj = 0; bj < 2; ++bj)
#pragma unroll
                for (int m = 0; m < 4; ++m)
#pragma unroll
                    for (int n = 0; n < 2; ++n) asm volatile("" :: "v"(acc[ai][bj][m][n]));
    }
};

template <class Epi, class Sched, bool ALIGN_EPI = false, bool SP2 = false>
__device__ __forceinline__ void gemm_phase(PG8_LAS unsigned char* lds, const Gemm g, const Sched& S, const Epi& E, const int tid) {
    const int wid = __builtin_amdgcn_readfirstlane(tid >> 6), lane = tid & 63, wr = wid >> 2, wc = wid & 3, fr = lane & 15, fq = lane >> 4;
    const int K = g.K;
    unsigned voffA[2], voffB[2];
#pragma unroll
    for (int i = 0; i < 2; ++i) { int R, C; stage_rc(tid * 16 + i * 8192, R, C); const int Rb = Epi::PERM ? ((R & ~31) + perm32(R & 31)) : R;
        voffA[i] = (unsigned)(R * K + C) * 2u; voffB[i] = (unsigned)(Rb * K + C) * 2u; }
    const size_t kstep = (size_t)(BK * 2);
    const size_t hstep = (size_t)HALF * K * 2;
    const size_t tstep = 2 * hstep;
    const unsigned ldsw = (unsigned)wid * 1024u;
    const int aoff = lds_byte(wr * 64 + fr, fq * 8), boff = lds_byte(wc * 32 + fr, fq * 8);
#define PG8_SA(b, h) (((b) * 2 + (h)) * HTB)
#define PG8_SB(b, h) ((4 + (b) * 2 + (h)) * HTB)
#define PG8_STAGE(bufoff, gbase, voff) do { _Pragma("unroll") for (int _i = 0; _i < 2; ++_i) \
        __builtin_amdgcn_global_load_lds((const unsigned*)((const char*)(gbase) + (voff)[_i]), (PG8_LAS unsigned*)(lds + (bufoff) + ldsw + _i * 8192), 16, 0, 0); } while (0)
#define PG8_LDA(dst, b, h) do { _Pragma("unroll") for (int m = 0; m < 4; ++m) _Pragma("unroll") for (int k = 0; k < 2; ++k) dst[m][k] = *(const PG8_LAS bf16x8*)(lds + PG8_SA(b, h) + aoff + m * 2048 + k * 1024); } while (0)
#define PG8_LDB(dst, b, h) do { _Pragma("unroll") for (int n = 0; n < 2; ++n) _Pragma("unroll") for (int k = 0; k < 2; ++k) dst[n][k] = *(const PG8_LAS bf16x8*)(lds + PG8_SB(b, h) + boff + n * 2048 + k * 1024); } while (0)
#define PG8_MMA(ai, bj, At, Bt) do { __builtin_amdgcn_s_setprio(1); _Pragma("unroll") for (int m = 0; m < 4; ++m) _Pragma("unroll") for (int n = 0; n < 2; ++n) _Pragma("unroll") for (int k = 0; k < 2; ++k) \
        acc[ai][bj][m][n] = __builtin_amdgcn_mfma_f32_16x16x32_bf16(Bt[n][k], At[m][k], acc[ai][bj][m][n], 0, 0, 0); __builtin_amdgcn_s_setprio(0); } while (0)
#define PG8_WAIT_V(n) asm volatile("s_waitcnt vmcnt(" #n ")" ::: "memory")
#define PG8_WAIT_L(n) asm volatile("s_waitcnt lgkmcnt(" #n ")" ::: "memory")
#define PG8_BAR __builtin_amdgcn_s_barrier()
#define PG8_SCHED __builtin_amdgcn_sched_barrier(0)
    Unit cur, nxt; int ui = 0;
    if (!S.next(0, cur)) return;
    f32x4 acc[2][2][4][2];
#pragma unroll
    for (int a = 0; a < 2; ++a)
#pragma unroll
        for (int b = 0; b < 2; ++b)
#pragma unroll
            for (int m = 0; m < 4; ++m)
#pragma unroll
                for (int n = 0; n < 2; ++n) acc[a][b][m][n] = (f32x4){0.f, 0.f, 0.f, 0.f};
    bf16x8 At[4][2], B0[2][2], B1[2][2];
    const char* cA = (const char*)g.A + (size_t)cur.pm * tstep + (size_t)cur.ko * (BK * 2); const char* cB = (const char*)g.Bt + (size_t)cur.pn * tstep + (size_t)cur.ko * (BK * 2);
    S.a_ready(cur);
    if constexpr (SP2) {
        PG8_STAGE(PG8_SB(0, 0), cB, voffB); PG8_STAGE(PG8_SB(0, 1), cB + hstep, voffB); PG8_STAGE(PG8_SA(0, 0), cA, voffA); PG8_STAGE(PG8_SA(0, 1), cA + hstep, voffA);
        if (wr == 1) PG8_BAR;
        PG8_WAIT_V(2); PG8_BAR;
        PG8_STAGE(PG8_SB(1, 0), cB + kstep, voffB); PG8_STAGE(PG8_SA(1, 0), cA + kstep, voffA); PG8_STAGE(PG8_SB(1, 1), cB + hstep + kstep, voffB);
        PG8_WAIT_V(6); PG8_BAR;
    } else {
        PG8_STAGE(PG8_SB(0, 0), cB, voffB); PG8_STAGE(PG8_SA(0, 0), cA, voffA); PG8_STAGE(PG8_SB(0, 1), cB + hstep, voffB); PG8_STAGE(PG8_SA(0, 1), cA + hstep, voffA);
        if (wr == 1) PG8_BAR;
        PG8_WAIT_V(4); PG8_BAR;
        PG8_STAGE(PG8_SB(1, 0), cB + kstep, voffB); PG8_STAGE(PG8_SA(1, 0), cA + kstep, voffA); PG8_STAGE(PG8_SB(1, 1), cB + hstep + kstep, voffB);
        PG8_WAIT_V(6); PG8_BAR;
    }
    for (;;) {
        const bool has_next = S.next(ui + 1, nxt);
        const char* nA = has_next ? (const char*)g.A + (size_t)nxt.pm * tstep + (size_t)nxt.ko * (BK * 2) : cA; const char* nB = has_next ? (const char*)g.Bt + (size_t)nxt.pn * tstep + (size_t)nxt.ko * (BK * 2) : cB;
        const int nt = cur.nt;
        for (int t = 0; t < nt; t += 2) {
            const bool last = (t == nt - 2);
            const char* a1 = cA + (size_t)(t + 1) * kstep;
            const char* a2 = last ? nA : cA + (size_t)(t + 2) * kstep; const char* b2 = last ? nB : cB + (size_t)(t + 2) * kstep;
            const char* a3 = a2 + kstep; const char* b3 = b2 + kstep;
            if (last && has_next) S.a_ready(nxt);
            if constexpr (SP2) {
            PG8_LDB(B0, 0, 0); PG8_LDB(B1, 0, 1); PG8_SCHED; PG8_LDA(At, 0, 0); PG8_STAGE(PG8_SA(1, 1), a1 + hstep, voffA);
            PG8_WAIT_V(8); PG8_WAIT_L(0); PG8_BAR; PG8_MMA(0, 0, At, B0); PG8_MMA(0, 1, At, B1); PG8_BAR; PG8_SCHED;
            PG8_LDA(At, 0, 1); PG8_STAGE(PG8_SB(0, 0), b2, voffB); PG8_STAGE(PG8_SB(0, 1), b2 + hstep, voffB); PG8_STAGE(PG8_SA(0, 0), a2, voffA);
            PG8_WAIT_V(8); PG8_WAIT_L(0); PG8_BAR; PG8_MMA(1, 0, At, B0); PG8_MMA(1, 1, At, B1); PG8_BAR; PG8_SCHED;
            PG8_LDB(B0, 1, 0); PG8_LDB(B1, 1, 1); PG8_SCHED; PG8_LDA(At, 1, 0); PG8_STAGE(PG8_SA(0, 1), a2 + hstep, voffA);
            PG8_WAIT_V(8); PG8_WAIT_L(0); PG8_BAR; PG8_MMA(0, 0, At, B0); PG8_MMA(0, 1, At, B1); PG8_BAR; PG8_SCHED;
            PG8_LDA(At, 1, 1); PG8_STAGE(PG8_SB(1, 0), b3, voffB); PG8_STAGE(PG8_SB(1, 1), b3 + hstep, voffB); PG8_STAGE(PG8_SA(1, 0), a3, voffA);
            PG8_WAIT_V(8); PG8_WAIT_L(0); PG8_BAR; PG8_MMA(1, 0, At, B0); PG8_MMA(1, 1, At, B1); PG8_BAR; PG8_SCHED;
            } else {
            PG8_LDB(B0, 0, 0); PG8_SCHED; PG8_LDA(At, 0, 0); PG8_STAGE(PG8_SA(1, 1), a1 + hstep, voffA);
            PG8_WAIT_L(8); PG8_BAR; PG8_WAIT_L(0); PG8_MMA(0, 0, At, B0); PG8_BAR; PG8_SCHED;
            PG8_LDB(B1, 0, 1); PG8_STAGE(PG8_SB(0, 0), b2, voffB);
            PG8_BAR; PG8_WAIT_L(0); PG8_MMA(0, 1, At, B1); PG8_BAR;
            PG8_LDA(At, 0, 1); PG8_STAGE(PG8_SA(0, 0), a2, voffA);
            PG8_BAR; PG8_WAIT_L(0); PG8_MMA(1, 0, At, B0); PG8_BAR; PG8_SCHED;
            PG8_STAGE(PG8_SB(0, 1), b2 + hstep, voffB);
            PG8_WAIT_V(6); PG8_BAR; PG8_MMA(1, 1, At, B1); PG8_BAR;
            PG8_LDB(B0, 1, 0); PG8_SCHED; PG8_LDA(At, 1, 0); PG8_STAGE(PG8_SA(0, 1), a2 + hstep, voffA);
            PG8_WAIT_L(8); PG8_BAR; PG8_WAIT_L(0); PG8_MMA(0, 0, At, B0); PG8_BAR; PG8_SCHED;
            PG8_LDB(B1, 1, 1); PG8_STAGE(PG8_SB(1, 0), b3, voffB);
            PG8_BAR; PG8_WAIT_L(0); PG8_MMA(0, 1, At, B1); PG8_BAR;
            PG8_LDA(At, 1, 1); PG8_STAGE(PG8_SA(1, 0), a3, voffA);
            PG8_BAR; PG8_WAIT_L(0); PG8_MMA(1, 0, At, B0); PG8_BAR; PG8_SCHED;
            PG8_STAGE(PG8_SB(1, 1), b3 + hstep, voffB);
            PG8_WAIT_V(6); PG8_BAR; PG8_MMA(1, 1, At, B1); PG8_BAR;
            }
        }
        if constexpr (ALIGN_EPI) { if (wr == 0) PG8_BAR; }
        if constexpr (!Epi::AFTER_DRAIN) { E(acc, cur, wr, wc, fr, fq); S.done(cur); }
        if (!has_next) break;
#pragma unroll
        for (int a = 0; a < 2; ++a)
#pragma unroll
            for (int b = 0; b < 2; ++b)
#pragma unroll
                for (int m = 0; m < 4; ++m)
#pragma unroll
                    for (int n = 0; n < 2; ++n) acc[a][b][m][n] = (f32x4){0.f, 0.f, 0.f, 0.f};
        cur = nxt; cA = nA; cB = nB; ++ui;
        if constexpr (ALIGN_EPI) { if (wr == 1) PG8_BAR; }
    }
    PG8_WAIT_V(0);
    if constexpr (!ALIGN_EPI) { if (wr == 0) PG8_BAR; }
    PG8_BAR;
    if constexpr (Epi::AFTER_DRAIN) { E.fused(acc, cur, wr, wc, fr, fq, lds, wid, lane); S.done(cur); }
#undef PG8_SA
#undef PG8_SB
#undef PG8_STAGE
#undef PG8_LDA
#undef PG8_LDB
#undef PG8_MMA
#undef PG8_WAIT_V
#undef PG8_WAIT_L
#undef PG8_BAR
#undef PG8_SCHED
}
}
#ifndef PG8_SP2
#define PG8_SP2 true
#endif
#ifndef PG8_ALIGN
#define PG8_ALIGN true
#endif
#ifndef MK_ONE_LAUNCH
#define MK_ONE_LAUNCH 0
#endif

constexpr int D = 2048, S = 8192, C = 256, R = S + C, DEPTH = 4, HD = 128;
constexpr int AW = 3072, HW = 6144, FF = 8192, NMODW = 6 * D;
constexpr float EPS = 1e-6f;
constexpr float QSCALE = 0.08838834764831845f;
constexpr float MIN_DECAY = -3.0701134573253944f, MAX_DECAY = -15.350567286626973f;
constexpr int NWAVES = 8, NTHREADS = 512;
#ifndef KS_DOWN_V
#define KS_DOWN_V 16
#endif
#ifndef KS_OUT_V
#define KS_OUT_V 4
#endif
constexpr int KS_OUT = KS_OUT_V, KS_DOWN = KS_DOWN_V;

constexpr size_t MiB = 1u << 20;
constexpr size_t WS_CTL = 0, CTL_ZERO_BYTES = 1 * MiB;
constexpr size_t WS_WAIN = 1 * MiB;
constexpr size_t WS_WAOUT = WS_WAIN + 24 * MiB;
constexpr size_t WS_WHIN = WS_WAOUT + 16 * MiB;
constexpr size_t WS_WHOUT = WS_WHIN + 48 * MiB;
constexpr size_t WS_WM1 = WS_WHOUT + 16 * MiB;
constexpr size_t WS_WM2 = WS_WM1 + 128 * MiB;
constexpr size_t WS_X = WS_WM2 + 128 * MiB;
constexpr size_t WS_H = WS_X + 66 * MiB;
constexpr size_t WS_QKV = WS_H + 33 * MiB;
constexpr size_t WS_KP = WS_QKV + 50 * MiB;
constexpr size_t WS_VP = WS_KP + 9 * MiB;
constexpr size_t WS_O = WS_VP + 9 * MiB;
constexpr size_t WS_U = WS_O + 33 * MiB;
constexpr size_t WS_UP = WS_U + 132 * MiB;
constexpr size_t WS_XV = WS_UP + 99 * MiB;
constexpr size_t WS_ZC = WS_XV + 99 * MiB;
constexpr size_t WS_FILT = WS_ZC + 33 * MiB;
constexpr size_t WS_FILTC = WS_FILT + 256 * MiB;
constexpr size_t WS_HID = WS_FILTC + 4 * MiB;
constexpr size_t WS_MISC = WS_HID + 5 * MiB;
constexpr size_t WS_PART = WS_MISC + 2 * MiB;
constexpr size_t WS_END = WS_PART + 32 * MiB;
constexpr int MO_MOD = 0, MO_MODC = MO_MOD + 4 * NMODW, MO_RCOS = MO_MODC + 4 * NMODW, MO_RSIN = MO_RCOS + 128 * 32, MO_FPART = MO_RSIN + 128 * 32, MO_FPARTC = MO_FPART + 2 * 4096 * 32, MO_END = MO_FPARTC + 4096 * 8;
static_assert((size_t)MO_END * 4 <= 2 * MiB, "misc");
constexpr int CW_BAR = 4096;

constexpr int LDS_BYTES = 147456;
constexpr int MISC_OFF = LDS_BYTES - 256;

typedef const float* const __attribute__((address_space(4)))* InTab;
#define GAS __attribute__((address_space(1)))
#define LAS __attribute__((address_space(3)))
typedef unsigned short bf16;
typedef unsigned v4u __attribute__((ext_vector_type(4)));
typedef unsigned v2u __attribute__((ext_vector_type(2)));
typedef float f32x4 __attribute__((ext_vector_type(4)));
#define LDS_WAIT() asm volatile("s_waitcnt lgkmcnt(0)" ::: "memory")
__device__ __forceinline__ unsigned f2bf(float f) { unsigned u = __builtin_bit_cast(unsigned, f); return (u + 0x7fffu + ((u >> 16) & 1u)) >> 16; }
__device__ __forceinline__ unsigned pk2(float lo, float hi) { unsigned r; asm("v_cvt_pk_bf16_f32 %0, %1, %2" : "=v"(r) : "v"(lo), "v"(hi)); return r; }
__device__ __forceinline__ float bf2f(unsigned b) { return __builtin_bit_cast(float, b << 16); }
__device__ __forceinline__ float xl_dpp_b1(float v) { return __builtin_bit_cast(float, __builtin_amdgcn_update_dpp(0, __builtin_bit_cast(int, v), 0xB1, 0xF, 0xF, true)); }
__device__ __forceinline__ float xl_dpp_4e(float v) { return __builtin_bit_cast(float, __builtin_amdgcn_update_dpp(0, __builtin_bit_cast(int, v), 0x4E, 0xF, 0xF, true)); }
__device__ __forceinline__ float xl_swz4(float v)  { return __builtin_bit_cast(float, __builtin_amdgcn_ds_swizzle(__builtin_bit_cast(int, v), 0x101F)); }
__device__ __forceinline__ float xl_swz8(float v)  { return __builtin_bit_cast(float, __builtin_amdgcn_ds_swizzle(__builtin_bit_cast(int, v), 0x201F)); }
__device__ __forceinline__ float xl_swz16(float v) { return __builtin_bit_cast(float, __builtin_amdgcn_ds_swizzle(__builtin_bit_cast(int, v), 0x401F)); }
__device__ __forceinline__ float xl_x32(float v) { const unsigned u = __builtin_bit_cast(unsigned, v); auto rr = __builtin_amdgcn_permlane32_swap(u, u, false, false);
    return __builtin_bit_cast(float, (unsigned)((threadIdx.x & 32) ? rr[0] : rr[1])); }
__device__ __forceinline__ float wave_sum(float v) {
    v += xl_dpp_b1(v); v += xl_dpp_4e(v); v += xl_swz4(v); v += xl_swz8(v); v += xl_swz16(v);
    { const unsigned u = __builtin_bit_cast(unsigned, v); auto rr = __builtin_amdgcn_permlane32_swap(u, u, false, false); v = __builtin_bit_cast(float, (unsigned)rr[0]) + __builtin_bit_cast(float, (unsigned)rr[1]); }
    return v;
}
__device__ __forceinline__ float wave_max(float v) {
    v = fmaxf(v, xl_dpp_b1(v)); v = fmaxf(v, xl_dpp_4e(v)); v = fmaxf(v, xl_swz4(v)); v = fmaxf(v, xl_swz8(v)); v = fmaxf(v, xl_swz16(v));
    { const unsigned u = __builtin_bit_cast(unsigned, v); auto rr = __builtin_amdgcn_permlane32_swap(u, u, false, false); v = fmaxf(__builtin_bit_cast(float, (unsigned)rr[0]), __builtin_bit_cast(float, (unsigned)rr[1])); }
    return v;
}
#define XB_SPIN_CAP_OVERRIDE 1
#define XB_TMO      128
#define XB_XCNT(j)  (256  + 64 * (j))
#define XB_XSUB(j)  (1280 + 64 * (j))
#define XB_XGEN(j)  (2304 + 64 * (j))
#define XB_TOP      3328
#define XB_TOPGEN   3392
#define XCD_BAR_WORDS 3456
#define XB_SPIN_CAP (1u << 22)

__device__ __forceinline__ unsigned xb_ld(unsigned* p)              { return __hip_atomic_load(p, __ATOMIC_RELAXED, __HIP_MEMORY_SCOPE_AGENT); }
__device__ __forceinline__ unsigned xb_add(unsigned* p, unsigned v) { return __hip_atomic_fetch_add(p, v, __ATOMIC_RELAXED, __HIP_MEMORY_SCOPE_AGENT); }
__device__ __forceinline__ unsigned xb_xcc_id() { return (unsigned)__builtin_amdgcn_s_getreg((3 << 11) | 20) & 0xFu; }
#define XB_SPIN(cond, bar) do { unsigned _sp = 0; while (cond) { __builtin_amdgcn_s_sleep(1); \
    if ((++_sp & 255u) == 0u) { if (xb_ld(&(bar)[XB_TMO])) break; if (_sp > XB_SPIN_CAP) { atomicAdd(&(bar)[XB_TMO], 1u); break; } } } } while (0)

struct XcdBarrier {
    unsigned* bar; unsigned x;
    volatile LAS unsigned* st;
};

__device__ __forceinline__ XcdBarrier xcd_barrier_post(unsigned* bar, volatile LAS unsigned* st) {
    XcdBarrier b; b.bar = bar; b.x = xb_xcc_id(); b.st = st;
    if (threadIdx.x == 0) (void)xb_add(&bar[XB_XCNT(b.x)], 1u);
    return b;
}
__device__ __forceinline__ void xcd_barrier_complete(unsigned* bar, unsigned x, unsigned& nloc, unsigned& nx) {
    const unsigned G = gridDim.x * gridDim.y * gridDim.z;
    unsigned sum, cnt, mine, sp = 0u;
    for (;;) {
        sum = 0u; cnt = 0u; mine = 0u;
#pragma unroll
        for (unsigned j = 0; j < 16; ++j) { const unsigned c = xb_ld(&bar[XB_XCNT(j)]); sum += c; cnt += (c > 0u) ? 1u : 0u; mine = (j == x) ? c : mine; }
        if (sum == G) break;
        __builtin_amdgcn_s_sleep(1);
        if ((++sp & 255u) == 0u) { if (xb_ld(&bar[XB_TMO])) break; if (sp > XB_SPIN_CAP) { atomicAdd(&bar[XB_TMO], 1u); break; } }
    }
    nloc = mine > 0u ? mine : 1u; nx = cnt > 0u ? cnt : 1u;
}

__device__ __forceinline__ void xcd_barrier(const XcdBarrier& b) {
    asm volatile("s_waitcnt vmcnt(0)" ::: "memory");
    __syncthreads();
    if (threadIdx.x == 0) {
        unsigned* bar = b.bar;
        __builtin_amdgcn_s_waitcnt(0);
        unsigned nloc = b.st[0], nx = b.st[1];
        if (nloc == 0u) { xcd_barrier_complete(bar, b.x, nloc, nx); b.st[0] = nloc; b.st[1] = nx; }
        const unsigned old = xb_add(&bar[XB_XSUB(b.x)], 1u);
        const unsigned gen = old / nloc;
        if (old + 1u == (gen + 1u) * nloc) {
            __builtin_amdgcn_fence(__ATOMIC_RELEASE, "agent");
            asm volatile("s_waitcnt vmcnt(0)" ::: "memory");
            const unsigned og = xb_add(&bar[XB_TOP], 1u);
            const unsigned tg = og / nx;
            if (og + 1u == (tg + 1u) * nx) xb_add(&bar[XB_TOPGEN], 1u);
            else XB_SPIN(xb_ld(&bar[XB_TOPGEN]) == tg, bar);
            __builtin_amdgcn_fence(__ATOMIC_ACQUIRE, "agent");
            xb_add(&bar[XB_XGEN(b.x)], 1u);
            asm volatile("s_waitcnt vmcnt(0)" ::: "memory");
        } else {
            XB_SPIN(xb_ld(&bar[XB_XGEN(b.x)]) == gen, bar);
            __builtin_amdgcn_fence(__ATOMIC_ACQUIRE, "agent");
            asm volatile("s_waitcnt vmcnt(0)" ::: "memory");
        }
    }
    __syncthreads();
}

#ifndef MLPW_IN_PROLOGUE
#define MLPW_IN_PROLOGUE 0
#endif
__device__ __forceinline__ void p0_transpose_item(const float* W, int K, int N, bf16* WT, LAS float* scr, int item, int lane) {
    const int nblk = N / 32, kb = item / nblk, nb = item % nblk, k0 = 64 * kb, n0 = 32 * nb;
#pragma unroll 8
    for (int i = 0; i < 32; ++i) { const int kk = 2 * i + (lane >> 5); scr[kk * 33 + (lane & 31)] = W[(size_t)(k0 + kk) * N + n0 + (lane & 31)]; }
    LDS_WAIT();
    const int c = lane & 7;
#pragma unroll
    for (int j = 0; j < 4; ++j) { const int n = (lane >> 3) + 8 * j; const LAS float* s = scr + (8 * c) * 33 + n;
        v4u o; o.x = pk2(s[0 * 33], s[1 * 33]); o.y = pk2(s[2 * 33], s[3 * 33]); o.z = pk2(s[4 * 33], s[5 * 33]); o.w = pk2(s[6 * 33], s[7 * 33]);
        *(v4u*)(WT + (size_t)(n0 + n) * K + k0 + 8 * c) = o; }
    LDS_WAIT();
}
__device__ __forceinline__ void transpose_mat(const float* W, int K, int N, bf16* WT, LAS float* scr, int gw, int NGW, int lane) {
    const int items = (K / 64) * (N / 32);
    for (int it = gw; it < items; it += NGW) p0_transpose_item(W, K, N, WT, scr, it, lane);
}

struct Ctx {
    LAS unsigned char* lds; int tid, lane, wave, bid, G, gw, NGW;
};

__device__ __forceinline__ void phase_prologue(const Ctx& F, InTab in, unsigned char* ws) {
    float* misc = (float*)(ws + WS_MISC);
    LAS float* scr = (LAS float*)(F.lds + F.wave * 16384);
    for (int j = 0; j < 2; ++j) {
        transpose_mat(in[8] + (size_t)j * D * AW, D, AW, (bf16*)(ws + WS_WAIN) + (size_t)j * AW * D, scr, F.gw, F.NGW, F.lane);
        transpose_mat(in[9] + (size_t)j * D * D, D, D, (bf16*)(ws + WS_WAOUT) + (size_t)j * D * D, scr, F.gw, F.NGW, F.lane);
        transpose_mat(in[13] + (size_t)j * D * HW, D, HW, (bf16*)(ws + WS_WHIN) + (size_t)j * HW * D, scr, F.gw, F.NGW, F.lane);
        transpose_mat(in[25] + (size_t)j * D * D, D, D, (bf16*)(ws + WS_WHOUT) + (size_t)j * D * D, scr, F.gw, F.NGW, F.lane);
    }
#if MLPW_IN_PROLOGUE
    for (int i = 0; i < 4; ++i) {
        transpose_mat(in[27] + (size_t)i * D * FF, D, FF, (bf16*)(ws + WS_WM1) + (size_t)i * FF * D, scr, F.gw, F.NGW, F.lane);
        transpose_mat(in[28] + (size_t)i * FF * D, FF, D, (bf16*)(ws + WS_WM2) + (size_t)i * D * FF, scr, F.gw, F.NGW, F.lane);
    }
#endif
    {
        v4u* X8 = (v4u*)(ws + WS_X); const f32x4* x4 = (const f32x4*)in[0]; const f32x4* c4 = (const f32x4*)in[2];
        const int gt = F.bid * NTHREADS + F.tid, NGT = F.G * NTHREADS;
        for (int i = gt; i < S * D / 8; i += NGT) { const f32x4 a = x4[2 * i], b = x4[2 * i + 1]; v4u w; w.x = pk2(a.x, a.y); w.y = pk2(a.z, a.w); w.z = pk2(b.x, b.y); w.w = pk2(b.z, b.w); X8[i] = w; }
        for (int i = gt; i < C * D / 8; i += NGT) { const f32x4 a = c4[2 * i], b = c4[2 * i + 1]; v4u w; w.x = pk2(a.x, a.y); w.y = pk2(a.z, a.w); w.z = pk2(b.x, b.y); w.w = pk2(b.z, b.w); X8[S * D / 8 + i] = w; }
        for (int i = gt; i < 128 * 32; i += NGT) { const int pos = i >> 5, k = i & 31; const float inv = powf(10000.0f, -(float)(2 * k) / 64.0f); const float a = (float)pos * inv;
            misc[MO_RCOS + i] = cosf(a); misc[MO_RSIN + i] = sinf(a); }
    }
    {
        float* HID = (float*)(ws + WS_HID);
        for (int p = F.gw; p < 2 * S + C; p += F.NGW) {
            int j, i, n; if (p < 2 * S) { j = p >> 13; i = p & (S - 1); n = S; } else { j = 0; i = p - 2 * S; n = C; }
            const float tt = (float)i / (float)(n - 1);
            const float w = (6.283185307179586f * (float)i) / (float)n;
            const int k = (F.lane - 1) & 15; const float fk = 1e-4f + (float)k * ((15.0f - 1e-4f) / 15.0f);
            const float feat = F.lane == 0 ? tt : (F.lane <= 16 ? cosf(fk * w) : (F.lane <= 32 ? -sinf(fk * w) : 0.f));
            const float* w1 = in[17] + (size_t)j * 33 * 64; const float* w2 = in[20] + (size_t)j * 64 * 64;
            float a = in[18][j * 64 + F.lane];
            for (int f = 0; f < 33; ++f) a += __builtin_bit_cast(float, __builtin_amdgcn_readlane(__builtin_bit_cast(int, feat), f)) * w1[f * 64 + F.lane];
            const float h1 = sinf(in[19][j * 64 + F.lane] * a);
            float b = in[21][j * 64 + F.lane];
            for (int q = 0; q < 64; ++q) b += __builtin_bit_cast(float, __builtin_amdgcn_readlane(__builtin_bit_cast(int, h1), q)) * w2[q * 64 + F.lane];
            HID[(size_t)p * 64 + F.lane] = sinf(in[22][j * 64 + F.lane] * b);
        }
    }
    __syncthreads();
    {
        LAS float* s_c = (LAS float*)F.lds; LAS float* s_cc = s_c + D; LAS f32x4* red = (LAS f32x4*)(F.lds + 16384);
        for (int k = F.tid; k < D; k += NTHREADS) { const float a = in[1][k], b = in[3][k]; s_c[k] = a / (1.0f + expf(-a)); s_cc[k] = b / (1.0f + expf(-b)); }
        __syncthreads();
        for (int item = F.bid; item < 4 * 48; item += F.G) {
            const int layer = item / 48, chunk = item % 48, col4 = chunk * 64 + F.lane;
            const f32x4* Wp = (const f32x4*)(in[4] + (size_t)layer * D * NMODW) + col4;
            f32x4 a0 = {0.f, 0.f, 0.f, 0.f}, a1 = {0.f, 0.f, 0.f, 0.f};
#pragma unroll 8
            for (int k = F.wave; k < D; k += 8) { const f32x4 w = Wp[(size_t)k * (NMODW / 4)]; a0 += w * s_c[k]; a1 += w * s_cc[k]; }
            red[(F.wave * 2 + 0) * 64 + F.lane] = a0; red[(F.wave * 2 + 1) * 64 + F.lane] = a1;
            __syncthreads();
            if (F.wave < 2) { f32x4 s = {0.f, 0.f, 0.f, 0.f};
#pragma unroll
                for (int w = 0; w < 8; ++w) s += red[(w * 2 + F.wave) * 64 + F.lane];
                s += ((const f32x4*)(in[5] + (size_t)layer * NMODW))[col4];
                ((f32x4*)(misc + (F.wave ? MO_MODC : MO_MOD) + layer * NMODW))[col4] = s; }
            __syncthreads();
        }
    }
}

constexpr int FCH = 32;
#if MLPW_IN_PROLOGUE
constexpr int NFW = 8;
#else
constexpr int NFW = 4;
#endif
__device__ __forceinline__ void fwave_meet(LAS unsigned* cnt, unsigned& target, int lane) {
    target += (unsigned)NFW;
    asm volatile("s_waitcnt lgkmcnt(0)" ::: "memory");
    if (lane == 0) __hip_atomic_fetch_add(cnt, 1u, __ATOMIC_RELAXED, __HIP_MEMORY_SCOPE_WORKGROUP);
    while (__hip_atomic_load(cnt, __ATOMIC_RELAXED, __HIP_MEMORY_SCOPE_WORKGROUP) < target) __builtin_amdgcn_s_sleep(1);
    asm volatile("" ::: "memory");
}
__device__ __forceinline__ void p0_item_load(const float* W, int N, int item, int lane, float (&r)[32]) {
    const int nblk = N / 32, kb = item / nblk, nb = item % nblk, k0 = 64 * kb, n0 = 32 * nb;
    unsigned off = ((unsigned)(k0 + (lane >> 5)) * (unsigned)N + (unsigned)(n0 + (lane & 31))) * 4u;
#pragma unroll
    for (int i = 0; i < 32; ++i) { r[i] = *(const float*)((const char*)W + off); off += 8u * (unsigned)N; asm volatile("" : "+v"(off)); }
}
__device__ __forceinline__ void p0_item_store(const float (&r)[32], int K, int N, bf16* WT, LAS float* scr, int item, int lane) {
    const int nblk = N / 32, kb = item / nblk, nb = item % nblk, k0 = 64 * kb, n0 = 32 * nb;
#pragma unroll
    for (int i = 0; i < 32; ++i) { const int kk = 2 * i + (lane >> 5); scr[kk * 33 + (lane & 31)] = r[i]; }
    LDS_WAIT();
    const int c = lane & 7;
#pragma unroll
    for (int j = 0; j < 4; ++j) { const int n = (lane >> 3) + 8 * j; const LAS float* s = scr + (8 * c) * 33 + n;
        v4u o; o.x = pk2(s[0 * 33], s[1 * 33]); o.y = pk2(s[2 * 33], s[3 * 33]); o.z = pk2(s[4 * 33], s[5 * 33]); o.w = pk2(s[6 * 33], s[7 * 33]);
        *(v4u*)(WT + (size_t)(n0 + n) * K + k0 + 8 * c) = o; }
    LDS_WAIT();
}
__device__ __forceinline__ void phase_filters(const Ctx& F, InTab in, unsigned char* ws) {
    typedef float f32x16 __attribute__((ext_vector_type(16)));
    constexpr int HL_BYTES = 256 * 144;
    LAS unsigned* fcnt = (LAS unsigned*)(F.lds + HL_BYTES + 4 * 8448);
    if (F.tid == 0) *fcnt = 0u;
    __syncthreads();
    if (F.wave >= NFW) {
        LAS float* scr = (LAS float*)(F.lds + HL_BYTES + (F.wave - 4) * 8448);
        const int cw = F.bid * 4 + (F.wave - 4), NCW = F.G * 4;
#if MLPW_IN_PROLOGUE
        constexpr int ITEMS = 0;
#else
        constexpr int ITEMS = 8 * 8192;
#endif
        float ra[32], rb[32], rc[32];
#define MLPW_SRC(it_) (((it_) >> 13) < 4 ? in[27] + (size_t)((it_) >> 13) * D * FF : in[28] + (size_t)(((it_) >> 13) - 4) * FF * D)
#define MLPW_DST(it_) (((it_) >> 13) < 4 ? (bf16*)(ws + WS_WM1) + (size_t)((it_) >> 13) * FF * D : (bf16*)(ws + WS_WM2) + (size_t)(((it_) >> 13) - 4) * D * FF)
#define MLPW_K(it_) (((it_) >> 13) < 4 ? D : FF)
#define MLPW_N(it_) (((it_) >> 13) < 4 ? FF : D)
#define MLPW_LD(it_, R_) p0_item_load(MLPW_SRC(it_), MLPW_N(it_), (it_) & 8191, F.lane, R_)
#define MLPW_ST(it_, R_) p0_item_store(R_, MLPW_K(it_), MLPW_N(it_), MLPW_DST(it_), scr, (it_) & 8191, F.lane)
        int it = cw;
        if (it < ITEMS) MLPW_LD(it, ra);
        if (it + NCW < ITEMS) MLPW_LD(it + NCW, rb);
        for (; it < ITEMS; it += 3 * NCW) {
            const int i1 = it + NCW, i2 = it + 2 * NCW, i3 = it + 3 * NCW, i4 = it + 4 * NCW;
            if (i2 < ITEMS) MLPW_LD(i2, rc);
            MLPW_ST(it, ra);
            if (i1 < ITEMS) { if (i3 < ITEMS) MLPW_LD(i3, ra); MLPW_ST(i1, rb); }
            if (i2 < ITEMS) { if (i4 < ITEMS) MLPW_LD(i4, rb); MLPW_ST(i2, rc); }
        }
#undef MLPW_LD
#undef MLPW_ST
#undef MLPW_SRC
#undef MLPW_DST
#undef MLPW_K
#undef MLPW_N
        return;
    }
    float* misc = (float*)(ws + WS_MISC); const float* HID = (const float*)(ws + WS_HID);
    {
        bf16* rg = (bf16*)(ws + WS_FILT);
        for (int q = F.bid * (NFW * 64) + F.tid; q < 2 * 4096 * 128; q += F.G * (NFW * 64)) { const int row = q >> 7, e = q & 127; rg[(size_t)row * 8320 + (e < 64 ? e : 8192 + e)] = 0; }
    }
    LAS unsigned char* hl = F.lds;
    const int n32 = F.lane & 31, hi = F.lane >> 5;
    unsigned meet = 0u;
    typedef short bf16x8_ __attribute__((ext_vector_type(8)));
    for (int item = F.bid; item < 2 * 16 * FCH + 128; item += F.G) {
        const bool isctx = item >= 2 * 16 * FCH; int j, g, ch, n, tlo = 0, thi = 8;
        if (!isctx) { j = item / (16 * FCH); g = (item / FCH) & 15; ch = item % FCH; n = S; } else { j = 0; g = (item - 2 * 16 * FCH) >> 3; ch = 0; n = C; tlo = (item - 2 * 16 * FCH) & 7; thi = tlo + 1; }
        const float* hsrc = HID + ((size_t)(isctx ? 2 * S : j * S) + ch * 256) * 64;
        fwave_meet(fcnt, meet, F.lane);
        for (int q = F.tid; q < 256 * 16; q += NFW * 64) { const f32x4 v = ((const f32x4*)hsrc)[q]; v2u w; w.x = pk2(v.x, v.y); w.y = pk2(v.z, v.w); *(LAS v2u*)(hl + (q >> 4) * 144 + (q & 15) * 8) = w; }
        fwave_meet(fcnt, meet, F.lane);
#pragma unroll 1
        for (int pass = 0; pass < 8 / NFW; ++pass) {
            const int od0 = g * 256 + (F.wave + NFW * pass) * 32, od = od0 + n32;
            bf16x8_ bw[4];
#pragma unroll
            for (int ks = 0; ks < 4; ++ks) { float t[8];
#pragma unroll
                for (int e = 0; e < 8; ++e) t[e] = in[23][(size_t)j * 64 * 4096 + (size_t)(16 * ks + 8 * hi + e) * 4096 + od];
                v4u w; w.x = pk2(t[0], t[1]); w.y = pk2(t[2], t[3]); w.z = pk2(t[4], t[5]); w.w = pk2(t[6], t[7]); bw[ks] = *reinterpret_cast<bf16x8_*>(&w); }
            const float dl2 = fabsf(MIN_DECAY + (float)(od & (D - 1)) * ((MAX_DECAY - MIN_DECAY) / (float)(D - 1))) * 1.4426950408889634f;
            float ssq = 0.f;
            bf16* rrow = (bf16*)(ws + WS_FILT) + ((size_t)j * 4096 + od) * 8320; float* crow_ = (float*)(ws + WS_FILTC) + (size_t)od * C;
            for (int t = tlo; t < thi; ++t) {
                f32x16 acc = {};
                const LAS unsigned char* ap_ = hl + (t * 32 + n32) * 144 + 16 * hi;
#pragma unroll
                for (int ks = 0; ks < 4; ++ks) acc = __builtin_amdgcn_mfma_f32_32x32x16_bf16(*(const LAS bf16x8_*)(ap_ + 32 * ks), bw[ks], acc, 0, 0, 0);
#pragma unroll
                for (int q4 = 0; q4 < 4; ++q4) { const int p0 = ch * 256 + t * 32 + 8 * q4 + 4 * hi; float h[4];
#pragma unroll
                    for (int e = 0; e < 4; ++e) { const float offs = fabsf((float)(p0 + e - n / 2)) * (2.0f / (float)n); h[e] = acc[4 * q4 + e] * __builtin_amdgcn_exp2f(-offs * dl2); ssq += h[e] * h[e]; }
                    if (isctx) *(f32x4*)(crow_ + p0) = (f32x4){h[0], h[1], h[2], h[3]};
                    else { v2u w; w.x = pk2(h[3], h[2]); w.y = pk2(h[1], h[0]); *(v2u*)(rrow + 8252 - p0) = w; } }
            }
            ssq += xl_x32(ssq);
            if (hi == 0) { if (isctx) misc[MO_FPARTC + od * 8 + tlo] = ssq; else misc[MO_FPART + (j * 4096 + od) * FCH + ch] = ssq; }
        }
    }
}

__device__ __forceinline__ void unpack8(const v4u w, float (&v)[8]) {
#pragma unroll
    for (int e = 0; e < 4; ++e) { v[2 * e] = bf2f(w[e] & 0xffffu); v[2 * e + 1] = bf2f(w[e] >> 16); }
}
__device__ __forceinline__ void ld8f(const float* p, float (&v)[8]) { const f32x4 a = *(const f32x4*)p, b = *(const f32x4*)(p + 4); v[0] = a.x; v[1] = a.y; v[2] = a.z; v[3] = a.w; v[4] = b.x; v[5] = b.y; v[6] = b.z; v[7] = b.w; }
__device__ __forceinline__ void nm_load(const Ctx& F, bf16* X, int r, float (&v)[4][8], const float* P, int fn, const float* fgate, const float* fbias) {
    v4u* xr = (v4u*)(X + (size_t)r * D) + F.lane;
#pragma unroll
    for (int j = 0; j < 4; ++j) unpack8(xr[64 * j], v[j]);
    if (r >= S && fn > 0) {
#pragma unroll
        for (int j = 0; j < 4; ++j) { float a[8], t[8];
            if (fbias) ld8f(fbias + 512 * j + 8 * F.lane, a); else {
#pragma unroll
                for (int e = 0; e < 8; ++e) a[e] = 0.f; }
            for (int s = 0; s < fn; ++s) { ld8f(P + ((size_t)s * 256 + (r - S)) * D + 512 * j + 8 * F.lane, t);
#pragma unroll
                for (int e = 0; e < 8; ++e) a[e] += t[e]; }
            ld8f(fgate + 512 * j + 8 * F.lane, t);
#pragma unroll
            for (int e = 0; e < 8; ++e) v[j][e] += t[e] * a[e];
            v4u w; w.x = pk2(v[j][0], v[j][1]); w.y = pk2(v[j][2], v[j][3]); w.z = pk2(v[j][4], v[j][5]); w.w = pk2(v[j][6], v[j][7]); xr[64 * j] = w;
            unpack8(w, v[j]); }
    }
}
__device__ __forceinline__ void nm_store(const Ctx& F, bf16* H, int r, const float (&v)[4][8], float rstd, const float (&wv)[4][8], const float (&sv)[4][8]) {
    v4u* o = (v4u*)(H + (size_t)r * D) + F.lane;
#pragma unroll
    for (int j = 0; j < 4; ++j) { float z[8];
#pragma unroll
        for (int e = 0; e < 8; ++e) z[e] = (v[j][e] * rstd) * wv[j][e] + sv[j][e];
        v4u w; w.x = pk2(z[0], z[1]); w.y = pk2(z[2], z[3]); w.z = pk2(z[4], z[5]); w.w = pk2(z[6], z[7]); o[64 * j] = w; }
}
__device__ __forceinline__ void nm_vecs(const Ctx& F, const float* g, const float* sh, const float* sc, float (&wv)[4][8], float (&sv)[4][8]) {
#pragma unroll
    for (int j = 0; j < 4; ++j) { float gg[8], s1[8]; ld8f(g + 512 * j + 8 * F.lane, gg); ld8f(sc + 512 * j + 8 * F.lane, s1); ld8f(sh + 512 * j + 8 * F.lane, sv[j]);
#pragma unroll
        for (int e = 0; e < 8; ++e) wv[j][e] = gg[e] * (1.0f + s1[e]); }
}
__device__ __forceinline__ float nm_ss(const float (&v)[4][8]) { float ss = 0.f;
#pragma unroll
    for (int j = 0; j < 4; ++j)
#pragma unroll
        for (int e = 0; e < 8; ++e) ss += v[j][e] * v[j][e];
    return ss; }
__device__ __forceinline__ void phase_norm_mod(const Ctx& F, bf16* X, bf16* H, int nrows, const float* g, const float* shL, const float* scL, const float* shC, const float* scC,
                                               const float* P, int fn, const float* fgate, const float* fbias) {
    float wv[4][8], sv[4][8];
    nm_vecs(F, g, shL, scL, wv, sv);
    for (int r = F.gw; r < nrows; r += F.NGW) {
        float va[4][8];
        nm_load(F, X, r, va, P, fn, fgate, fbias);
        const float rsa = 1.0f / sqrtf(wave_sum(nm_ss(va)) * (1.0f / D) + EPS);
        if (r < S) nm_store(F, H, r, va, rsa, wv, sv);
        else {
            v4u* o = (v4u*)(H + (size_t)r * D) + F.lane;
#pragma unroll
            for (int j = 0; j < 4; ++j) { float gg[8], s1[8], s0[8], z[8]; ld8f(g + 512 * j + 8 * F.lane, gg); ld8f(scC + 512 * j + 8 * F.lane, s1); ld8f(shC + 512 * j + 8 * F.lane, s0);
#pragma unroll
                for (int e = 0; e < 8; ++e) z[e] = (va[j][e] * rsa * gg[e]) * (1.0f + s1[e]) + s0[e];
                v4u w; w.x = pk2(z[0], z[1]); w.y = pk2(z[2], z[3]); w.z = pk2(z[4], z[5]); w.w = pk2(z[6], z[7]); o[64 * j] = w; } }
    }
}
__device__ __forceinline__ void phase_final_norm(const Ctx& F, const bf16* X, float* out, const float* g) {
    for (int r = F.gw; r < S; r += F.NGW) {
        const v4u* xr = (const v4u*)(X + (size_t)r * D) + F.lane;
        float v[4][8]; float ss = 0.f;
#pragma unroll
        for (int j = 0; j < 4; ++j) unpack8(xr[64 * j], v[j]);
#pragma unroll
        for (int j = 0; j < 4; ++j)
#pragma unroll
            for (int e = 0; e < 8; ++e) ss += v[j][e] * v[j][e];
        const float rstd = 1.0f / sqrtf(wave_sum(ss) * (1.0f / D) + EPS);
        float* o = out + (size_t)r * D + 8 * F.lane;
#pragma unroll
        for (int j = 0; j < 4; ++j) { float gg[8]; ld8f(g + 512 * j + 8 * F.lane, gg);
            *(f32x4*)(o + 512 * j) = (f32x4){v[j][0] * rstd * gg[0], v[j][1] * rstd * gg[1], v[j][2] * rstd * gg[2], v[j][3] * rstd * gg[3]};
            *(f32x4*)(o + 512 * j + 4) = (f32x4){v[j][4] * rstd * gg[4], v[j][5] * rstd * gg[5], v[j][6] * rstd * gg[6], v[j][7] * rstd * gg[7]}; }
    }
}

__device__ __forceinline__ void phase_kprep(const Ctx& F, const bf16* QKV, bf16* KP, bf16* VP, const float* knorm, const float* rcos, const float* rsin) {
    const int h = F.lane >> 4, c = F.lane & 15;
    const int half64 = c >> 3, first = ((c >> 2) & 1) == 0;
    const int pfreq = (c & 3) * 8;
    for (int r = F.gw; r < R; r += F.NGW) {
        const bool lat = r < S; const int kr = lat ? C + r : r - S;
        const v4u raw = *(const v4u*)(QKV + (size_t)r * AW + 2048 + h * HD + 8 * c);
        float x[8]; unpack8(raw, x);
        if (h >= 2) { float ss = 0.f;
#pragma unroll
            for (int e = 0; e < 8; ++e) ss += x[e] * x[e];
            ss += xl_dpp_b1(ss); ss += xl_dpp_4e(ss); ss += xl_swz4(ss); ss += xl_swz8(ss);
            const float rstd = 1.0f / sqrtf(ss * (1.0f / HD) + EPS);
            float gn[8]; ld8f(knorm + 8 * c, gn);
#pragma unroll
            for (int e = 0; e < 8; ++e) x[e] *= rstd * gn[e]; }
        if (lat) {
            const int pos = half64 == 0 ? (r >> 6) : (r & 63);
            float cs[8], sn[8]; ld8f(rcos + pos * 32 + pfreq, cs); ld8f(rsin + pos * 32 + pfreq, sn);
#pragma unroll
            for (int e = 0; e < 8; ++e) { const float other = xl_swz4(x[e]);
                x[e] = first ? x[e] * cs[e] - other * sn[e] : x[e] * cs[e] + other * sn[e]; }
        }
        v4u w; w.x = pk2(x[0], x[1]); w.y = pk2(x[2], x[3]); w.z = pk2(x[4], x[5]); w.w = pk2(x[6], x[7]);
        *(v4u*)(KP + (size_t)kr * 512 + h * HD + 8 * c) = w;
        *(v4u*)(VP + (size_t)kr * 512 + h * HD + 8 * c) = *(const v4u*)(QKV + (size_t)r * AW + 2560 + h * HD + 8 * c);
    }
}

__device__ __forceinline__ void phase_shortconv(const Ctx& F, const bf16* UP, bf16* XV, const float* cw, const float* cb, int nrows) {
    const int ntb = nrows / 64, tg = F.lane >> 3, cg = F.lane & 7;
    const int nslots = F.NGW / 96;
    if (F.gw >= 96 * nslots) return;
    const int cbk = F.gw % 96, slot = F.gw / 96, c0 = cbk * 64 + 8 * cg;
    const f32x4 w0a = *(const f32x4*)(cw + c0), w0b = *(const f32x4*)(cw + c0 + 4), w1a = *(const f32x4*)(cw + HW + c0), w1b = *(const f32x4*)(cw + HW + c0 + 4);
    const f32x4 w2a = *(const f32x4*)(cw + 2 * HW + c0), w2b = *(const f32x4*)(cw + 2 * HW + c0 + 4), ba = *(const f32x4*)(cb + c0), bb = *(const f32x4*)(cb + c0 + 4);
    const float w0[8] = {w0a.x, w0a.y, w0a.z, w0a.w, w0b.x, w0b.y, w0b.z, w0b.w}, w1[8] = {w1a.x, w1a.y, w1a.z, w1a.w, w1b.x, w1b.y, w1b.z, w1b.w};
    const float w2[8] = {w2a.x, w2a.y, w2a.z, w2a.w, w2b.x, w2b.y, w2b.z, w2b.w}, bs[8] = {ba.x, ba.y, ba.z, ba.w, bb.x, bb.y, bb.z, bb.w};
    for (int tb = slot; tb < ntb; tb += nslots) {
        const int r0 = tb * 64 + 8 * tg;
        const int slo = tb < 128 ? 0 : S, shi = tb < 128 ? S : R;
        v4u raw[10];
#pragma unroll
        for (int k = 0; k < 10; ++k) { const int r = r0 - 1 + k; raw[k] = (r >= slo && r < shi) ? *(const v4u*)(UP + (size_t)r * HW + c0) : (v4u){0u, 0u, 0u, 0u}; }
#pragma unroll
        for (int cc = 0; cc < 8; ++cc) {
            float x[10];
#pragma unroll
            for (int k = 0; k < 10; ++k) { const unsigned d = raw[k][cc >> 1]; x[k] = (cc & 1) ? bf2f(d >> 16) : bf2f(d & 0xffffu); }
            float u[8];
#pragma unroll
            for (int j = 0; j < 8; ++j) u[j] = w0[cc] * x[j] + w1[cc] * x[j + 1] + w2[cc] * x[j + 2] + bs[cc];
            v4u o; o.x = pk2(u[0], u[1]); o.y = pk2(u[2], u[3]); o.z = pk2(u[4], u[5]); o.w = pk2(u[6], u[7]);
            *(v4u*)(XV + (size_t)(c0 + cc) * R + r0) = o;
        }
    }
}

__device__ __forceinline__ void phase_transpose_zc(const Ctx& F, const bf16* ZC, bf16* O, int nrows) {
    LAS unsigned char* scr = F.lds + F.wave * 9216;
    const int ntb = nrows / 64;
    for (int it = F.gw; it < ntb * 32; it += F.NGW) {
        const int cbk = it / ntb, tb = it % ntb, r0 = tb * 64, c0 = cbk * 64;
        v4u raw[8];
#pragma unroll
        for (int k = 0; k < 8; ++k) raw[k] = *(const v4u*)(ZC + (size_t)(c0 + F.lane) * R + r0 + 8 * k);
#pragma unroll
        for (int k = 0; k < 8; ++k)
#pragma unroll
            for (int e = 0; e < 4; ++e) { const unsigned d = raw[k][e]; const int t = 8 * k + 2 * e;
                *(LAS bf16*)(scr + t * 144 + 2 * F.lane) = (bf16)(d & 0xffffu); *(LAS bf16*)(scr + (t + 1) * 144 + 2 * F.lane) = (bf16)(d >> 16); }
        LDS_WAIT();
#pragma unroll
        for (int k = 0; k < 8; ++k) { const int t = 8 * k + (F.lane >> 3), ch = (F.lane & 7) * 8;
            *(v4u*)(O + (size_t)(r0 + t) * D + c0 + ch) = *(const LAS v4u*)(scr + t * 144 + 2 * ch); }
        LDS_WAIT();
    }
}
namespace att {
using bf16x8 = __attribute__((ext_vector_type(8))) short;
using s16x4  = __attribute__((ext_vector_type(4))) short;
using f32x16 = __attribute__((ext_vector_type(16))) float;
using u32x4  = __attribute__((ext_vector_type(4))) unsigned;
constexpr int KVBLK = 64, LDQ = AW, LDK = 512, LDO = D;
constexpr float SCALE = 0.088388347648318440f;
constexpr float THR = 8.f;
constexpr int SDEPTH = 1;
constexpr int SHM_V = KVBLK * 128 * 2, SHM_K = KVBLK * 128 * 2, SHM_ATTN = 2 * SHM_V + 2 * SHM_K + 8 * 64 * 4;
#define KSWZ(row, colB) ((row) * 256 + ((colB) ^ (((row) & 7) << 4)))
#define SBAR() __builtin_amdgcn_sched_barrier(0)
__device__ __forceinline__ int crow(int r, int hi) { return (r & 3) + 8 * (r >> 2) + 4 * hi; }
__device__ __forceinline__ unsigned cvtpk(float lo, float hi) { unsigned r; asm volatile("v_cvt_pk_bf16_f32 %0, %1, %2" : "=v"(r) : "v"(lo), "v"(hi)); return r; }

__device__ __forceinline__ void partialSM(f32x16& p0, f32x16& p1, float& m_reg, float& mn, float& alpha) {
  constexpr float Cc = SCALE * 1.4426950408889634f;
  float pmax = p0[0]; for (int r = 1; r < 16; ++r) pmax = fmaxf(pmax, p0[r]); for (int r = 0; r < 16; ++r) pmax = fmaxf(pmax, p1[r]);
  { auto rr = __builtin_amdgcn_permlane32_swap(__float_as_uint(pmax), __float_as_uint(pmax), false, false);
    pmax = fmaxf(__uint_as_float(rr[0]), __uint_as_float(rr[1])); }
  if (__builtin_expect(__all(pmax - m_reg <= THR / SCALE), 1)) { mn = m_reg; alpha = 1.f; }
  else { mn = fmaxf(m_reg, pmax); alpha = __builtin_amdgcn_exp2f((m_reg - mn) * Cc); m_reg = mn; }
  float mnC = -mn * Cc;
  for (int r = 0; r < 16; ++r) p0[r] = fmaf(p0[r], Cc, mnC); for (int r = 0; r < 16; ++r) p1[r] = fmaf(p1[r], Cc, mnC);
  for (int r = 0; r < 16; ++r) p0[r] = __builtin_amdgcn_exp2f(p0[r]);
}
__device__ __forceinline__ void finishSM(f32x16& p0, f32x16& p1, float alpha, float& l_reg, bf16x8& pa0, bf16x8& pa1, bf16x8& pa2, bf16x8& pa3) {
  for (int r = 0; r < 16; ++r) p1[r] = __builtin_amdgcn_exp2f(p1[r]);
  float ps = 0; for (int r = 0; r < 16; ++r) ps += p0[r]; for (int r = 0; r < 16; ++r) ps += p1[r];
  { auto rr = __builtin_amdgcn_permlane32_swap(__float_as_uint(ps), __float_as_uint(ps), false, false);
    ps = __uint_as_float(rr[0]) + __uint_as_float(rr[1]); }
  l_reg = l_reg * alpha + ps;
#define PK4(P, BASE, OUT) do { unsigned a0 = cvtpk(P[BASE + 0], P[BASE + 1]), a1 = cvtpk(P[BASE + 2], P[BASE + 3]);   \
    unsigned b0 = cvtpk(P[BASE + 4], P[BASE + 5]), b1 = cvtpk(P[BASE + 6], P[BASE + 7]);                              \
    auto r0 = __builtin_amdgcn_permlane32_swap(a0, b0, false, false); auto r1 = __builtin_amdgcn_permlane32_swap(a1, b1, false, false); \
    u32x4 w = {r0[0], r1[0], r0[1], r1[1]}; OUT = *reinterpret_cast<bf16x8*>(&w); } while (0)
  PK4(p0, 0, pa0); PK4(p0, 8, pa1); PK4(p1, 0, pa2); PK4(p1, 8, pa3);
#undef PK4
}
__device__ __forceinline__ void qkt(f32x16& p0, f32x16& p1, const char* Ks, const bf16x8* qr, int r32, int hi) {
  p0 = f32x16{}; p1 = f32x16{};
  for (int d0 = 0; d0 < 8; ++d0) { int cb = (d0 * 16 + hi * 8) * 2;
    bf16x8 b0 = *reinterpret_cast<const bf16x8*>(Ks + KSWZ(r32, cb));
    bf16x8 b1 = *reinterpret_cast<const bf16x8*>(Ks + KSWZ(32 + r32, cb));
    p0 = __builtin_amdgcn_mfma_f32_32x32x16_bf16(b0, qr[d0], p0, 0, 0, 0);
    p1 = __builtin_amdgcn_mfma_f32_32x32x16_bf16(b1, qr[d0], p1, 0, 0, 0); }
}
__device__ __forceinline__ int v_st(int k, int c) { const int kk = (k & ~0xC) | ((k & 4) << 1) | ((k & 8) >> 1); return ((kk >> 3) * 4 + (c >> 5)) * 512 + ((kk & 7) * 32 + (c & 31)) * 2; }
__device__ __forceinline__ int v_rd_base(int lane) { return ((lane & 3) << 3) | (((lane >> 2) & 3) << 6) | (((lane >> 4) & 1) << 5) | (((lane >> 5) & 1) << 8); }
constexpr int v_rd_off(int d0, int ks, int half) { return d0 * 512 + ks * 4096 + half * 2048; }
template <int OFF> __device__ __forceinline__ s16x4 tr_read(int vb) {
  s16x4 r; asm volatile("ds_read_b64_tr_b16 %0, %1 offset:%2" : "=&v"(r) : "v"(vb), "i"(OFF) : "memory"); return r;
}
template <int D0> __device__ __forceinline__ void pv_one(f32x16& od, int vb, bf16x8 pa0, bf16x8 pa1, bf16x8 pa2, bf16x8 pa3) {
  const s16x4 l0 = tr_read<v_rd_off(D0, 0, 0)>(vb), h0 = tr_read<v_rd_off(D0, 0, 1)>(vb), l1 = tr_read<v_rd_off(D0, 1, 0)>(vb), h1 = tr_read<v_rd_off(D0, 1, 1)>(vb);
  const s16x4 l2 = tr_read<v_rd_off(D0, 2, 0)>(vb), h2 = tr_read<v_rd_off(D0, 2, 1)>(vb), l3 = tr_read<v_rd_off(D0, 3, 0)>(vb), h3 = tr_read<v_rd_off(D0, 3, 1)>(vb);
  asm volatile("s_waitcnt lgkmcnt(0)" ::: "memory"); SBAR();
#define PK(L, H) (bf16x8){L[0], L[1], L[2], L[3], H[0], H[1], H[2], H[3]}
  od = __builtin_amdgcn_mfma_f32_32x32x16_bf16(pa0, PK(l0, h0), od, 0, 0, 0);
  od = __builtin_amdgcn_mfma_f32_32x32x16_bf16(pa1, PK(l1, h1), od, 0, 0, 0);
  od = __builtin_amdgcn_mfma_f32_32x32x16_bf16(pa2, PK(l2, h2), od, 0, 0, 0);
  od = __builtin_amdgcn_mfma_f32_32x32x16_bf16(pa3, PK(l3, h3), od, 0, 0, 0);
#undef PK
}
__device__ __forceinline__ void pv_d0(f32x16* o, int vb, bf16x8 pa0, bf16x8 pa1, bf16x8 pa2, bf16x8 pa3) {
  pv_one<0>(o[0], vb, pa0, pa1, pa2, pa3); pv_one<1>(o[1], vb, pa0, pa1, pa2, pa3); pv_one<2>(o[2], vb, pa0, pa1, pa2, pa3); pv_one<3>(o[3], vb, pa0, pa1, pa2, pa3);
}

struct Unit {
    const bf16* Qb;
    const bf16* Kh;
    const bf16* Vh;
    bf16* Ob;
    int NT;
    int lat0;
    int i0;
    int windowed;
    int norm_q;
    float sink; int has_sink;
};

__device__ __forceinline__ void window_mask(f32x16& p0, f32x16& p1, int base, int hi) {
#pragma unroll
  for (int r = 0; r < 16; ++r) { const int d0 = base + crow(r, hi), d1 = d0 + 32;
    p0[r] = (d0 >= -128 && d0 <= 128) ? p0[r] : -__builtin_inff();
    p1[r] = (d1 >= -128 && d1 <= 128) ? p1[r] : -__builtin_inff(); }
}

__device__ __forceinline__ void attn_unit(const Unit u, const float* __restrict__ qn, const float* __restrict__ rcos, const float* __restrict__ rsin, char* lds, const int tid) {
  const int wid = tid >> 6, lane = tid & 63, r32 = lane & 31, hi = lane >> 5;
  char* V_lds = lds; char* K_lds = lds + 2 * SHM_V;
  float* wsx = (float*)(lds + 2 * SHM_V + 2 * SHM_K) + wid * 64; float* li_l = wsx; float* al_l = wsx + 32;
  float m_reg = u.has_sink ? u.sink * (1.0f / SCALE) : -1e30f, l_reg = u.has_sink ? 1.f : 0.f; f32x16 o[4] = {}; bf16x8 qr[8];
  const int qpos = u.i0 + wid * 32 + r32;
  {
    const bf16* Qw = u.Qb + (long)(wid * 32 + r32) * LDQ + hi * 8;
    float qf[8][8];
#pragma unroll
    for (int d0 = 0; d0 < 8; ++d0) { const u32x4 raw = *reinterpret_cast<const u32x4*>(Qw + d0 * 16);
#pragma unroll
      for (int e = 0; e < 4; ++e) { qf[d0][2 * e] = bf2f(raw[e] & 0xffffu); qf[d0][2 * e + 1] = bf2f(raw[e] >> 16); } }
    if (u.norm_q) { float ss = 0.f;
#pragma unroll
      for (int d0 = 0; d0 < 8; ++d0)
#pragma unroll
        for (int e = 0; e < 8; ++e) ss += qf[d0][e] * qf[d0][e];
      ss += xl_x32(ss);
      const float rstd = 1.0f / sqrtf(ss * (1.0f / 128.0f) + EPS);
#pragma unroll
      for (int d0 = 0; d0 < 8; ++d0) { const f32x4 g0 = *(const f32x4*)(qn + d0 * 16 + hi * 8), g1 = *(const f32x4*)(qn + d0 * 16 + hi * 8 + 4);
        qf[d0][0] *= rstd * g0.x; qf[d0][1] *= rstd * g0.y; qf[d0][2] *= rstd * g0.z; qf[d0][3] *= rstd * g0.w;
        qf[d0][4] *= rstd * g1.x; qf[d0][5] *= rstd * g1.y; qf[d0][6] *= rstd * g1.z; qf[d0][7] *= rstd * g1.w; } }
    if (u.i0 >= 0) {
#pragma unroll
      for (int hf = 0; hf < 2; ++hf) { const int pos = hf == 0 ? (qpos >> 6) : (qpos & 63);
#pragma unroll
        for (int dd = 0; dd < 2; ++dd) { const int pb = pos * 32 + dd * 16 + hi * 8;
          const f32x4 c0 = *(const f32x4*)(rcos + pb), c1 = *(const f32x4*)(rcos + pb + 4), s0 = *(const f32x4*)(rsin + pb), s1 = *(const f32x4*)(rsin + pb + 4);
          const float cs[8] = {c0.x, c0.y, c0.z, c0.w, c1.x, c1.y, c1.z, c1.w}, sn[8] = {s0.x, s0.y, s0.z, s0.w, s1.x, s1.y, s1.z, s1.w};
#pragma unroll
          for (int e = 0; e < 8; ++e) { const float a = qf[4 * hf + dd][e], b = qf[4 * hf + dd + 2][e];
            qf[4 * hf + dd][e] = a * cs[e] - b * sn[e]; qf[4 * hf + dd + 2][e] = b * cs[e] + a * sn[e]; } } } }
#pragma unroll
    for (int d0 = 0; d0 < 8; ++d0) { u32x4 w = {cvtpk(qf[d0][0], qf[d0][1]), cvtpk(qf[d0][2], qf[d0][3]), cvtpk(qf[d0][4], qf[d0][5]), cvtpk(qf[d0][6], qf[d0][7])}; qr[d0] = *reinterpret_cast<bf16x8*>(&w); }
  }
  const int sr = tid >> 4, sc = (tid & 15) * 8, vst0 = v_st(sr, sc), vst1 = v_st(32 + sr, sc);
  const int vb0 = (int)(uintptr_t)V_lds + v_rd_base(lane);
  const bf16* Kh = u.Kh; const bf16* Vh = u.Vh; const int lat0 = u.lat0;
  struct { bf16x8 vs0, vs1, ks0, ks1; } sr_[SDEPTH];
#define KOFF(t) (64 * (t) + ((t) >= 4 ? lat0 : 0))
#define SLOAD(i, k0) do { const long _k = (k0); sr_[i].vs0 = *reinterpret_cast<const bf16x8*>(&Vh[(_k + sr) * LDK + sc]); sr_[i].vs1 = *reinterpret_cast<const bf16x8*>(&Vh[(_k + 32 + sr) * LDK + sc]); \
    sr_[i].ks0 = *reinterpret_cast<const bf16x8*>(&Kh[(_k + sr) * LDK + sc]); sr_[i].ks1 = *reinterpret_cast<const bf16x8*>(&Kh[(_k + 32 + sr) * LDK + sc]); } while (0)
#define SWRITE(b, i) do { *(bf16x8*)(V_lds + (b) * SHM_V + vst0) = sr_[i].vs0;          \
    *(bf16x8*)(V_lds + (b) * SHM_V + vst1) = sr_[i].vs1; int kc = sc * 2;               \
    *(bf16x8*)(K_lds + (b) * SHM_K + KSWZ(sr, kc)) = sr_[i].ks0;                       \
    *(bf16x8*)(K_lds + (b) * SHM_K + KSWZ(32 + sr, kc)) = sr_[i].ks1; } while (0)
#define SWAIT() do { if constexpr (SDEPTH == 2) asm volatile("s_waitcnt vmcnt(4)" ::: "memory"); else asm volatile("s_waitcnt vmcnt(0)" ::: "memory"); } while (0)
#define RESC(a) do { if (__any((a) < 1.f)) { if (hi == 0) al_l[r32] = (a); asm volatile("s_waitcnt lgkmcnt(0)" ::: "memory"); \
    for (int d = 0; d < 4; ++d) for (int r = 0; r < 16; ++r) o[d][r] *= al_l[crow(r, hi)]; } } while (0)
#define WMASK(P0, P1, t) do { if (u.windowed && (t) >= 4) { const int _b = KOFF(t) - C - qpos; if (__any(_b < -128 || _b + 63 > 128)) window_mask(P0, P1, _b, hi); } } while (0)
  f32x16 pA0, pA1, pB0, pB1; float mnA, mnB, alA, alB; bf16x8 pa0, pa1, pa2, pa3; const int NT = u.NT;
  constexpr int SE = 0, SO = SDEPTH - 1;
  SLOAD(SE, KOFF(0)); asm volatile("s_waitcnt vmcnt(0)" ::: "memory"); SWRITE(0, SE); __syncthreads();
  qkt(pA0, pA1, K_lds, qr, r32, hi); WMASK(pA0, pA1, 0); partialSM(pA0, pA1, m_reg, mnA, alA);
  SLOAD(SO, KOFF(1)); if constexpr (SDEPTH == 2) { if (2 < NT) SLOAD(SE, KOFF(2)); }
  SWAIT(); SWRITE(1, SO); __syncthreads();
  for (int j = 1; j + 1 < NT; j += 2) {
    SBAR(); qkt(pB0, pB1, K_lds + SHM_K, qr, r32, hi);
    finishSM(pA0, pA1, alA, l_reg, pa0, pa1, pa2, pa3); SBAR();
    SLOAD(SO, KOFF(j + SDEPTH)); SBAR();
    pv_d0(o, vb0, pa0, pa1, pa2, pa3); WMASK(pB0, pB1, j); partialSM(pB0, pB1, m_reg, mnB, alB);
    __syncthreads(); SWAIT(); SWRITE(0, SE);
    RESC(alB); __syncthreads();
    SBAR(); qkt(pA0, pA1, K_lds, qr, r32, hi);
    finishSM(pB0, pB1, alB, l_reg, pa0, pa1, pa2, pa3); SBAR();
    if (SDEPTH == 1 || j + 3 < NT) SLOAD(SE, KOFF(j + 1 + SDEPTH)); SBAR();
    pv_d0(o, vb0 + (int)SHM_V, pa0, pa1, pa2, pa3); WMASK(pA0, pA1, j + 1); partialSM(pA0, pA1, m_reg, mnA, alA);
    __syncthreads(); SWAIT(); SWRITE(1, SO);
    RESC(alA); __syncthreads();
  }
  SBAR(); qkt(pB0, pB1, K_lds + SHM_K, qr, r32, hi);
  finishSM(pA0, pA1, alA, l_reg, pa0, pa1, pa2, pa3); SBAR();
  pv_d0(o, vb0, pa0, pa1, pa2, pa3); WMASK(pB0, pB1, NT - 1); partialSM(pB0, pB1, m_reg, mnB, alB);
  __syncthreads(); RESC(alB);
  finishSM(pB0, pB1, alB, l_reg, pa0, pa1, pa2, pa3); SBAR();
  pv_d0(o, vb0 + (int)SHM_V, pa0, pa1, pa2, pa3);
  if (hi == 0) li_l[r32] = l_reg; asm volatile("s_waitcnt lgkmcnt(0)" ::: "memory");
  float rli[16];
#pragma unroll
  for (int r = 0; r < 16; ++r) rli[r] = __builtin_amdgcn_rcpf(li_l[crow(r, hi)]);
  bf16* Ow = u.Ob + (long)(wid * 32) * LDO;
#pragma unroll
  for (int r = 0; r < 16; ++r) { const int orow = crow(r, hi);
#pragma unroll
    for (int d0 = 0; d0 < 4; ++d0) Ow[(long)orow * LDO + d0 * 32 + r32] = (bf16)f2bf(o[d0][r] * rli[r]); }
  __syncthreads();
#undef KOFF
#undef SLOAD
#undef SWRITE
#undef SWAIT
#undef RESC
#undef WMASK
}
#undef KSWZ
#undef SBAR
}

__device__ __forceinline__ void phase_attn(const Ctx& F, const bf16* QKV, const bf16* KP, const bf16* VP, bf16* O, bool ctx_out, const float* sink, const float* qnorm, const float* rcos, const float* rsin) {
    const int nunits = 256 + 256 + (ctx_out ? 16 : 0);
    for (int un = F.bid; un < nunits; un += F.G) {
        att::Unit u;
        int h, qb, isctx = 0;
        if (un < 512) { const int w = un & 255, x = w & 7, idx = w >> 3; h = (un < 256 ? 8 : 0) + 4 * (x >> 2) + (idx >> 3); qb = 8 * (x & 3) + (idx & 7); }
        else { h = un - 512; qb = 32; isctx = 1; }
        const int kvh = h < 8 ? (h >> 2) : 2 + ((h - 8) >> 2);
        const int row0 = qb * 256;
        u.Qb = QKV + (size_t)row0 * AW + h * HD; u.Kh = KP + kvh * HD; u.Vh = VP + kvh * HD; u.Ob = O + (size_t)row0 * D + h * HD;
        u.i0 = isctx ? -1 : row0; u.norm_q = h >= 8; u.has_sink = h < 8; u.sink = h < 8 ? sink[h] : 0.f;
        if (isctx) { u.NT = 4; u.lat0 = 0; u.windowed = 0; }
        else if (h >= 8) { u.NT = R / 64; u.lat0 = 0; u.windowed = 0; }
        else { const int l0 = row0 - 128 < 0 ? 0 : row0 - 128, l1 = row0 + 384 > S ? S : row0 + 384; u.lat0 = l0; u.NT = 4 + (l1 - l0) / 64; u.windowed = 1; }
#if ATT16
        att16::attn_unit(u, qnorm, rcos, rsin, (char*)F.lds, F.tid);
#else
        att::attn_unit(u, qnorm, rcos, rsin, (char*)F.lds, F.tid);
#endif
    }
}
namespace hconv {
using bf16x8 = __attribute__((ext_vector_type(8))) short;
using f32x4v = __attribute__((ext_vector_type(4))) float;
using u32x4  = __attribute__((ext_vector_type(4))) unsigned;
constexpr int RLEN = 8320, ROFF = 4159;
constexpr int ZBYTES = 8 * 2048, RBYTES = RLEN * 2, ZERO_OFF = 4 * (ZBYTES + RBYTES);
static_assert(ZERO_OFF + 8192 + 16 <= LDS_BYTES - 256, "conv LDS map");

template <int TM>
__device__ __forceinline__ void conv_seg(const LAS unsigned char* zl, const LAS unsigned char* rl, const LAS unsigned char* zero, int nh, int q, int kg, int dl0, int dl1, f32x4v (&acc)[2][2][4]) {
    const LAS unsigned char* ap = rl + 2 * (8 * kg - 2 * q - 1 + ROFF) - 128 * dl0;
    const LAS unsigned char* zp = zl + kg * 2048 + 16 * (64 * nh - dl0 + q);
    int sb = 64 * nh - dl0 + q;
    asm volatile("" : "+v"(ap), "+v"(zp));
    unsigned ra0[4][5], ra1[4][5]; bf16x8 rb0[4][2], rb1[4][2];
#define CONV_LOAD(RA, RB) do { \
        _Pragma("unroll") for (int rh = 0; rh < 2; ++rh) _Pragma("unroll") for (int ks = 0; ks < 2; ++ks) { const LAS unsigned* p_ = (const LAS unsigned*)(ap + 64 * ks - 64 * rh); \
            RA[rh * 2 + ks][0] = p_[0]; RA[rh * 2 + ks][1] = p_[1]; RA[rh * 2 + ks][2] = p_[2]; RA[rh * 2 + ks][3] = p_[3]; RA[rh * 2 + ks][4] = p_[4]; } \
        _Pragma("unroll") for (int ct = 0; ct < 4; ++ct) if ((TM >> ct) & 1) { \
            const LAS unsigned char* bp_ = (unsigned)(sb + 16 * ct) < 128u ? zp + 256 * ct : zero; \
            RB[ct][0] = *(const LAS bf16x8*)bp_; RB[ct][1] = *(const LAS bf16x8*)(bp_ + 8192); } \
        ap -= 128; zp -= 16; sb -= 1; } while (0)
#define CONV_MMA(RA, RB) do { \
        _Pragma("unroll") for (int rh = 0; rh < 2; ++rh) _Pragma("unroll") for (int ks = 0; ks < 2; ++ks) { const int a_ = rh * 2 + ks; \
            u32x4 e_ = {__builtin_amdgcn_alignbit(RA[a_][1], RA[a_][0], 16), __builtin_amdgcn_alignbit(RA[a_][2], RA[a_][1], 16), __builtin_amdgcn_alignbit(RA[a_][3], RA[a_][2], 16), __builtin_amdgcn_alignbit(RA[a_][4], RA[a_][3], 16)}; \
            u32x4 o_ = {RA[a_][0], RA[a_][1], RA[a_][2], RA[a_][3]}; \
            _Pragma("unroll") for (int ct = 0; ct < 4; ++ct) if ((TM >> ct) & 1) { \
                acc[0][rh][ct] = __builtin_amdgcn_mfma_f32_16x16x32_bf16(*reinterpret_cast<bf16x8*>(&e_), RB[ct][ks], acc[0][rh][ct], 0, 0, 0); \
                acc[1][rh][ct] = __builtin_amdgcn_mfma_f32_16x16x32_bf16(*reinterpret_cast<bf16x8*>(&o_), RB[ct][ks], acc[1][rh][ct], 0, 0, 0); } } } while (0)
    CONV_LOAD(ra0, rb0);
    for (int dl = dl0; dl <= dl1; dl += 2) {
        CONV_LOAD(ra1, rb1);
        __builtin_amdgcn_sched_barrier(0);
        CONV_MMA(ra0, rb0);
        __builtin_amdgcn_sched_barrier(0);
        if (dl + 2 > dl1) { ap += 128; zp += 16; sb += 1; }
        CONV_LOAD(ra0, rb0);
        __builtin_amdgcn_sched_barrier(0);
        CONV_MMA(ra1, rb1);
        __builtin_amdgcn_sched_barrier(0);
    }
#undef CONV_LOAD
#undef CONV_MMA
}
__device__ __forceinline__ void conv_wave(const LAS unsigned char* zl, const LAS unsigned char* rl, const LAS unsigned char* zero, int nh, int lane, f32x4v (&acc)[2][2][4]) {
    asm volatile("" : "+v"(lane));
    const int q = lane & 15, kg = lane >> 4;
#pragma unroll
    for (int a = 0; a < 2; ++a)
#pragma unroll
        for (int b = 0; b < 2; ++b)
#pragma unroll
            for (int c = 0; c < 4; ++c) acc[a][b][c] = f32x4v{0.f, 0.f, 0.f, 0.f};
    if (nh == 0) { conv_seg<15>(zl, rl, zero, nh, q, kg, -64, 15, acc); conv_seg<14>(zl, rl, zero, nh, q, kg, 16, 31, acc); conv_seg<12>(zl, rl, zero, nh, q, kg, 32, 47, acc); conv_seg<8>(zl, rl, zero, nh, q, kg, 48, 63, acc); }
    else         { conv_seg<1>(zl, rl, zero, nh, q, kg, -63, -48, acc); conv_seg<3>(zl, rl, zero, nh, q, kg, -47, -32, acc); conv_seg<7>(zl, rl, zero, nh, q, kg, -31, -16, acc); conv_seg<15>(zl, rl, zero, nh, q, kg, -15, 64, acc); }
}
}

#ifdef PROBE_SUB
#define PSUB(k_) do { const unsigned long long tn_ = __builtin_amdgcn_s_memrealtime(); if (PROBE_SUB == (k_)) tsub += tn_ - tprev_; tprev_ = tn_; } while (0)
#else
#define PSUB(k_)
#endif
__device__ __forceinline__ void phase_longconv_mfma(const Ctx& F, const bf16* XV, bf16* ZC, const bf16* RG, const float* fpart, const float* skip, unsigned long long& tsub) {
#ifdef PROBE_SUB
    unsigned long long tprev_ = __builtin_amdgcn_s_memrealtime();
#endif
    using namespace hconv;
    const int chs = F.wave >> 1, nh = F.wave & 1, q = F.lane & 15, kg = F.lane >> 4;
    LAS unsigned char* zl = F.lds + chs * ZBYTES; LAS unsigned char* rl = F.lds + 4 * ZBYTES + chs * RBYTES; LAS unsigned char* zero = F.lds + ZERO_OFF;
    if (F.tid < 4) { ((LAS unsigned*)zero)[F.tid] = 0u; ((LAS unsigned*)(zero + 8192))[F.tid] = 0u; }
    for (int grp = F.bid; grp < D / 4; grp += F.G) {
        const int c0 = grp * 4, c = c0 + chs;
        for (int qq = F.tid; qq < 4 * 1024; qq += NTHREADS) { const int cc = qq >> 10, pc = qq & 1023;
            const v4u v = *(const v4u*)(XV + (size_t)(2 * D + c0 + cc) * R + pc * 8);
            *(LAS v4u*)(F.lds + cc * ZBYTES + (pc & 7) * 2048 + (pc >> 3) * 16) = v; }
        { const char* gb = (const char*)(RG + (size_t)c0 * RLEN);
          for (unsigned qq = F.tid; qq < 4u * (RLEN / 8); qq += NTHREADS) *(LAS v4u*)(F.lds + 4 * ZBYTES + qq * 16u) = *(const v4u*)(gb + qq * 16u); }
        float s0, s1;
        { const float a = F.lane < FCH ? fpart[c * FCH + F.lane] : 0.f, b = F.lane < FCH ? fpart[(D + c) * FCH + F.lane] : 0.f;
          s0 = 1.0f / sqrtf(wave_sum(a) + EPS); s1 = 1.0f / sqrtf(wave_sum(b) + EPS); }
        const float sk0 = skip[c], sk1 = skip[D + c];
        __syncthreads();
        PSUB(1);
        f32x4v acc[2][2][4];
        conv_wave(zl, rl, zero, nh, F.lane, acc);
        PSUB(2);
        int tl = F.tid; asm volatile("" : "+v"(tl));
        v4u r1[9];
#pragma unroll
        for (int k = 0; k < 9; ++k) { const unsigned qq = (unsigned)tl + NTHREADS * k; const char* gb = (const char*)(RG + (size_t)(D + c0) * RLEN);
            r1[k] = qq < 4u * (RLEN / 8) ? *(const v4u*)(gb + qq * 16u) : (v4u){0u, 0u, 0u, 0u}; }
        __builtin_amdgcn_sched_barrier(0);
        __syncthreads();
#pragma unroll
        for (int ct = 0; ct < 4; ++ct) { const int tb = 64 * nh + 16 * ct + q;
#pragma unroll
            for (int rh = 0; rh < 2; ++rh) { LAS v4u* zp = (LAS v4u*)(zl + (4 * rh + kg) * 2048 + tb * 16);
                const v4u vv = *zp; const v4u xx = *(const v4u*)(XV + (size_t)c * R + 64 * tb + 32 * rh + 8 * kg);
                v4u w;
#pragma unroll
                for (int r = 0; r < 4; ++r) { const float ye = acc[0][rh][ct][r], yo = acc[1][rh][ct][r];
                    const float ze = bf2f(xx[r] & 0xffffu) * (s0 * ye + bf2f(vv[r] & 0xffffu) * sk0), zo = bf2f(xx[r] >> 16) * (s0 * yo + bf2f(vv[r] >> 16) * sk0);
                    w[r] = pk2(ze, zo); }
                *zp = w; } }
#pragma unroll
        for (int k = 0; k < 9; ++k) { const unsigned qq = (unsigned)tl + NTHREADS * k;
            if (qq < 4u * (RLEN / 8)) *(LAS v4u*)(F.lds + 4 * ZBYTES + qq * 16u) = r1[k]; }
        __syncthreads();
        PSUB(3);
        conv_wave(zl, rl, zero, nh, F.lane, acc);
        PSUB(4);
#pragma unroll
        for (int ct = 0; ct < 4; ++ct) { const int tb = 64 * nh + 16 * ct + q;
#pragma unroll
            for (int rh = 0; rh < 2; ++rh) { const v4u vv = *(const LAS v4u*)(zl + (4 * rh + kg) * 2048 + tb * 16);
                const v4u xx = *(const v4u*)(XV + (size_t)(D + c) * R + 64 * tb + 32 * rh + 8 * kg);
                v4u w;
#pragma unroll
                for (int r = 0; r < 4; ++r) { const float ye = acc[0][rh][ct][r], yo = acc[1][rh][ct][r];
                    const float ze = bf2f(xx[r] & 0xffffu) * (s1 * ye + bf2f(vv[r] & 0xffffu) * sk1), zo = bf2f(xx[r] >> 16) * (s1 * yo + bf2f(vv[r] >> 16) * sk1);
                    w[r] = pk2(ze, zo); }
                *(v4u*)(ZC + (size_t)c * R + 64 * tb + 32 * rh + 8 * kg) = w; } }
        __syncthreads();
        PSUB(5);
    }
}

__device__ __forceinline__ void phase_ctxconv(const Ctx& F, const bf16* XV, bf16* ZC, const float* FILTC, const float* fpartc, const float* skip) {
    LAS float* zs = (LAS float*)(F.lds + F.wave * 4096); LAS float* Tp = zs + 256;
    for (int c = F.gw; c < D; c += F.NGW) {
        const bf16* v = XV + (size_t)(2 * D + c) * R + S; const bf16* x1 = XV + (size_t)c * R + S; const bf16* x2 = XV + (size_t)(D + c) * R + S;
        float e0 = 0.f, e1 = 0.f;
#pragma unroll
        for (int t = 0; t < 8; ++t) { e0 += fpartc[c * 8 + t]; e1 += fpartc[(D + c) * 8 + t]; }
        const float s0 = 1.0f / sqrtf(e0 + EPS), s1 = 1.0f / sqrtf(e1 + EPS), sk0 = skip[c], sk1 = skip[D + c];
        float vv[4], acc[4], z2[4];
#pragma unroll
        for (int q = 0; q < 4; ++q) { vv[q] = bf2f(v[F.lane + 64 * q]); zs[F.lane + 64 * q] = vv[q]; }
#pragma unroll
        for (int q = 0; q < 8; ++q) { const int src = F.lane + 64 * q - 128; Tp[F.lane + 64 * q] = (unsigned)src < 256u ? FILTC[(size_t)c * C + src] : 0.f; }
        LDS_WAIT();
#pragma unroll
        for (int q = 0; q < 4; ++q) acc[q] = 0.f;
        for (int s = 0; s < C; ++s) { const float zv = zs[s];
#pragma unroll
            for (int q = 0; q < 4; ++q) acc[q] += zv * Tp[F.lane + 64 * q - s + 256]; }
#pragma unroll
        for (int q = 0; q < 4; ++q) z2[q] = bf2f(x1[F.lane + 64 * q]) * (s0 * acc[q] + vv[q] * sk0);
        LDS_WAIT();
#pragma unroll
        for (int q = 0; q < 4; ++q) zs[F.lane + 64 * q] = z2[q];
#pragma unroll
        for (int q = 0; q < 8; ++q) { const int src = F.lane + 64 * q - 128; Tp[F.lane + 64 * q] = (unsigned)src < 256u ? FILTC[(size_t)(D + c) * C + src] : 0.f; }
        LDS_WAIT();
#pragma unroll
        for (int q = 0; q < 4; ++q) acc[q] = 0.f;
        for (int s = 0; s < C; ++s) { const float zv = zs[s];
#pragma unroll
            for (int q = 0; q < 4; ++q) acc[q] += zv * Tp[F.lane + 64 * q - s + 256]; }
#pragma unroll
        for (int q = 0; q < 4; ++q) ZC[(size_t)c * R + S + F.lane + 64 * q] = (bf16)f2bf(bf2f(x2[F.lane + 64 * q]) * (s1 * acc[q] + z2[q] * sk1));
        LDS_WAIT();
    }
}
#ifndef RP_PRO
#define RP_PRO 1
#endif
#ifndef RP_FIL
#define RP_FIL 1
#endif
#ifndef RP_THIN
#define RP_THIN 1
#endif
#ifndef RP_ATT
#define RP_ATT 1
#endif
#ifndef RP_CONV
#define RP_CONV 1
#endif
#ifndef RP_GIN
#define RP_GIN 1
#endif
#ifndef RP_GUP
#define RP_GUP 1
#endif
#define REP(n) for (int rep_ = 0; rep_ < (n); ++rep_)
#define REPSYNC __syncthreads();
#ifdef PROBE_MASK
#ifndef PROBE_BLOCK
#define PROBE_BLOCK 0
#endif
#ifndef PROBE_MULT
#define PROBE_MULT 4
#endif
#define PROBE_T0 const unsigned long long t0_ = __builtin_amdgcn_s_memrealtime();
#define PROBE_T1 const unsigned long long t1_ = __builtin_amdgcn_s_memrealtime(); if ((PROBE_MASK >> pcat_) & 1) tacc_ += t1_ - t0_;
#ifndef PROBE_WMASK
#define PROBE_WMASK 0xffff
#endif
#define PROBE_T2 if (((PROBE_MASK >> 15) & 1) && ((PROBE_WMASK >> pcat_) & 1)) tacc_ += __builtin_amdgcn_s_memrealtime() - t1_;
#else
#define PROBE_T0
#define PROBE_T1
#define PROBE_T2
#endif
struct Args { const float* in[30]; float* out; unsigned char* ws; int ph_lo, ph_hi; };
typedef const float* const __attribute__((address_space(4)))* InTab;
#ifdef PROBE_GK
constexpr int N_PHASES = 2 + 4 * 9 + 2;
#else
constexpr int N_PHASES = 2 + 4 * 9 + 1;
#endif

__global__ void __launch_bounds__(NTHREADS, 2) fwd(Args args) {
    extern __shared__ __attribute__((aligned(16))) unsigned char lds_raw[];
    Ctx F;
    F.lds = (LAS unsigned char*)lds_raw;
    F.tid = threadIdx.x; F.lane = F.tid & 63; F.wave = __builtin_amdgcn_readfirstlane(F.tid >> 6);
    F.bid = blockIdx.x; F.G = gridDim.x; F.gw = F.bid * NWAVES + F.wave; F.NGW = F.G * NWAVES;
    unsigned char* ws = args.ws;
    volatile LAS unsigned* MISC = (volatile LAS unsigned*)(F.lds + MISC_OFF);
    if (F.tid < 32) MISC[F.tid] = 0u;
    __syncthreads();
    XcdBarrier bar; bar.bar = (unsigned*)(ws + WS_CTL) + CW_BAR; bar.x = 0; bar.st = nullptr;
#if MK_ONE_LAUNCH
    bar = xcd_barrier_post((unsigned*)(ws + WS_CTL) + CW_BAR, MISC + 8);
#endif
    const int lo = args.ph_lo, hi = args.ph_hi;
    int ph = 0;
    unsigned long long tsub_ = 0ull; (void)tsub_;
#ifdef PROBE_MASK
    unsigned long long tacc_ = 0ull;
#endif
#define CAS __attribute__((address_space(4)))
#define PH_BEGIN(cat_) if (ph >= lo && ph < hi) { const int pcat_ = (cat_); (void)pcat_; PROBE_T0 int tid_ = threadIdx.x; asm volatile("" : "+v"(tid_)); F.tid = tid_; F.lane = tid_ & 63; \
    const CAS unsigned char* ka_ = (const CAS unsigned char*)__builtin_amdgcn_kernarg_segment_ptr(); asm volatile("" : "+s"(ka_)); \
    InTab in = (InTab)ka_; unsigned char* ws = *(unsigned char* const CAS*)(ka_ + 248); float* out_ = *(float* const CAS*)(ka_ + 240); (void)out_; \
    float* misc = (float*)(ws + WS_MISC); bf16* X = (bf16*)(ws + WS_X); bf16* H = (bf16*)(ws + WS_H); bf16* QKV = (bf16*)(ws + WS_QKV); bf16* KP = (bf16*)(ws + WS_KP); bf16* VP = (bf16*)(ws + WS_VP); \
    bf16* O = (bf16*)(ws + WS_O); bf16* U = (bf16*)(ws + WS_U); bf16* UP = (bf16*)(ws + WS_UP); bf16* XV = (bf16*)(ws + WS_XV); bf16* ZC = (bf16*)(ws + WS_ZC); float* PART = (float*)(ws + WS_PART); \
    const float* rcos = misc + MO_RCOS; const float* rsin = misc + MO_RSIN; const float* mod = misc + MO_MOD + i * NMODW; const float* modc = misc + MO_MODC + i * NMODW; \
    (void)X; (void)H; (void)QKV; (void)KP; (void)VP; (void)O; (void)U; (void)UP; (void)XV; (void)ZC; (void)PART; (void)rcos; (void)rsin; (void)mod; (void)modc; (void)in;
#if MK_ONE_LAUNCH
#define PH_END PROBE_T1 if (ph + 1 < hi) xcd_barrier(bar); PROBE_T2 } ++ph;
#else
#define PH_END } ++ph;
#endif
    int i = 0;
    PH_BEGIN(0) REP(RP_PRO) { phase_prologue(F, in, ws); REPSYNC } PH_END
    PH_BEGIN(1) REP(RP_FIL) { phase_filters(F, in, ws); REPSYNC } PH_END

    for (i = 0; i < DEPTH; ++i) {
        const int j = i >> 1; const bool is_attn = (i & 1) == 0, ctx_upd = i < 2, has_ctx = is_attn || ctx_upd;
        const int nrows1 = has_ctx ? R : S, nrows2 = ctx_upd ? R : S;
        PH_BEGIN(2) REP(RP_THIN) { phase_norm_mod(F, X, H, nrows1, in[6] + i * D, mod, mod + D, modc, modc + D, PART, (i == 1 || i == 2) ? KS_DOWN : 0, modc - NMODW + 5 * D, nullptr); REPSYNC } PH_END
        PH_BEGIN(3) REP(RP_GIN) { const int N = is_attn ? AW : HW;
            pg8::Gemm g{H, is_attn ? (const bf16*)(ws + WS_WAIN) + (size_t)j * AW * D : (const bf16*)(ws + WS_WHIN) + (size_t)j * HW * D, nrows1, N, D};
            pg8::StaticOrder So; So.init(nrows1, N, D, F.G, F.bid);
            pg8::EpiBf16<0> E{is_attn ? QKV : UP, N, is_attn ? nullptr : in[14] + j * HW};
            pg8::gemm_phase<pg8::EpiBf16<0>, pg8::StaticOrder, PG8_ALIGN, PG8_SP2>(F.lds, g, So, E, F.tid); REPSYNC } PH_END
        if (is_attn) {
            PH_BEGIN(4) REP(RP_THIN) { phase_kprep(F, QKV, KP, VP, in[12] + j * HD, rcos, rsin); REPSYNC } PH_END
            PH_BEGIN(5) REP(RP_ATT) { phase_attn(F, QKV, KP, VP, O, ctx_upd, in[10] + j * 8, in[11] + j * HD, rcos, rsin); REPSYNC } PH_END
            ++ph;
        } else {
            PH_BEGIN(4) REP(RP_THIN) { phase_shortconv(F, UP, XV, in[15] + (size_t)j * 3 * HW, in[16] + j * HW, nrows2); REPSYNC } PH_END
            PH_BEGIN(6) REP(RP_CONV) { phase_longconv_mfma(F, XV, ZC, (const bf16*)(ws + WS_FILT) + (size_t)j * 4096 * 8320, misc + MO_FPART + j * 4096 * FCH, in[24] + j * 2 * D, tsub_);
                if (ctx_upd) { __syncthreads(); phase_ctxconv(F, XV, ZC, (const float*)(ws + WS_FILTC), misc + MO_FPARTC, in[24] + j * 2 * D); } REPSYNC } PH_END
            PH_BEGIN(4) REP(RP_THIN) { phase_transpose_zc(F, ZC, O, nrows2); REPSYNC } PH_END
        }
        PH_BEGIN(7) { pg8::Gemm g{O, is_attn ? (const bf16*)(ws + WS_WAOUT) + (size_t)j * D * D : (const bf16*)(ws + WS_WHOUT) + (size_t)j * D * D, S, D, D};
            pg8::StaticOrder So; So.init(S, D, D, F.G, F.bid); if (ctx_upd) So.extend(S / 256, KS_OUT);
            pg8::EpiResGate E{X, D, is_attn ? nullptr : in[26] + j * D, mod + 2 * D, modc + 2 * D, S / 256, PART};
            pg8::gemm_phase<pg8::EpiResGate, pg8::StaticOrder, PG8_ALIGN, PG8_SP2>(F.lds, g, So, E, F.tid); } PH_END
        PH_BEGIN(2) REP(RP_THIN) { phase_norm_mod(F, X, H, nrows2, in[7] + i * D, mod + 3 * D, mod + 4 * D, modc + 3 * D, modc + 4 * D, PART, ctx_upd ? KS_OUT : 0, modc + 2 * D, is_attn ? nullptr : in[26] + j * D); REPSYNC } PH_END
        PH_BEGIN(8) REP(RP_GUP) { pg8::Gemm g{H, (const bf16*)(ws + WS_WM1) + (size_t)i * FF * D, nrows2, FF, D}; pg8::StaticOrder So; So.init(nrows2, FF, D, F.G, F.bid);
            pg8::EpiBf16<1> E{U, FF, nullptr};
            pg8::gemm_phase<pg8::EpiBf16<1>, pg8::StaticOrder, PG8_ALIGN, PG8_SP2>(F.lds, g, So, E, F.tid); REPSYNC } PH_END
        PH_BEGIN(9) { pg8::Gemm g{U, (const bf16*)(ws + WS_WM2) + (size_t)i * D * FF, S, D, FF}; pg8::StaticOrder So; So.init(S, D, FF, F.G, F.bid); if (ctx_upd) So.extend(S / 256, KS_DOWN);
            pg8::EpiResGate E{X, D, nullptr, mod + 5 * D, modc + 5 * D, S / 256, PART};
            pg8::gemm_phase<pg8::EpiResGate, pg8::StaticOrder, PG8_ALIGN, PG8_SP2>(F.lds, g, So, E, F.tid); } PH_END
    }
#ifdef PROBE_GK
    PH_BEGIN(11) for (int rep_ = 0; rep_ < PROBE_GREPS; ++rep_) { pg8::Gemm g{H, (const bf16*)(ws + WS_WM1), S, FF, PROBE_GK}; pg8::StaticOrder So; So.init(S, FF, PROBE_GK, F.G, F.bid);
#ifdef PROBE_GNULL
            pg8::EpiNull E{};
            pg8::gemm_phase<pg8::EpiNull, pg8::StaticOrder, PG8_ALIGN, PG8_SP2>(F.lds, g, So, E, F.tid); __syncthreads(); } PH_END
#else
            pg8::EpiBf16<1> E{UP, FF, nullptr};
            pg8::gemm_phase<pg8::EpiBf16<1>, pg8::StaticOrder, PG8_ALIGN, PG8_SP2>(F.lds, g, So, E, F.tid); __syncthreads(); } PH_END
#endif
#endif
    PH_BEGIN(10) REP(RP_THIN) { phase_final_norm(F, X, out_, in[29]); REPSYNC } PH_END
#ifdef PROBE_MASK
    if (blockIdx.x == PROBE_BLOCK && threadIdx.x == 0) { const unsigned long long tend_ = __builtin_amdgcn_s_memrealtime() + (unsigned long long)PROBE_MULT * (tacc_ + tsub_); while (__builtin_amdgcn_s_memrealtime() < tend_) __builtin_amdgcn_s_sleep(32); }
#endif
#undef PH_BEGIN
#undef PH_END
}

extern "C" void kernel_launch(void* const* d_in, const int* in_sizes, int n_in, void* d_out, int out_size, void* d_ws, size_t ws_size, hipStream_t stream) {
    static int grid = 0;
    if (grid == 0) {
        if (n_in != 30 || out_size != S * D || ws_size < WS_END) { fprintf(stderr, "kernel_launch: unexpected shapes: n_in %d out %d ws %zu (need %zu)\n", n_in, out_size, ws_size, (size_t)WS_END); grid = -1; return; }
        int dev = 0, cus = 0, per_cu = 0;
        if (hipGetDevice(&dev) != hipSuccess || hipDeviceGetAttribute(&cus, hipDeviceAttributeMultiprocessorCount, dev) != hipSuccess) { grid = -1; return; }
        if (hipFuncSetAttribute((const void*)fwd, hipFuncAttributeMaxDynamicSharedMemorySize, LDS_BYTES) != hipSuccess) { fprintf(stderr, "kernel_launch: hipFuncSetAttribute failed\n"); grid = -1; return; }
        if (hipOccupancyMaxActiveBlocksPerMultiprocessor(&per_cu, (const void*)fwd, NTHREADS, LDS_BYTES) != hipSuccess || per_cu < 1)
            fprintf(stderr, "kernel_launch: occupancy query reports %d workgroups per CU\n", per_cu);
        (void)hipGetLastError();
        grid = cus;
    }
    if (grid < 0) return;
    (void)hipMemsetAsync((char*)d_ws + WS_CTL, 0, CTL_ZERO_BYTES, stream);
    Args a{};
    for (int i = 0; i < 30; ++i) a.in[i] = (const float*)d_in[i];
    a.out = (float*)d_out; a.ws = (unsigned char*)d_ws;
#if MK_ONE_LAUNCH
    a.ph_lo = 0; a.ph_hi = N_PHASES;
    hipLaunchKernelGGL(fwd, dim3(grid), dim3(NTHREADS), LDS_BYTES, stream, a);
#else
    for (int p = 0; p < N_PHASES; ++p) { a.ph_lo = p; a.ph_hi = p + 1; hipLaunchKernelGGL(fwd, dim3(grid), dim3(NTHREADS), LDS_BYTES, stream, a); }
#endif
    const hipError_t le = hipPeekAtLastError();
    if (le != hipSuccess) fprintf(stderr, "kernel_launch: launch failed: %s\n", hipGetErrorName(le));
}
```

```cpp
#include <hip/hip_runtime.h>
#include <cstdio>
#include <cstdint>
#define MK_ONE_LAUNCH 1
#ifndef ATT16
#define ATT16 0
#endif
#ifndef PG8_WGM
#define PG8_WGM 4
#endif
namespace pg8 {
#define PG8_LAS __attribute__((address_space(3)))
typedef unsigned short bf16_t;
typedef short bf16x8 __attribute__((ext_vector_type(8)));
typedef float f32x4 __attribute__((ext_vector_type(4)));
typedef unsigned u32x4 __attribute__((ext_vector_type(4)));
constexpr int BM = 256, BK = 64, HALF = 128, HTB = HALF * BK * 2  , STAGE_BYTES = 8 * HTB, NXCD = 8, WGM = PG8_WGM;

__host__ __device__ __forceinline__ int lds_byte(int r, int c) { const int st = (r >> 4) * 2 + (c >> 5), rr = r & 15, cc = c & 31, ob = rr * 64 + cc * 2; return st * 1024 + (ob ^ (((ob >> 9) & 1) << 5)); }
__host__ __device__ __forceinline__ void stage_rc(int b, int& R, int& C) { const int st = b / 1024, sb = b % 1024, swz = sb ^ (((sb >> 9) & 1) << 5); R = (st >> 1) * 16 + swz / 64; C = (st & 1) * 32 + (swz % 64) / 2; }
__host__ __device__ __forceinline__ int perm32(int rho) { const int n = rho >> 4, i = rho & 15; return 8 * (i >> 2) + 4 * n + (i & 3); }

struct Unit { int pm, pn; int ko, nt, split; };
struct Gemm { const bf16_t* A; const bf16_t* Bt; int M, N, K; };

struct StaticOrder {
    int nM, nN, nwg, G, c, ntk;
    int xpm, xks, xnt;
    __host__ __device__ void init(int M, int N, int K, int G_, int c_) { nM = M / BM; nN = N / BM; nwg = nM * nN; G = G_; c = c_; ntk = K / BK; xpm = 0; xks = 0; xnt = 0; }
    __host__ __device__ void extend(int pm, int ks) { xpm = pm; xks = ks; xnt = ntk / ks; }
    __host__ __device__ bool next(int i, Unit& u) const {
        const long L = (long)i * G + c; if (L >= nwg + xks * nN) return false;
        const bool ext = L >= nwg;
        int wgid = ext ? 0 : (int)L; { const int q = nwg / NXCD, r = nwg % NXCD, xcd = wgid % NXCD, off = wgid / NXCD; wgid = (xcd < r ? xcd * (q + 1) : r * (q + 1) + (xcd - r) * q) + off; }
        const int nig = WGM * nN, gid = wgid / nig, fm = gid * WGM, gsz = (nM - fm) < WGM ? (nM - fm) : WGM;
        const int pm_s = fm + ((wgid % nig) % gsz), pn_s = (wgid % nig) / gsz;
        const int q = ext ? (int)(L - nwg) : 0, ks = q / nN;
        u.pm = ext ? xpm : pm_s; u.pn = ext ? q - ks * nN : pn_s; u.ko = ext ? ks * xnt : 0; u.nt = ext ? xnt : ntk; u.split = ext ? 1 + ks : 0;
        return true;
    }
    __device__ __forceinline__ void a_ready(const Unit&) const {}
    __device__ __forceinline__ void done(const Unit&) const {}
};

__device__ __forceinline__ unsigned cvt_pk_bf16(float lo, float hi) { unsigned r; asm("v_cvt_pk_bf16_f32 %0, %1, %2" : "=v"(r) : "v"(lo), "v"(hi)); return r; }

template <int ACT> struct EpiBf16 {
    static constexpr bool PERM = true, AFTER_DRAIN = false;
    bf16_t* O; int ldc; const float* bias;
    __device__ __forceinline__ void operator()(const f32x4 (&acc)[2][2][4][2], const Unit& u, int wr, int wc, int fr, int fq) const {
        const int row0 = u.pm * BM + wr * 64 + fr; const int col0 = u.pn * BM + wc * 32 + 8 * fq;
        f32x4 bv[2][2];
#pragma unroll
        for (int bj = 0; bj < 2; ++bj)
#pragma unroll
            for (int n = 0; n < 2; ++n) bv[bj][n] = bias ? *(const f32x4*)(bias + col0 + bj * HALF + 4 * n) : (f32x4){0.f, 0.f, 0.f, 0.f};
#pragma unroll
        for (int ai = 0; ai < 2; ++ai)
#pragma unroll
            for (int m = 0; m < 4; ++m) { bf16_t* rowp = O + (size_t)(row0 + ai * HALF + m * 16) * ldc + col0;
#pragma unroll
                for (int bj = 0; bj < 2; ++bj) { f32x4 v0 = acc[ai][bj][m][0] + bv[bj][0], v1 = acc[ai][bj][m][1] + bv[bj][1];
                    if (ACT == 1) {
#pragma unroll
                        for (int j = 0; j < 4; ++j) { const float a = fmaxf(v0[j], 0.f), b = fmaxf(v1[j], 0.f); v0[j] = a * a; v1[j] = b * b; } }
                    u32x4 w; w.x = cvt_pk_bf16(v0[0], v0[1]); w.y = cvt_pk_bf16(v0[2], v0[3]); w.z = cvt_pk_bf16(v1[0], v1[1]); w.w = cvt_pk_bf16(v1[2], v1[3]);
                    *(u32x4*)(rowp + bj * HALF) = w; } }
    }
};
struct EpiResGate {
    static constexpr bool PERM = true, AFTER_DRAIN = false;
    bf16_t* X; int ldc; const float* bias; const float* gate_lat; const float* gate_ctx; int ctx_pm; float* P;
    __device__ __forceinline__ void operator()(const f32x4 (&acc)[2][2][4][2], const Unit& u, int wr, int wc, int fr, int fq) const {
        const int col0 = u.pn * BM + wc * 32 + 8 * fq;
        if (u.split) {
            float* base = P + ((size_t)(u.split - 1) * BM + wr * 64 + fr) * ldc + col0;
#pragma unroll
            for (int ai = 0; ai < 2; ++ai)
#pragma unroll
                for (int m = 0; m < 4; ++m) { float* rowp = base + (size_t)(ai * HALF + m * 16) * ldc;
#pragma unroll
                    for (int bj = 0; bj < 2; ++bj)
#pragma unroll
                        for (int n = 0; n < 2; ++n) *(f32x4*)(rowp + bj * HALF + n * 4) = acc[ai][bj][m][n]; }
            return;
        }
        const int row0 = u.pm * BM + wr * 64 + fr;
        const float* gate = (u.pm >= ctx_pm) ? gate_ctx : gate_lat;
        f32x4 bv[2][2], gv[2][2];
#pragma unroll
        for (int bj = 0; bj < 2; ++bj)
#pragma unroll
            for (int n = 0; n < 2; ++n) { bv[bj][n] = bias ? *(const f32x4*)(bias + col0 + bj * HALF + n * 4) : (f32x4){0.f, 0.f, 0.f, 0.f};
                gv[bj][n] = *(const f32x4*)(gate + col0 + bj * HALF + n * 4); }
#pragma unroll
        for (int ai = 0; ai < 2; ++ai)
#pragma unroll
            for (int m = 0; m < 4; ++m) { bf16_t* rowp = X + (size_t)(row0 + ai * HALF + m * 16) * ldc + col0;
#pragma unroll
                for (int bj = 0; bj < 2; ++bj) { u32x4* p = (u32x4*)(rowp + bj * HALF); const u32x4 old = *p;
                    const f32x4 v0 = gv[bj][0] * (acc[ai][bj][m][0] + bv[bj][0]), v1 = gv[bj][1] * (acc[ai][bj][m][1] + bv[bj][1]);
                    u32x4 w;
                    w.x = cvt_pk_bf16(__builtin_bit_cast(float, old.x << 16) + v0[0], __builtin_bit_cast(float, old.x & 0xffff0000u) + v0[1]);
                    w.y = cvt_pk_bf16(__builtin_bit_cast(float, old.y << 16) + v0[2], __builtin_bit_cast(float, old.y & 0xffff0000u) + v0[3]);
                    w.z = cvt_pk_bf16(__builtin_bit_cast(float, old.z << 16) + v1[0], __builtin_bit_cast(float, old.z & 0xffff0000u) + v1[1]);
                    w.w = cvt_pk_bf16(__builtin_bit_cast(float, old.w << 16) + v1[2], __builtin_bit_cast(float, old.w & 0xffff0000u) + v1[3]);
                    *p = w; } }
    }
};

struct EpiNull {
    static constexpr bool PERM = true, AFTER_DRAIN = false;
    __device__ __forceinline__ void operator()(const f32x4 (&acc)[2][2][4][2], const Unit&, int, int, int, int) const {
#pragma unroll
        for (int ai = 0; ai < 2; ++ai)
#pragma unroll
            for (int bj = 0; bj < 2; ++bj)
#pragma unroll
                for (int m = 0; m < 4; ++m)
#pragma unroll
                    for (int n = 0; n < 2; ++n) asm volatile("" :: "v"(acc[ai][bj][m][n]));
    }
};

template <class Epi, class Sched, bool ALIGN_EPI = false, bool SP2 = false>
__device__ __forceinline__ void gemm_phase(PG8_LAS unsigned char* lds, const Gemm g, const Sched& S, const Epi& E, const int tid) {
    const int wid = __builtin_amdgcn_readfirstlane(tid >> 6), lane = tid & 63, wr = wid >> 2, wc = wid & 3, fr = lane & 15, fq = lane >> 4;
    const int K = g.K;
    unsigned voffA[2], voffB[2];
#pragma unroll
    for (int i = 0; i < 2; ++i) { int R, C; stage_rc(tid * 16 + i * 8192, R, C); const int Rb = Epi::PERM ? ((R & ~31) + perm32(R & 31)) : R;
        voffA[i] = (unsigned)(R * K + C) * 2u; voffB[i] = (unsigned)(Rb * K + C) * 2u; }
    const size_t kstep = (size_t)(BK * 2);
    const size_t hstep = (size_t)HALF * K * 2;
    const size_t tstep = 2 * hstep;
    const unsigned ldsw = (unsigned)wid * 1024u;
    const int aoff = lds_byte(wr * 64 + fr, fq * 8), boff = lds_byte(wc * 32 + fr, fq * 8);
#define PG8_SA(b, h) (((b) * 2 + (h)) * HTB)
#define PG8_SB(b, h) ((4 + (b) * 2 + (h)) * HTB)
#define PG8_STAGE(bufoff, gbase, voff) do { _Pragma("unroll") for (int _i = 0; _i < 2; ++_i) \
        __builtin_amdgcn_global_load_lds((const unsigned*)((const char*)(gbase) + (voff)[_i]), (PG8_LAS unsigned*)(lds + (bufoff) + ldsw + _i * 8192), 16, 0, 0); } while (0)
#define PG8_LDA(dst, b, h) do { _Pragma("unroll") for (int m = 0; m < 4; ++m) _Pragma("unroll") for (int k = 0; k < 2; ++k) dst[m][k] = *(const PG8_LAS bf16x8*)(lds + PG8_SA(b, h) + aoff + m * 2048 + k * 1024); } while (0)
#define PG8_LDB(dst, b, h) do { _Pragma("unroll") for (int n = 0; n < 2; ++n) _Pragma("unroll") for (int k = 0; k < 2; ++k) dst[n][k] = *(const PG8_LAS bf16x8*)(lds + PG8_SB(b, h) + boff + n * 2048 + k * 1024); } while (0)
#define PG8_MMA(ai, bj, At, Bt) do { __builtin_amdgcn_s_setprio(1); _Pragma("unroll") for (int m = 0; m < 4; ++m) _Pragma("unroll") for (int n = 0; n < 2; ++n) _Pragma("unroll") for (int k = 0; k < 2; ++k) \
        acc[ai][bj][m][n] = __builtin_amdgcn_mfma_f32_16x16x32_bf16(Bt[n][k], At[m][k], acc[ai][bj][m][n], 0, 0, 0); __builtin_amdgcn_s_setprio(0); } while (0)
#define PG8_WAIT_V(n) asm volatile("s_waitcnt vmcnt(" #n ")" ::: "memory")
#define PG8_WAIT_L(n) asm volatile("s_waitcnt lgkmcnt(" #n ")" ::: "memory")
#define PG8_BAR __builtin_amdgcn_s_barrier()
#define PG8_SCHED __builtin_amdgcn_sched_barrier(0)
    Unit cur, nxt; int ui = 0;
    if (!S.next(0, cur)) return;
    f32x4 acc[2][2][4][2];
#pragma unroll
    for (int a = 0; a < 2; ++a)
#pragma unroll
        for (int b = 0; b < 2; ++b)
#pragma unroll
            for (int m = 0; m < 4; ++m)
#pragma unroll
                for (int n = 0; n < 2; ++n) acc[a][b][m][n] = (f32x4){0.f, 0.f, 0.f, 0.f};
    bf16x8 At[4][2], B0[2][2], B1[2][2];
    const char* cA = (const char*)g.A + (size_t)cur.pm * tstep + (size_t)cur.ko * (BK * 2); const char* cB = (const char*)g.Bt + (size_t)cur.pn * tstep + (size_t)cur.ko * (BK * 2);
    S.a_ready(cur);
    if constexpr (SP2) {
        PG8_STAGE(PG8_SB(0, 0), cB, voffB); PG8_STAGE(PG8_SB(0, 1), cB + hstep, voffB); PG8_STAGE(PG8_SA(0, 0), cA, voffA); PG8_STAGE(PG8_SA(0, 1), cA + hstep, voffA);
        if (wr == 1) PG8_BAR;
        PG8_WAIT_V(2); PG8_BAR;
        PG8_STAGE(PG8_SB(1, 0), cB + kstep, voffB); PG8_STAGE(PG8_SA(1, 0), cA + kstep, voffA); PG8_STAGE(PG8_SB(1, 1), cB + hstep + kstep, voffB);
        PG8_WAIT_V(6); PG8_BAR;
    } else {
        PG8_STAGE(PG8_SB(0, 0), cB, voffB); PG8_STAGE(PG8_SA(0, 0), cA, voffA); PG8_STAGE(PG8_SB(0, 1), cB + hstep, voffB); PG8_STAGE(PG8_SA(0, 1), cA + hstep, voffA);
        if (wr == 1) PG8_BAR;
        PG8_WAIT_V(4); PG8_BAR;
        PG8_STAGE(PG8_SB(1, 0), cB + kstep, voffB); PG8_STAGE(PG8_SA(1, 0), cA + kstep, voffA); PG8_STAGE(PG8_SB(1, 1), cB + hstep + kstep, voffB);
        PG8_WAIT_V(6); PG8_BAR;
    }
    for (;;) {
        const bool has_next = S.next(ui + 1, nxt);
        const char* nA = has_next ? (const char*)g.A + (size_t)nxt.pm * tstep + (size_t)nxt.ko * (BK * 2) : cA; const char* nB = has_next ? (const char*)g.Bt + (size_t)nxt.pn * tstep + (size_t)nxt.ko * (BK * 2) : cB;
        const int nt = cur.nt;
        for (int t = 0; t < nt; t += 2) {
            const bool last = (t == nt - 2);
            const char* a1 = cA + (size_t)(t + 1) * kstep;
            const char* a2 = last ? nA : cA + (size_t)(t + 2) * kstep; const char* b2 = last ? nB : cB + (size_t)(t + 2) * kstep;
            const char* a3 = a2 + kstep; const char* b3 = b2 + kstep;
            if (last && has_next) S.a_ready(nxt);
            if constexpr (SP2) {
            PG8_LDB(B0, 0, 0); PG8_LDB(B1, 0, 1); PG8_SCHED; PG8_LDA(At, 0, 0); PG8_STAGE(PG8_SA(1, 1), a1 + hstep, voffA);
            PG8_WAIT_V(8); PG8_WAIT_L(0); PG8_BAR; PG8_MMA(0, 0, At, B0); PG8_MMA(0, 1, At, B1); PG8_BAR; PG8_SCHED;
            PG8_LDA(At, 0, 1); PG8_STAGE(PG8_SB(0, 0), b2, voffB); PG8_STAGE(PG8_SB(0, 1), b2 + hstep, voffB); PG8_STAGE(PG8_SA(0, 0), a2, voffA);
            PG8_WAIT_V(8); PG8_WAIT_L(0); PG8_BAR; PG8_MMA(1, 0, At, B0); PG8_MMA(1, 1, At, B1); PG8_BAR; PG8_SCHED;
            PG8_LDB(B0, 1, 0); PG8_LDB(B1, 1, 1); PG8_SCHED; PG8_LDA(At, 1, 0); PG8_STAGE(PG8_SA(0, 1), a2 + hstep, voffA);
            PG8_WAIT_V(8); PG8_WAIT_L(0); PG8_BAR; PG8_MMA(0, 0, At, B0); PG8_MMA(0, 1, At, B1); PG8_BAR; PG8_SCHED;
            PG8_LDA(At, 1, 1); PG8_STAGE(PG8_SB(1, 0), b3, voffB); PG8_STAGE(PG8_SB(1, 1), b3 + hstep, voffB); PG8_STAGE(PG8_SA(1, 0), a3, voffA);
            PG8_WAIT_V(8); PG8_WAIT_L(0); PG8_BAR; PG8_MMA(1, 0, At, B0); PG8_MMA(1, 1, At, B1); PG8_BAR; PG8_SCHED;
            } else {
            PG8_LDB(B0, 0, 0); PG8_SCHED; PG8_LDA(At, 0, 0); PG8_STAGE(PG8_SA(1, 1), a1 + hstep, voffA);
            PG8_WAIT_L(8); PG8_BAR; PG8_WAIT_L(0); PG8_MMA(0, 0, At, B0); PG8_BAR; PG8_SCHED;
            PG8_LDB(B1, 0, 1); PG8_STAGE(PG8_SB(0, 0), b2, voffB);
            PG8_BAR; PG8_WAIT_L(0); PG8_MMA(0, 1, At, B1); PG8_BAR;
            PG8_LDA(At, 0, 1); PG8_STAGE(PG8_SA(0, 0), a2, voffA);
            PG8_BAR; PG8_WAIT_L(0); PG8_MMA(1, 0, At, B0); PG8_BAR; PG8_SCHED;
            PG8_STAGE(PG8_SB(0, 1), b2 + hstep, voffB);
            PG8_WAIT_V(6); PG8_BAR; PG8_MMA(1, 1, At, B1); PG8_BAR;
            PG8_LDB(B0, 1, 0); PG8_SCHED; PG8_LDA(At, 1, 0); PG8_STAGE(PG8_SA(0, 1), a2 + hstep, voffA);
            PG8_WAIT_L(8); PG8_BAR; PG8_WAIT_L(0); PG8_MMA(0, 0, At, B0); PG8_BAR; PG8_SCHED;
            PG8_LDB(B1, 1, 1); PG8_STAGE(PG8_SB(1, 0), b3, voffB);
            PG8_BAR; PG8_WAIT_L(0); PG8_MMA(0, 1, At, B1); PG8_BAR;
            PG8_LDA(At, 1, 1); PG8_STAGE(PG8_SA(1, 0), a3, voffA);
            PG8_BAR; PG8_WAIT_L(0); PG8_MMA(1, 0, At, B0); PG8_BAR; PG8_SCHED;
            PG8_STAGE(PG8_SB(1, 1), b3 + hstep, voffB);
            PG8_WAIT_V(6); PG8_BAR; PG8_MMA(1, 1, At, B1); PG8_BAR;
            }
        }
        if constexpr (ALIGN_EPI) { if (wr == 0) PG8_BAR; }
        if constexpr (!Epi::AFTER_DRAIN) { E(acc, cur, wr, wc, fr, fq); S.done(cur); }
        if (!has_next) break;
#pragma unroll
        for (int a = 0; a < 2; ++a)
#pragma unroll
            for (int b = 0; b < 2; ++b)
#pragma unroll
                for (int m = 0; m < 4; ++m)
#pragma unroll
                    for (int n = 0; n < 2; ++n) acc[a][b][m][n] = (f32x4){0.f, 0.f, 0.f, 0.f};
        cur = nxt; cA = nA; cB = nB; ++ui;
        if constexpr (ALIGN_EPI) { if (wr == 1) PG8_BAR; }
    }
    PG8_WAIT_V(0);
    if constexpr (!ALIGN_EPI) { if (wr == 0) PG8_BAR; }
    PG8_BAR;
    if constexpr (Epi::AFTER_DRAIN) { E.fused(acc, cur, wr, wc, fr, fq, lds, wid, lane); S.done(cur); }
#undef PG8_SA
#undef PG8_SB
#undef PG8_STAGE
#undef PG8_LDA
#undef PG8_LDB
#undef PG8_MMA
#undef PG8_WAIT_V
#undef PG8_WAIT_L
#undef PG8_BAR
#undef PG8_SCHED
}
}
#ifndef PG8_SP2
#define PG8_SP2 true
#endif
#ifndef PG8_ALIGN
#define PG8_ALIGN true
#endif
#ifndef MK_ONE_LAUNCH
#define MK_ONE_LAUNCH 0
#endif

constexpr int D = 2048, S = 8192, C = 256, R = S + C, DEPTH = 4, HD = 128;
constexpr int AW = 3072, HW = 6144, FF = 8192, NMODW = 6 * D;
constexpr float EPS = 1e-6f;
constexpr float QSCALE = 0.08838834764831845f;
constexpr float MIN_DECAY = -3.0701134573253944f, MAX_DECAY = -15.350567286626973f;
constexpr int NWAVES = 8, NTHREADS = 512;
#ifndef KS_DOWN_V
#define KS_DOWN_V 16
#endif
#ifndef KS_OUT_V
#define KS_OUT_V 4
#endif
constexpr int KS_OUT = KS_OUT_V, KS_DOWN = KS_DOWN_V;

constexpr size_t MiB = 1u << 20;
constexpr size_t WS_CTL = 0, CTL_ZERO_BYTES = 1 * MiB;
constexpr size_t WS_WAIN = 1 * MiB;
constexpr size_t WS_WAOUT = WS_WAIN + 24 * MiB;
constexpr size_t WS_WHIN = WS_WAOUT + 16 * MiB;
constexpr size_t WS_WHOUT = WS_WHIN + 48 * MiB;
constexpr size_t WS_WM1 = WS_WHOUT + 16 * MiB;
constexpr size_t WS_WM2 = WS_WM1 + 128 * MiB;
constexpr size_t WS_X = WS_WM2 + 128 * MiB;
constexpr size_t WS_H = WS_X + 66 * MiB;
constexpr size_t WS_QKV = WS_H + 33 * MiB;
constexpr size_t WS_KP = WS_QKV + 50 * MiB;
constexpr size_t WS_VP = WS_KP + 9 * MiB;
constexpr size_t WS_O = WS_VP + 9 * MiB;
constexpr size_t WS_U = WS_O + 33 * MiB;
constexpr size_t WS_UP = WS_U + 132 * MiB;
constexpr size_t WS_XV = WS_UP + 99 * MiB;
constexpr size_t WS_ZC = WS_XV + 99 * MiB;
constexpr size_t WS_FILT = WS_ZC + 33 * MiB;
constexpr size_t WS_FILTC = WS_FILT + 256 * MiB;
constexpr size_t WS_HID = WS_FILTC + 4 * MiB;
constexpr size_t WS_MISC = WS_HID + 5 * MiB;
constexpr size_t WS_PART = WS_MISC + 2 * MiB;
constexpr size_t WS_END = WS_PART + 32 * MiB;
constexpr int MO_MOD = 0, MO_MODC = MO_MOD + 4 * NMODW, MO_RCOS = MO_MODC + 4 * NMODW, MO_RSIN = MO_RCOS + 128 * 32, MO_FPART = MO_RSIN + 128 * 32, MO_FPARTC = MO_FPART + 2 * 4096 * 32, MO_END = MO_FPARTC + 4096 * 8;
static_assert((size_t)MO_END * 4 <= 2 * MiB, "misc");
constexpr int CW_BAR = 4096;

constexpr int LDS_BYTES = 147456;
constexpr int MISC_OFF = LDS_BYTES - 256;

typedef const float* const __attribute__((address_space(4)))* InTab;
#define GAS __attribute__((address_space(1)))
#define LAS __attribute__((address_space(3)))
typedef unsigned short bf16;
typedef unsigned v4u __attribute__((ext_vector_type(4)));
typedef unsigned v2u __attribute__((ext_vector_type(2)));
typedef float f32x4 __attribute__((ext_vector_type(4)));
#define LDS_WAIT() asm volatile("s_waitcnt lgkmcnt(0)" ::: "memory")
__device__ __forceinline__ unsigned f2bf(float f) { unsigned u = __builtin_bit_cast(unsigned, f); return (u + 0x7fffu + ((u >> 16) & 1u)) >> 16; }
__device__ __forceinline__ unsigned pk2(float lo, float hi) { unsigned r; asm("v_cvt_pk_bf16_f32 %0, %1, %2" : "=v"(r) : "v"(lo), "v"(hi)); return r; }
__device__ __forceinline__ float bf2f(unsigned b) { return __builtin_bit_cast(float, b << 16); }
__device__ __forceinline__ float xl_dpp_b1(float v) { return __builtin_bit_cast(float, __builtin_amdgcn_update_dpp(0, __builtin_bit_cast(int, v), 0xB1, 0xF, 0xF, true)); }
__device__ __forceinline__ float xl_dpp_4e(float v) { return __builtin_bit_cast(float, __builtin_amdgcn_update_dpp(0, __builtin_bit_cast(int, v), 0x4E, 0xF, 0xF, true)); }
__device__ __forceinline__ float xl_swz4(float v)  { return __builtin_bit_cast(float, __builtin_amdgcn_ds_swizzle(__builtin_bit_cast(int, v), 0x101F)); }
__device__ __forceinline__ float xl_swz8(float v)  { return __builtin_bit_cast(float, __builtin_amdgcn_ds_swizzle(__builtin_bit_cast(int, v), 0x201F)); }
__device__ __forceinline__ float xl_swz16(float v) { return __builtin_bit_cast(float, __builtin_amdgcn_ds_swizzle(__builtin_bit_cast(int, v), 0x401F)); }
__device__ __forceinline__ float xl_x32(float v) { const unsigned u = __builtin_bit_cast(unsigned, v); auto rr = __builtin_amdgcn_permlane32_swap(u, u, false, false);
    return __builtin_bit_cast(float, (unsigned)((threadIdx.x & 32) ? rr[0] : rr[1])); }
__device__ __forceinline__ float wave_sum(float v) {
    v += xl_dpp_b1(v); v += xl_dpp_4e(v); v += xl_swz4(v); v += xl_swz8(v); v += xl_swz16(v);
    { const unsigned u = __builtin_bit_cast(unsigned, v); auto rr = __builtin_amdgcn_permlane32_swap(u, u, false, false); v = __builtin_bit_cast(float, (unsigned)rr[0]) + __builtin_bit_cast(float, (unsigned)rr[1]); }
    return v;
}
__device__ __forceinline__ float wave_max(float v) {
    v = fmaxf(v, xl_dpp_b1(v)); v = fmaxf(v, xl_dpp_4e(v)); v = fmaxf(v, xl_swz4(v)); v = fmaxf(v, xl_swz8(v)); v = fmaxf(v, xl_swz16(v));
    { const unsigned u = __builtin_bit_cast(unsigned, v); auto rr = __builtin_amdgcn_permlane32_swap(u, u, false, false); v = fmaxf(__builtin_bit_cast(float, (unsigned)rr[0]), __builtin_bit_cast(float, (unsigned)rr[1])); }
    return v;
}
#define XB_SPIN_CAP_OVERRIDE 1
#define XB_TMO      128
#define XB_XCNT(j)  (256  + 64 * (j))
#define XB_XSUB(j)  (1280 + 64 * (j))
#define XB_XGEN(j)  (2304 + 64 * (j))
#define XB_TOP      3328
#define XB_TOPGEN   3392
#define XCD_BAR_WORDS 3456
#define XB_SPIN_CAP (1u << 22)

__device__ __forceinline__ unsigned xb_ld(unsigned* p)              { return __hip_atomic_load(p, __ATOMIC_RELAXED, __HIP_MEMORY_SCOPE_AGENT); }
__device__ __forceinline__ unsigned xb_add(unsigned* p, unsigned v) { return __hip_atomic_fetch_add(p, v, __ATOMIC_RELAXED, __HIP_MEMORY_SCOPE_AGENT); }
__device__ __forceinline__ unsigned xb_xcc_id() { return (unsigned)__builtin_amdgcn_s_getreg((3 << 11) | 20) & 0xFu; }
#define XB_SPIN(cond, bar) do { unsigned _sp = 0; while (cond) { __builtin_amdgcn_s_sleep(1); \
    if ((++_sp & 255u) == 0u) { if (xb_ld(&(bar)[XB_TMO])) break; if (_sp > XB_SPIN_CAP) { atomicAdd(&(bar)[XB_TMO], 1u); break; } } } } while (0)

struct XcdBarrier {
    unsigned* bar; unsigned x;
    volatile LAS unsigned* st;
};

__device__ __forceinline__ XcdBarrier xcd_barrier_post(unsigned* bar, volatile LAS unsigned* st) {
    XcdBarrier b; b.bar = bar; b.x = xb_xcc_id(); b.st = st;
    if (threadIdx.x == 0) (void)xb_add(&bar[XB_XCNT(b.x)], 1u);
    return b;
}
__device__ __forceinline__ void xcd_barrier_complete(unsigned* bar, unsigned x, unsigned& nloc, unsigned& nx) {
    const unsigned G = gridDim.x * gridDim.y * gridDim.z;
    unsigned sum, cnt, mine, sp = 0u;
    for (;;) {
        sum = 0u; cnt = 0u; mine = 0u;
#pragma unroll
        for (unsigned j = 0; j < 16; ++j) { const unsigned c = xb_ld(&bar[XB_XCNT(j)]); sum += c; cnt += (c > 0u) ? 1u : 0u; mine = (j == x) ? c : mine; }
        if (sum == G) break;
        __builtin_amdgcn_s_sleep(1);
        if ((++sp & 255u) == 0u) { if (xb_ld(&bar[XB_TMO])) break; if (sp > XB_SPIN_CAP) { atomicAdd(&bar[XB_TMO], 1u); break; } }
    }
    nloc = mine > 0u ? mine : 1u; nx = cnt > 0u ? cnt : 1u;
}

__device__ __forceinline__ void xcd_barrier(const XcdBarrier& b) {
    asm volatile("s_waitcnt vmcnt(0)" ::: "memory");
    __syncthreads();
    if (threadIdx.x == 0) {
        unsigned* bar = b.bar;
        __builtin_amdgcn_s_waitcnt(0);
        unsigned nloc = b.st[0], nx = b.st[1];
        if (nloc == 0u) { xcd_barrier_complete(bar, b.x, nloc, nx); b.st[0] = nloc; b.st[1] = nx; }
        const unsigned old = xb_add(&bar[XB_XSUB(b.x)], 1u);
        const unsigned gen = old / nloc;
        if (old + 1u == (gen + 1u) * nloc) {
            __builtin_amdgcn_fence(__ATOMIC_RELEASE, "agent");
            asm volatile("s_waitcnt vmcnt(0)" ::: "memory");
            const unsigned og = xb_add(&bar[XB_TOP], 1u);
            const unsigned tg = og / nx;
            if (og + 1u == (tg + 1u) * nx) xb_add(&bar[XB_TOPGEN], 1u);
            else XB_SPIN(xb_ld(&bar[XB_TOPGEN]) == tg, bar);
            __builtin_amdgcn_fence(__ATOMIC_ACQUIRE, "agent");
            xb_add(&bar[XB_XGEN(b.x)], 1u);
            asm volatile("s_waitcnt vmcnt(0)" ::: "memory");
        } else {
            XB_SPIN(xb_ld(&bar[XB_XGEN(b.x)]) == gen, bar);
            __builtin_amdgcn_fence(__ATOMIC_ACQUIRE, "agent");
            asm volatile("s_waitcnt vmcnt(0)" ::: "memory");
        }
    }
    __syncthreads();
}

#ifndef TILE_TR
#define TILE_TR 1
#endif
#if TILE_TR
#undef MLPW_IN_PROLOGUE
#define MLPW_IN_PROLOGUE 1
#endif
#ifndef MLPW_IN_PROLOGUE
#define MLPW_IN_PROLOGUE 0
#endif
__device__ __forceinline__ void p0_transpose_item(const float* W, int K, int N, bf16* WT, LAS float* scr, int item, int lane) {
    const int nblk = N / 32, kb = item / nblk, nb = item % nblk, k0 = 64 * kb, n0 = 32 * nb;
#pragma unroll 8
    for (int i = 0; i < 32; ++i) { const int kk = 2 * i + (lane >> 5); scr[kk * 33 + (lane & 31)] = W[(size_t)(k0 + kk) * N + n0 + (lane & 31)]; }
    LDS_WAIT();
    const int c = lane & 7;
#pragma unroll
    for (int j = 0; j < 4; ++j) { const int n = (lane >> 3) + 8 * j; const LAS float* s = scr + (8 * c) * 33 + n;
        v4u o; o.x = pk2(s[0 * 33], s[1 * 33]); o.y = pk2(s[2 * 33], s[3 * 33]); o.z = pk2(s[4 * 33], s[5 * 33]); o.w = pk2(s[6 * 33], s[7 * 33]);
        *(v4u*)(WT + (size_t)(n0 + n) * K + k0 + 8 * c) = o; }
    LDS_WAIT();
}
__device__ __forceinline__ void transpose_mat(const float* W, int K, int N, bf16* WT, LAS float* scr, int gw, int NGW, int lane) {
    const int items = (K / 64) * (N / 32);
    for (int it = gw; it < items; it += NGW) p0_transpose_item(W, K, N, WT, scr, it, lane);
}

struct Ctx {
    LAS unsigned char* lds; int tid, lane, wave, bid, G, gw, NGW;
};

#ifndef TR_NT
#define TR_NT 1
#endif
#if TR_NT & 1
#define TR_LD(p_) __builtin_nontemporal_load(p_)
#else
#define TR_LD(p_) (*(p_))
#endif
#if TR_NT & 2
#define TR_ST(p_, v_) __builtin_nontemporal_store(v_, p_)
#else
#define TR_ST(p_, v_) (*(p_) = (v_))
#endif
#ifndef NT_THIN
#define NT_THIN 0
#endif
#if NT_THIN
#define NTL(p_) __builtin_nontemporal_load(p_)
#else
#define NTL(p_) (*(p_))
#endif
struct TrTile { const float* W; bf16* WT; int K, N, t; };
constexpr int TR_MIX = 192 + 128 + 384 + 128, TR_TILES = 2 * TR_MIX + 4 * 1024;
__device__ __forceinline__ TrTile tr_decode(int g, InTab in, unsigned char* ws) {
    TrTile r;
    if (g < 2 * TR_MIX) { const int j = g >= TR_MIX ? 1 : 0; int q = g - TR_MIX * j;
        if (q < 192)      { r.W = in[8] + (size_t)j * D * AW;  r.WT = (bf16*)(ws + WS_WAIN) + (size_t)j * AW * D;  r.K = D; r.N = AW; r.t = q; }
        else if (q < 320) { r.W = in[9] + (size_t)j * D * D;   r.WT = (bf16*)(ws + WS_WAOUT) + (size_t)j * D * D;  r.K = D; r.N = D;  r.t = q - 192; }
        else if (q < 704) { r.W = in[13] + (size_t)j * D * HW; r.WT = (bf16*)(ws + WS_WHIN) + (size_t)j * HW * D;  r.K = D; r.N = HW; r.t = q - 320; }
        else              { r.W = in[25] + (size_t)j * D * D;  r.WT = (bf16*)(ws + WS_WHOUT) + (size_t)j * D * D;  r.K = D; r.N = D;  r.t = q - 704; }
    } else { g -= 2 * TR_MIX; const int i = g >> 10, q = g & 1023;
        if (q < 512) { r.W = in[27] + (size_t)i * D * FF; r.WT = (bf16*)(ws + WS_WM1) + (size_t)i * FF * D; r.K = D;  r.N = FF; r.t = q; }
        else         { r.W = in[28] + (size_t)i * FF * D; r.WT = (bf16*)(ws + WS_WM2) + (size_t)i * D * FF; r.K = FF; r.N = D;  r.t = q - 512; } }
    return r;
}
__device__ __forceinline__ void tr_load(const TrTile T, int wave, int lane, float (&r)[16][4]) {
    const int nbk = T.N >> 8, kb = T.t / nbk, nb = T.t - kb * nbk;
    const char* base = (const char*)(T.W + (size_t)(128 * kb + 16 * wave) * T.N + 256 * nb);
    unsigned off = (unsigned)lane * 4u; const unsigned pitch = (unsigned)T.N * 4u;
#pragma unroll
    for (int q = 0; q < 16; ++q) {
#pragma unroll
        for (int e = 0; e < 4; ++e) r[q][e] = TR_LD((const float*)(base + off + 256 * e));
        off += pitch; asm volatile("" : "+v"(off)); }
}
__device__ __forceinline__ void tr_put(const float (&r)[16][4], LAS unsigned* tile, int wave, int lane) {
    LAS unsigned* p = tile + lane * 65 + 8 * wave;
#pragma unroll
    for (int rp = 0; rp < 8; ++rp)
#pragma unroll
        for (int e = 0; e < 4; ++e) p[64 * 65 * e + rp] = pk2(r[2 * rp][e], r[2 * rp + 1][e]);
}
__device__ __forceinline__ void tr_out(const TrTile T, const LAS unsigned* tile, int wave, int lane) {
    const int nbk = T.N >> 8, kb = T.t / nbk, nb = T.t - kb * nbk, c = lane & 15, rr = lane >> 4;
    bf16* dst = T.WT + (size_t)(256 * nb + 32 * wave + rr) * T.K + 128 * kb + 8 * c;
    const LAS unsigned* src = tile + (32 * wave + rr) * 65 + 4 * c;
#pragma unroll
    for (int it = 0; it < 8; ++it) { v4u o; o.x = src[4 * it * 65 + 0]; o.y = src[4 * it * 65 + 1]; o.z = src[4 * it * 65 + 2]; o.w = src[4 * it * 65 + 3];
        TR_ST((v4u*)(dst + (size_t)(4 * it) * T.K), o); }
}
__device__ __forceinline__ void tile_transposes(const Ctx& F, InTab in, unsigned char* ws) {
    LAS unsigned* tile = (LAS unsigned*)F.lds;
    float r[16][4];
    int g = F.bid;
    if (g < TR_TILES) tr_load(tr_decode(g, in, ws), F.wave, F.lane, r);
    for (; g < TR_TILES; g += F.G) {
        const TrTile T = tr_decode(g, in, ws);
        tr_put(r, tile, F.wave, F.lane);
        __syncthreads();
        if (g + F.G < TR_TILES) tr_load(tr_decode(g + F.G, in, ws), F.wave, F.lane, r);
        tr_out(T, tile, F.wave, F.lane);
        __syncthreads();
    }
}

__device__ __forceinline__ void phase_prologue(const Ctx& F, InTab in, unsigned char* ws) {
    float* misc = (float*)(ws + WS_MISC);
    LAS float* scr = (LAS float*)(F.lds + F.wave * 16384);
#if TILE_TR
    tile_transposes(F, in, ws);
#else
    for (int j = 0; j < 2; ++j) {
        transpose_mat(in[8] + (size_t)j * D * AW, D, AW, (bf16*)(ws + WS_WAIN) + (size_t)j * AW * D, scr, F.gw, F.NGW, F.lane);
        transpose_mat(in[9] + (size_t)j * D * D, D, D, (bf16*)(ws + WS_WAOUT) + (size_t)j * D * D, scr, F.gw, F.NGW, F.lane);
        transpose_mat(in[13] + (size_t)j * D * HW, D, HW, (bf16*)(ws + WS_WHIN) + (size_t)j * HW * D, scr, F.gw, F.NGW, F.lane);
        transpose_mat(in[25] + (size_t)j * D * D, D, D, (bf16*)(ws + WS_WHOUT) + (size_t)j * D * D, scr, F.gw, F.NGW, F.lane);
    }
#if MLPW_IN_PROLOGUE
    for (int i = 0; i < 4; ++i) {
        transpose_mat(in[27] + (size_t)i * D * FF, D, FF, (bf16*)(ws + WS_WM1) + (size_t)i * FF * D, scr, F.gw, F.NGW, F.lane);
        transpose_mat(in[28] + (size_t)i * FF * D, FF, D, (bf16*)(ws + WS_WM2) + (size_t)i * D * FF, scr, F.gw, F.NGW, F.lane);
    }
#endif
#endif
    {
        v4u* X8 = (v4u*)(ws + WS_X); const f32x4* x4 = (const f32x4*)in[0]; const f32x4* c4 = (const f32x4*)in[2];
        const int gt = F.bid * NTHREADS + F.tid, NGT = F.G * NTHREADS;
        for (int i = gt; i < S * D / 8; i += NGT) { const f32x4 a = TR_LD(&x4[2 * i]), b = TR_LD(&x4[2 * i + 1]); v4u w; w.x = pk2(a.x, a.y); w.y = pk2(a.z, a.w); w.z = pk2(b.x, b.y); w.w = pk2(b.z, b.w); X8[i] = w; }
        for (int i = gt; i < C * D / 8; i += NGT) { const f32x4 a = c4[2 * i], b = c4[2 * i + 1]; v4u w; w.x = pk2(a.x, a.y); w.y = pk2(a.z, a.w); w.z = pk2(b.x, b.y); w.w = pk2(b.z, b.w); X8[S * D / 8 + i] = w; }
        for (int i = gt; i < 128 * 32; i += NGT) { const int pos = i >> 5, k = i & 31; const float inv = powf(10000.0f, -(float)(2 * k) / 64.0f); const float a = (float)pos * inv;
            misc[MO_RCOS + i] = cosf(a); misc[MO_RSIN + i] = sinf(a); }
    }
    {
        float* HID = (float*)(ws + WS_HID);
        const int hb0 = F.G > 4 * 48 ? 4 * 48 : 0, nhw = (F.G - hb0) * NWAVES;
        if (F.bid >= hb0) {
            int jc = -1; float w1r[33], w2r[64], b1 = 0.f, f1 = 0.f, b2 = 0.f, f2 = 0.f;
            for (int p = (F.bid - hb0) * NWAVES + F.wave; p < 2 * S + C; p += nhw) {
                int j, i, n; if (p < 2 * S) { j = p >> 13; i = p & (S - 1); n = S; } else { j = 0; i = p - 2 * S; n = C; }
                if (j != jc) { jc = j; const float* w1 = in[17] + (size_t)j * 33 * 64; const float* w2 = in[20] + (size_t)j * 64 * 64;
#pragma unroll
                    for (int f = 0; f < 33; ++f) w1r[f] = w1[f * 64 + F.lane];
#pragma unroll
                    for (int q = 0; q < 64; ++q) w2r[q] = w2[q * 64 + F.lane];
                    b1 = in[18][j * 64 + F.lane]; f1 = in[19][j * 64 + F.lane]; b2 = in[21][j * 64 + F.lane]; f2 = in[22][j * 64 + F.lane]; }
                const float tt = (float)i / (float)(n - 1);
                const float w = (6.283185307179586f * (float)i) / (float)n;
                const int k = (F.lane - 1) & 15; const float fk = 1e-4f + (float)k * ((15.0f - 1e-4f) / 15.0f);
                const float feat = F.lane == 0 ? tt : (F.lane <= 16 ? cosf(fk * w) : (F.lane <= 32 ? -sinf(fk * w) : 0.f));
                float a = b1;
#pragma unroll
                for (int f = 0; f < 33; ++f) a += __builtin_bit_cast(float, __builtin_amdgcn_readlane(__builtin_bit_cast(int, feat), f)) * w1r[f];
                const float h1 = sinf(f1 * a);
                float b = b2;
#pragma unroll
                for (int q = 0; q < 64; ++q) b += __builtin_bit_cast(float, __builtin_amdgcn_readlane(__builtin_bit_cast(int, h1), q)) * w2r[q];
                HID[(size_t)p * 64 + F.lane] = sinf(f2 * b);
            }
        }
    }
    __syncthreads();
    {
        LAS float* s_c = (LAS float*)F.lds; LAS float* s_cc = s_c + D; LAS f32x4* red = (LAS f32x4*)(F.lds + 16384);
        for (int k = F.tid; k < D; k += NTHREADS) { const float a = in[1][k], b = in[3][k]; s_c[k] = a / (1.0f + expf(-a)); s_cc[k] = b / (1.0f + expf(-b)); }
        __syncthreads();
        for (int item = F.bid; item < 4 * 48; item += F.G) {
            const int layer = item / 48, chunk = item % 48, col4 = chunk * 64 + F.lane;
            const f32x4* Wp = (const f32x4*)(in[4] + (size_t)layer * D * NMODW) + col4;
            f32x4 a0 = {0.f, 0.f, 0.f, 0.f}, a1 = {0.f, 0.f, 0.f, 0.f};
#pragma unroll 8
            for (int k = F.wave; k < D; k += 8) { const f32x4 w = TR_LD(&Wp[(size_t)k * (NMODW / 4)]); a0 += w * s_c[k]; a1 += w * s_cc[k]; }
            red[(F.wave * 2 + 0) * 64 + F.lane] = a0; red[(F.wave * 2 + 1) * 64 + F.lane] = a1;
            __syncthreads();
            if (F.wave < 2) { f32x4 s = {0.f, 0.f, 0.f, 0.f};
#pragma unroll
                for (int w = 0; w < 8; ++w) s += red[(w * 2 + F.wave) * 64 + F.lane];
                s += ((const f32x4*)(in[5] + (size_t)layer * NMODW))[col4];
                ((f32x4*)(misc + (F.wave ? MO_MODC : MO_MOD) + layer * NMODW))[col4] = s; }
            __syncthreads();
        }
    }
}

constexpr int FCH = 32;
#if MLPW_IN_PROLOGUE
constexpr int NFW = 8;
#else
constexpr int NFW = 4;
#endif
__device__ __forceinline__ void fwave_meet(LAS unsigned* cnt, unsigned& target, int lane) {
    target += (unsigned)NFW;
    asm volatile("s_waitcnt lgkmcnt(0)" ::: "memory");
    if (lane == 0) __hip_atomic_fetch_add(cnt, 1u, __ATOMIC_RELAXED, __HIP_MEMORY_SCOPE_WORKGROUP);
    while (__hip_atomic_load(cnt, __ATOMIC_RELAXED, __HIP_MEMORY_SCOPE_WORKGROUP) < target) __builtin_amdgcn_s_sleep(1);
    asm volatile("" ::: "memory");
}
__device__ __forceinline__ void p0_item_load(const float* W, int N, int item, int lane, float (&r)[32]) {
    const int nblk = N / 32, kb = item / nblk, nb = item % nblk, k0 = 64 * kb, n0 = 32 * nb;
    unsigned off = ((unsigned)(k0 + (lane >> 5)) * (unsigned)N + (unsigned)(n0 + (lane & 31))) * 4u;
#pragma unroll
    for (int i = 0; i < 32; ++i) { r[i] = *(const float*)((const char*)W + off); off += 8u * (unsigned)N; asm volatile("" : "+v"(off)); }
}
__device__ __forceinline__ void p0_item_store(const float (&r)[32], int K, int N, bf16* WT, LAS float* scr, int item, int lane) {
    const int nblk = N / 32, kb = item / nblk, nb = item % nblk, k0 = 64 * kb, n0 = 32 * nb;
#pragma unroll
    for (int i = 0; i < 32; ++i) { const int kk = 2 * i + (lane >> 5); scr[kk * 33 + (lane & 31)] = r[i]; }
    LDS_WAIT();
    const int c = lane & 7;
#pragma unroll
    for (int j = 0; j < 4; ++j) { const int n = (lane >> 3) + 8 * j; const LAS float* s = scr + (8 * c) * 33 + n;
        v4u o; o.x = pk2(s[0 * 33], s[1 * 33]); o.y = pk2(s[2 * 33], s[3 * 33]); o.z = pk2(s[4 * 33], s[5 * 33]); o.w = pk2(s[6 * 33], s[7 * 33]);
        *(v4u*)(WT + (size_t)(n0 + n) * K + k0 + 8 * c) = o; }
    LDS_WAIT();
}
__device__ __forceinline__ void phase_filters(const Ctx& F, InTab in, unsigned char* ws) {
    typedef float f32x16 __attribute__((ext_vector_type(16)));
    constexpr int HL_BYTES = 256 * 144;
    LAS unsigned* fcnt = (LAS unsigned*)(F.lds + HL_BYTES + 4 * 8448);
    if (F.tid == 0) *fcnt = 0u;
    __syncthreads();
    if (F.wave >= NFW) {
        LAS float* scr = (LAS float*)(F.lds + HL_BYTES + (F.wave - 4) * 8448);
        const int cw = F.bid * 4 + (F.wave - 4), NCW = F.G * 4;
#if MLPW_IN_PROLOGUE
        constexpr int ITEMS = 0;
#else
        constexpr int ITEMS = 8 * 8192;
#endif
        float ra[32], rb[32], rc[32];
#define MLPW_SRC(it_) (((it_) >> 13) < 4 ? in[27] + (size_t)((it_) >> 13) * D * FF : in[28] + (size_t)(((it_) >> 13) - 4) * FF * D)
#define MLPW_DST(it_) (((it_) >> 13) < 4 ? (bf16*)(ws + WS_WM1) + (size_t)((it_) >> 13) * FF * D : (bf16*)(ws + WS_WM2) + (size_t)(((it_) >> 13) - 4) * D * FF)
#define MLPW_K(it_) (((it_) >> 13) < 4 ? D : FF)
#define MLPW_N(it_) (((it_) >> 13) < 4 ? FF : D)
#define MLPW_LD(it_, R_) p0_item_load(MLPW_SRC(it_), MLPW_N(it_), (it_) & 8191, F.lane, R_)
#define MLPW_ST(it_, R_) p0_item_store(R_, MLPW_K(it_), MLPW_N(it_), MLPW_DST(it_), scr, (it_) & 8191, F.lane)
        int it = cw;
        if (it < ITEMS) MLPW_LD(it, ra);
        if (it + NCW < ITEMS) MLPW_LD(it + NCW, rb);
        for (; it < ITEMS; it += 3 * NCW) {
            const int i1 = it + NCW, i2 = it + 2 * NCW, i3 = it + 3 * NCW, i4 = it + 4 * NCW;
            if (i2 < ITEMS) MLPW_LD(i2, rc);
            MLPW_ST(it, ra);
            if (i1 < ITEMS) { if (i3 < ITEMS) MLPW_LD(i3, ra); MLPW_ST(i1, rb); }
            if (i2 < ITEMS) { if (i4 < ITEMS) MLPW_LD(i4, rb); MLPW_ST(i2, rc); }
        }
#undef MLPW_LD
#undef MLPW_ST
#undef MLPW_SRC
#undef MLPW_DST
#undef MLPW_K
#undef MLPW_N
        return;
    }
    float* misc = (float*)(ws + WS_MISC); const float* HID = (const float*)(ws + WS_HID);
    {
        bf16* rg = (bf16*)(ws + WS_FILT);
        for (int q = F.bid * (NFW * 64) + F.tid; q < 2 * 4096 * 128; q += F.G * (NFW * 64)) { const int row = q >> 7, e = q & 127; rg[(size_t)row * 8320 + (e < 64 ? e : 8192 + e)] = 0; }
    }
    LAS unsigned char* hl = F.lds;
    const int n32 = F.lane & 31, hi = F.lane >> 5;
    unsigned meet = 0u;
    typedef short bf16x8_ __attribute__((ext_vector_type(8)));
    for (int item = F.bid; item < 2 * 16 * FCH + 128; item += F.G) {
        const bool isctx = item >= 2 * 16 * FCH; int j, g, ch, n, tlo = 0, thi = 8;
        if (!isctx) { j = item / (16 * FCH); g = (item / FCH) & 15; ch = item % FCH; n = S; } else { j = 0; g = (item - 2 * 16 * FCH) >> 3; ch = 0; n = C; tlo = (item - 2 * 16 * FCH) & 7; thi = tlo + 1; }
        const float* hsrc = HID + ((size_t)(isctx ? 2 * S : j * S) + ch * 256) * 64;
        fwave_meet(fcnt, meet, F.lane);
        for (int q = F.tid; q < 256 * 16; q += NFW * 64) { const f32x4 v = ((const f32x4*)hsrc)[q]; v2u w; w.x = pk2(v.x, v.y); w.y = pk2(v.z, v.w); *(LAS v2u*)(hl + (q >> 4) * 144 + (q & 15) * 8) = w; }
        fwave_meet(fcnt, meet, F.lane);
#pragma unroll 1
        for (int pass = 0; pass < 8 / NFW; ++pass) {
            const int od0 = g * 256 + (F.wave + NFW * pass) * 32, od = od0 + n32;
            bf16x8_ bw[4];
#pragma unroll
            for (int ks = 0; ks < 4; ++ks) { float t[8];
#pragma unroll
                for (int e = 0; e < 8; ++e) t[e] = in[23][(size_t)j * 64 * 4096 + (size_t)(16 * ks + 8 * hi + e) * 4096 + od];
                v4u w; w.x = pk2(t[0], t[1]); w.y = pk2(t[2], t[3]); w.z = pk2(t[4], t[5]); w.w = pk2(t[6], t[7]); bw[ks] = *reinterpret_cast<bf16x8_*>(&w); }
            const float dl2 = fabsf(MIN_DECAY + (float)(od & (D - 1)) * ((MAX_DECAY - MIN_DECAY) / (float)(D - 1))) * 1.4426950408889634f;
            float ssq = 0.f;
            bf16* rrow = (bf16*)(ws + WS_FILT) + ((size_t)j * 4096 + od) * 8320; float* crow_ = (float*)(ws + WS_FILTC) + (size_t)od * C;
            for (int t = tlo; t < thi; ++t) {
                f32x16 acc = {};
                const LAS unsigned char* ap_ = hl + (t * 32 + n32) * 144 + 16 * hi;
#pragma unroll
                for (int ks = 0; ks < 4; ++ks) acc = __builtin_amdgcn_mfma_f32_32x32x16_bf16(*(const LAS bf16x8_*)(ap_ + 32 * ks), bw[ks], acc, 0, 0, 0);
#pragma unroll
                for (int q4 = 0; q4 < 4; ++q4) { const int p0 = ch * 256 + t * 32 + 8 * q4 + 4 * hi; float h[4];
#pragma unroll
                    for (int e = 0; e < 4; ++e) { const float offs = fabsf((float)(p0 + e - n / 2)) * (2.0f / (float)n); h[e] = acc[4 * q4 + e] * __builtin_amdgcn_exp2f(-offs * dl2); ssq += h[e] * h[e]; }
                    if (isctx) *(f32x4*)(crow_ + p0) = (f32x4){h[0], h[1], h[2], h[3]};
                    else { v2u w; w.x = pk2(h[3], h[2]); w.y = pk2(h[1], h[0]); *(v2u*)(rrow + 8252 - p0) = w; } }
            }
            ssq += xl_x32(ssq);
            if (hi == 0) { if (isctx) misc[MO_FPARTC + od * 8 + tlo] = ssq; else misc[MO_FPART + (j * 4096 + od) * FCH + ch] = ssq; }
        }
    }
}

__device__ __forceinline__ void unpack8(const v4u w, float (&v)[8]) {
#pragma unroll
    for (int e = 0; e < 4; ++e) { v[2 * e] = bf2f(w[e] & 0xffffu); v[2 * e + 1] = bf2f(w[e] >> 16); }
}
__device__ __forceinline__ void ld8f(const float* p, float (&v)[8]) { const f32x4 a = *(const f32x4*)p, b = *(const f32x4*)(p + 4); v[0] = a.x; v[1] = a.y; v[2] = a.z; v[3] = a.w; v[4] = b.x; v[5] = b.y; v[6] = b.z; v[7] = b.w; }
__device__ __forceinline__ void nm_load(const Ctx& F, bf16* X, int r, float (&v)[4][8], const float* P, int fn, const float* fgate, const float* fbias) {
    v4u* xr = (v4u*)(X + (size_t)r * D) + F.lane;
#pragma unroll
    for (int j = 0; j < 4; ++j) unpack8(xr[64 * j], v[j]);
    if (r >= S && fn > 0) {
#pragma unroll
        for (int j = 0; j < 4; ++j) { float a[8], t[8];
            if (fbias) ld8f(fbias + 512 * j + 8 * F.lane, a); else {
#pragma unroll
                for (int e = 0; e < 8; ++e) a[e] = 0.f; }
            for (int s = 0; s < fn; s += 4) { float t4[4][8];
#pragma unroll
                for (int u = 0; u < 4; ++u) ld8f(P + ((size_t)(s + u) * 256 + (r - S)) * D + 512 * j + 8 * F.lane, t4[u]);
#pragma unroll
                for (int u = 0; u < 4; ++u)
#pragma unroll
                    for (int e = 0; e < 8; ++e) a[e] += t4[u][e]; }
            ld8f(fgate + 512 * j + 8 * F.lane, t);
#pragma unroll
            for (int e = 0; e < 8; ++e) v[j][e] += t[e] * a[e];
            v4u w; w.x = pk2(v[j][0], v[j][1]); w.y = pk2(v[j][2], v[j][3]); w.z = pk2(v[j][4], v[j][5]); w.w = pk2(v[j][6], v[j][7]); xr[64 * j] = w;
            unpack8(w, v[j]); }
    }
}
__device__ __forceinline__ void nm_store(const Ctx& F, bf16* H, int r, const float (&v)[4][8], float rstd, const float (&wv)[4][8], const float (&sv)[4][8]) {
    v4u* o = (v4u*)(H + (size_t)r * D) + F.lane;
#pragma unroll
    for (int j = 0; j < 4; ++j) { float z[8];
#pragma unroll
        for (int e = 0; e < 8; ++e) z[e] = (v[j][e] * rstd) * wv[j][e] + sv[j][e];
        v4u w; w.x = pk2(z[0], z[1]); w.y = pk2(z[2], z[3]); w.z = pk2(z[4], z[5]); w.w = pk2(z[6], z[7]); o[64 * j] = w; }
}
__device__ __forceinline__ void nm_vecs(const Ctx& F, const float* g, const float* sh, const float* sc, float (&wv)[4][8], float (&sv)[4][8]) {
#pragma unroll
    for (int j = 0; j < 4; ++j) { float gg[8], s1[8]; ld8f(g + 512 * j + 8 * F.lane, gg); ld8f(sc + 512 * j + 8 * F.lane, s1); ld8f(sh + 512 * j + 8 * F.lane, sv[j]);
#pragma unroll
        for (int e = 0; e < 8; ++e) wv[j][e] = gg[e] * (1.0f + s1[e]); }
}
__device__ __forceinline__ float nm_ss(const float (&v)[4][8]) { float ss = 0.f;
#pragma unroll
    for (int j = 0; j < 4; ++j)
#pragma unroll
        for (int e = 0; e < 8; ++e) ss += v[j][e] * v[j][e];
    return ss; }
#ifndef NORM_XCD
#define NORM_XCD 1
#endif
__device__ __forceinline__ int norm_row(const Ctx& F, int q) {
#if NORM_XCD
    if (F.G == 256 && q < S) { const int k = q >> 11, b = (q >> 3) & 255, w = q & 7; return 1024 * (b & 7) + 256 * k + 8 * (b >> 3) + w; }
#endif
    return q;
}
__device__ __forceinline__ void phase_norm_mod(const Ctx& F, bf16* X, bf16* H, int nrows, const float* g, const float* shL, const float* scL, const float* shC, const float* scC,
                                               const float* P, int fn, const float* fgate, const float* fbias) {
    float wv[4][8], sv[4][8];
    nm_vecs(F, g, shL, scL, wv, sv);
    static_assert(KS_OUT % 4 == 0 && KS_DOWN % 4 == 0, "nm_load folds the split-K slices four at a time");
    for (int q = F.gw; q < S && q < nrows; q += F.NGW) {
        const int r = norm_row(F, q);
        float va[4][8];
        nm_load(F, X, r, va, P, 0, fgate, fbias);
        const float rsa = 1.0f / sqrtf(wave_sum(nm_ss(va)) * (1.0f / D) + EPS);
        nm_store(F, H, r, va, rsa, wv, sv);
    }
    LAS float* red = (LAS float*)F.lds;
    for (int c = F.bid; c < nrows - S; c += F.G) {
        const int r = S + c, col = 256 * F.wave + 4 * F.lane;
        const v2u xraw = *(const v2u*)(X + (size_t)r * D + col);
        float x[4] = {bf2f(xraw.x & 0xffffu), bf2f(xraw.x >> 16), bf2f(xraw.y & 0xffffu), bf2f(xraw.y >> 16)};
        if (fn > 0) {
            f32x4 a = fbias ? *(const f32x4*)(fbias + col) : (f32x4){0.f, 0.f, 0.f, 0.f};
            const float* Pc = P + (size_t)c * D + col;
            int sl = 0;
            for (; sl + 8 <= fn; sl += 8) { f32x4 t[8];
#pragma unroll
                for (int u = 0; u < 8; ++u) t[u] = *(const f32x4*)(Pc + (size_t)(sl + u) * 256 * D);
#pragma unroll
                for (int u = 0; u < 8; ++u) a += t[u]; }
            for (; sl < fn; sl += 4) { f32x4 t[4];
#pragma unroll
                for (int u = 0; u < 4; ++u) t[u] = *(const f32x4*)(Pc + (size_t)(sl + u) * 256 * D);
#pragma unroll
                for (int u = 0; u < 4; ++u) a += t[u]; }
            const f32x4 gt = *(const f32x4*)(fgate + col);
            x[0] += gt.x * a.x; x[1] += gt.y * a.y; x[2] += gt.z * a.z; x[3] += gt.w * a.w;
            v2u w; w.x = pk2(x[0], x[1]); w.y = pk2(x[2], x[3]); *(v2u*)(X + (size_t)r * D + col) = w;
            x[0] = bf2f(w.x & 0xffffu); x[1] = bf2f(w.x >> 16); x[2] = bf2f(w.y & 0xffffu); x[3] = bf2f(w.y >> 16);
        }
        const float ssw = wave_sum(x[0] * x[0] + x[1] * x[1] + x[2] * x[2] + x[3] * x[3]);
        if (F.lane == 0) red[F.wave] = ssw;
        __syncthreads();
        float tot = 0.f;
#pragma unroll
        for (int w = 0; w < 8; ++w) tot += red[w];
        __syncthreads();
        const float rsa = 1.0f / sqrtf(tot * (1.0f / D) + EPS);
        const f32x4 gg = *(const f32x4*)(g + col), s1 = *(const f32x4*)(scC + col), s0 = *(const f32x4*)(shC + col);
        v2u o; o.x = pk2((x[0] * rsa * gg.x) * (1.0f + s1.x) + s0.x, (x[1] * rsa * gg.y) * (1.0f + s1.y) + s0.y);
        o.y = pk2((x[2] * rsa * gg.z) * (1.0f + s1.z) + s0.z, (x[3] * rsa * gg.w) * (1.0f + s1.w) + s0.w);
        *(v2u*)(H + (size_t)r * D + col) = o;
    }
}
#ifndef OUT_NT
#define OUT_NT 1
#endif
#if OUT_NT
#define OUT_ST(p_, v_) __builtin_nontemporal_store(v_, p_)
#else
#define OUT_ST(p_, v_) (*(p_) = (v_))
#endif
__device__ __forceinline__ void phase_final_norm(const Ctx& F, const bf16* X, float* out, const float* g) {
    for (int q = F.gw; q < S; q += F.NGW) {
        const int r = norm_row(F, q);
        const v4u* xr = (const v4u*)(X + (size_t)r * D) + F.lane;
        float v[4][8]; float ss = 0.f;
#pragma unroll
        for (int j = 0; j < 4; ++j) unpack8(NTL(&xr[64 * j]), v[j]);
#pragma unroll
        for (int j = 0; j < 4; ++j)
#pragma unroll
            for (int e = 0; e < 8; ++e) ss += v[j][e] * v[j][e];
        const float rstd = 1.0f / sqrtf(wave_sum(ss) * (1.0f / D) + EPS);
        float* o = out + (size_t)r * D + 8 * F.lane;
#pragma unroll
        for (int j = 0; j < 4; ++j) { float gg[8]; ld8f(g + 512 * j + 8 * F.lane, gg);
            OUT_ST((f32x4*)(o + 512 * j), ((f32x4){v[j][0] * rstd * gg[0], v[j][1] * rstd * gg[1], v[j][2] * rstd * gg[2], v[j][3] * rstd * gg[3]}));
            OUT_ST((f32x4*)(o + 512 * j + 4), ((f32x4){v[j][4] * rstd * gg[4], v[j][5] * rstd * gg[5], v[j][6] * rstd * gg[6], v[j][7] * rstd * gg[7]})); }
    }
}

__device__ __forceinline__ void phase_kprep(const Ctx& F, const bf16* QKV, bf16* KP, bf16* VP, const float* knorm, const float* rcos, const float* rsin) {
    const int h = F.lane >> 4, c = F.lane & 15;
    const int half64 = c >> 3, first = ((c >> 2) & 1) == 0;
    const int pfreq = (c & 3) * 8;
    for (int r = F.gw; r < R; r += F.NGW) {
        const bool lat = r < S; const int kr = lat ? C + r : r - S;
        const v4u raw = NTL((const v4u*)(QKV + (size_t)r * AW + 2048 + h * HD + 8 * c));
        float x[8]; unpack8(raw, x);
        if (h >= 2) { float ss = 0.f;
#pragma unroll
            for (int e = 0; e < 8; ++e) ss += x[e] * x[e];
            ss += xl_dpp_b1(ss); ss += xl_dpp_4e(ss); ss += xl_swz4(ss); ss += xl_swz8(ss);
            const float rstd = 1.0f / sqrtf(ss * (1.0f / HD) + EPS);
            float gn[8]; ld8f(knorm + 8 * c, gn);
#pragma unroll
            for (int e = 0; e < 8; ++e) x[e] *= rstd * gn[e]; }
        if (lat) {
            const int pos = half64 == 0 ? (r >> 6) : (r & 63);
            float cs[8], sn[8]; ld8f(rcos + pos * 32 + pfreq, cs); ld8f(rsin + pos * 32 + pfreq, sn);
#pragma unroll
            for (int e = 0; e < 8; ++e) { const float other = xl_swz4(x[e]);
                x[e] = first ? x[e] * cs[e] - other * sn[e] : x[e] * cs[e] + other * sn[e]; }
        }
        v4u w; w.x = pk2(x[0], x[1]); w.y = pk2(x[2], x[3]); w.z = pk2(x[4], x[5]); w.w = pk2(x[6], x[7]);
        *(v4u*)(KP + (size_t)kr * 512 + h * HD + 8 * c) = w;
        *(v4u*)(VP + (size_t)kr * 512 + h * HD + 8 * c) = NTL((const v4u*)(QKV + (size_t)r * AW + 2560 + h * HD + 8 * c));
    }
}

__device__ __forceinline__ void phase_shortconv(const Ctx& F, const bf16* UP, bf16* XV, const float* cw, const float* cb, int nrows) {
    const int ntb = nrows / 64, tg = F.lane >> 3, cg = F.lane & 7;
    const int nslots = F.NGW / 96;
    if (F.gw >= 96 * nslots) return;
    const int cbk = F.gw % 96, slot = F.gw / 96, c0 = cbk * 64 + 8 * cg;
    const f32x4 w0a = *(const f32x4*)(cw + c0), w0b = *(const f32x4*)(cw + c0 + 4), w1a = *(const f32x4*)(cw + HW + c0), w1b = *(const f32x4*)(cw + HW + c0 + 4);
    const f32x4 w2a = *(const f32x4*)(cw + 2 * HW + c0), w2b = *(const f32x4*)(cw + 2 * HW + c0 + 4), ba = *(const f32x4*)(cb + c0), bb = *(const f32x4*)(cb + c0 + 4);
    const float w0[8] = {w0a.x, w0a.y, w0a.z, w0a.w, w0b.x, w0b.y, w0b.z, w0b.w}, w1[8] = {w1a.x, w1a.y, w1a.z, w1a.w, w1b.x, w1b.y, w1b.z, w1b.w};
    const float w2[8] = {w2a.x, w2a.y, w2a.z, w2a.w, w2b.x, w2b.y, w2b.z, w2b.w}, bs[8] = {ba.x, ba.y, ba.z, ba.w, bb.x, bb.y, bb.z, bb.w};
    for (int tb = slot; tb < ntb; tb += nslots) {
        const int r0 = tb * 64 + 8 * tg;
        const int slo = tb < 128 ? 0 : S, shi = tb < 128 ? S : R;
        v4u raw[10];
#pragma unroll
        for (int k = 0; k < 10; ++k) { const int r = r0 - 1 + k; raw[k] = (r >= slo && r < shi) ? NTL((const v4u*)(UP + (size_t)r * HW + c0)) : (v4u){0u, 0u, 0u, 0u}; }
#pragma unroll
        for (int cc = 0; cc < 8; ++cc) {
            float x[10];
#pragma unroll
            for (int k = 0; k < 10; ++k) { const unsigned d = raw[k][cc >> 1]; x[k] = (cc & 1) ? bf2f(d >> 16) : bf2f(d & 0xffffu); }
            float u[8];
#pragma unroll
            for (int j = 0; j < 8; ++j) u[j] = w0[cc] * x[j] + w1[cc] * x[j + 1] + w2[cc] * x[j + 2] + bs[cc];
            v4u o; o.x = pk2(u[0], u[1]); o.y = pk2(u[2], u[3]); o.z = pk2(u[4], u[5]); o.w = pk2(u[6], u[7]);
            *(v4u*)(XV + (size_t)(c0 + cc) * R + r0) = o;
        }
    }
}

__device__ __forceinline__ void phase_transpose_zc(const Ctx& F, const bf16* ZC, bf16* O, int nrows) {
    LAS unsigned char* scr = F.lds + F.wave * 9216;
    const int ntb = nrows / 64;
    for (int it = F.gw; it < ntb * 32; it += F.NGW) {
        const int cbk = it / ntb, tb = it % ntb, r0 = tb * 64, c0 = cbk * 64;
        v4u raw[8];
#pragma unroll
        for (int k = 0; k < 8; ++k) raw[k] = NTL((const v4u*)(ZC + (size_t)(c0 + F.lane) * R + r0 + 8 * k));
#pragma unroll
        for (int k = 0; k < 8; ++k)
#pragma unroll
            for (int e = 0; e < 4; ++e) { const unsigned d = raw[k][e]; const int t = 8 * k + 2 * e;
                *(LAS bf16*)(scr + t * 144 + 2 * F.lane) = (bf16)(d & 0xffffu); *(LAS bf16*)(scr + (t + 1) * 144 + 2 * F.lane) = (bf16)(d >> 16); }
        LDS_WAIT();
#pragma unroll
        for (int k = 0; k < 8; ++k) { const int t = 8 * k + (F.lane >> 3), ch = (F.lane & 7) * 8;
            *(v4u*)(O + (size_t)(r0 + t) * D + c0 + ch) = *(const LAS v4u*)(scr + t * 144 + 2 * ch); }
        LDS_WAIT();
    }
}
namespace att {
using bf16x8 = __attribute__((ext_vector_type(8))) short;
using s16x4  = __attribute__((ext_vector_type(4))) short;
using f32x16 = __attribute__((ext_vector_type(16))) float;
using u32x4  = __attribute__((ext_vector_type(4))) unsigned;
constexpr int KVBLK = 64, LDQ = AW, LDK = 512, LDO = D;
constexpr float SCALE = 0.088388347648318440f;
constexpr float THR = 8.f;
constexpr int SDEPTH = 1;
constexpr int SHM_V = KVBLK * 128 * 2, SHM_K = KVBLK * 128 * 2, SHM_ATTN = 2 * SHM_V + 2 * SHM_K + 8 * 64 * 4;
#define KSWZ(row, colB) ((row) * 256 + ((colB) ^ (((row) & 7) << 4)))
#define SBAR() __builtin_amdgcn_sched_barrier(0)
__device__ __forceinline__ int crow(int r, int hi) { return (r & 3) + 8 * (r >> 2) + 4 * hi; }
__device__ __forceinline__ unsigned cvtpk(float lo, float hi) { unsigned r; asm volatile("v_cvt_pk_bf16_f32 %0, %1, %2" : "=v"(r) : "v"(lo), "v"(hi)); return r; }

__device__ __forceinline__ void partialSM(f32x16& p0, f32x16& p1, float& m_reg, float& mn, float& alpha) {
  constexpr float Cc = SCALE * 1.4426950408889634f;
  float pmax = p0[0]; for (int r = 1; r < 16; ++r) pmax = fmaxf(pmax, p0[r]); for (int r = 0; r < 16; ++r) pmax = fmaxf(pmax, p1[r]);
  { auto rr = __builtin_amdgcn_permlane32_swap(__float_as_uint(pmax), __float_as_uint(pmax), false, false);
    pmax = fmaxf(__uint_as_float(rr[0]), __uint_as_float(rr[1])); }
  if (__builtin_expect(__all(pmax - m_reg <= THR / SCALE), 1)) { mn = m_reg; alpha = 1.f; }
  else { mn = fmaxf(m_reg, pmax); alpha = __builtin_amdgcn_exp2f((m_reg - mn) * Cc); m_reg = mn; }
  float mnC = -mn * Cc;
  for (int r = 0; r < 16; ++r) p0[r] = fmaf(p0[r], Cc, mnC); for (int r = 0; r < 16; ++r) p1[r] = fmaf(p1[r], Cc, mnC);
  for (int r = 0; r < 16; ++r) p0[r] = __builtin_amdgcn_exp2f(p0[r]);
}
__device__ __forceinline__ void finishSM(f32x16& p0, f32x16& p1, float alpha, float& l_reg, bf16x8& pa0, bf16x8& pa1, bf16x8& pa2, bf16x8& pa3) {
  for (int r = 0; r < 16; ++r) p1[r] = __builtin_amdgcn_exp2f(p1[r]);
  float ps = 0; for (int r = 0; r < 16; ++r) ps += p0[r]; for (int r = 0; r < 16; ++r) ps += p1[r];
  { auto rr = __builtin_amdgcn_permlane32_swap(__float_as_uint(ps), __float_as_uint(ps), false, false);
    ps = __uint_as_float(rr[0]) + __uint_as_float(rr[1]); }
  l_reg = l_reg * alpha + ps;
#define PK4(P, BASE, OUT) do { unsigned a0 = cvtpk(P[BASE + 0], P[BASE + 1]), a1 = cvtpk(P[BASE + 2], P[BASE + 3]);   \
    unsigned b0 = cvtpk(P[BASE + 4], P[BASE + 5]), b1 = cvtpk(P[BASE + 6], P[BASE + 7]);                              \
    auto r0 = __builtin_amdgcn_permlane32_swap(a0, b0, false, false); auto r1 = __builtin_amdgcn_permlane32_swap(a1, b1, false, false); \
    u32x4 w = {r0[0], r1[0], r0[1], r1[1]}; OUT = *reinterpret_cast<bf16x8*>(&w); } while (0)
  PK4(p0, 0, pa0); PK4(p0, 8, pa1); PK4(p1, 0, pa2); PK4(p1, 8, pa3);
#undef PK4
}
__device__ __forceinline__ void qkt(f32x16& p0, f32x16& p1, const char* Ks, const bf16x8* qr, int r32, int hi) {
  p0 = f32x16{}; p1 = f32x16{};
  for (int d0 = 0; d0 < 8; ++d0) { int cb = (d0 * 16 + hi * 8) * 2;
    bf16x8 b0 = *reinterpret_cast<const bf16x8*>(Ks + KSWZ(r32, cb));
    bf16x8 b1 = *reinterpret_cast<const bf16x8*>(Ks + KSWZ(32 + r32, cb));
    p0 = __builtin_amdgcn_mfma_f32_32x32x16_bf16(b0, qr[d0], p0, 0, 0, 0);
    p1 = __builtin_amdgcn_mfma_f32_32x32x16_bf16(b1, qr[d0], p1, 0, 0, 0); }
}
__device__ __forceinline__ int v_st(int k, int c) { const int kk = (k & ~0xC) | ((k & 4) << 1) | ((k & 8) >> 1); return ((kk >> 3) * 4 + (c >> 5)) * 512 + ((kk & 7) * 32 + (c & 31)) * 2; }
__device__ __forceinline__ int v_rd_base(int lane) { return ((lane & 3) << 3) | (((lane >> 2) & 3) << 6) | (((lane >> 4) & 1) << 5) | (((lane >> 5) & 1) << 8); }
constexpr int v_rd_off(int d0, int ks, int half) { return d0 * 512 + ks * 4096 + half * 2048; }
template <int OFF> __device__ __forceinline__ s16x4 tr_read(int vb) {
  s16x4 r; asm volatile("ds_read_b64_tr_b16 %0, %1 offset:%2" : "=&v"(r) : "v"(vb), "i"(OFF) : "memory"); return r;
}
template <int D0> __device__ __forceinline__ void pv_one(f32x16& od, int vb, bf16x8 pa0, bf16x8 pa1, bf16x8 pa2, bf16x8 pa3) {
  const s16x4 l0 = tr_read<v_rd_off(D0, 0, 0)>(vb), h0 = tr_read<v_rd_off(D0, 0, 1)>(vb), l1 = tr_read<v_rd_off(D0, 1, 0)>(vb), h1 = tr_read<v_rd_off(D0, 1, 1)>(vb);
  const s16x4 l2 = tr_read<v_rd_off(D0, 2, 0)>(vb), h2 = tr_read<v_rd_off(D0, 2, 1)>(vb), l3 = tr_read<v_rd_off(D0, 3, 0)>(vb), h3 = tr_read<v_rd_off(D0, 3, 1)>(vb);
  asm volatile("s_waitcnt lgkmcnt(0)" ::: "memory"); SBAR();
#define PK(L, H) (bf16x8){L[0], L[1], L[2], L[3], H[0], H[1], H[2], H[3]}
  od = __builtin_amdgcn_mfma_f32_32x32x16_bf16(pa0, PK(l0, h0), od, 0, 0, 0);
  od = __builtin_amdgcn_mfma_f32_32x32x16_bf16(pa1, PK(l1, h1), od, 0, 0, 0);
  od = __builtin_amdgcn_mfma_f32_32x32x16_bf16(pa2, PK(l2, h2), od, 0, 0, 0);
  od = __builtin_amdgcn_mfma_f32_32x32x16_bf16(pa3, PK(l3, h3), od, 0, 0, 0);
#undef PK
}
__device__ __forceinline__ void pv_d0(f32x16* o, int vb, bf16x8 pa0, bf16x8 pa1, bf16x8 pa2, bf16x8 pa3) {
  pv_one<0>(o[0], vb, pa0, pa1, pa2, pa3); pv_one<1>(o[1], vb, pa0, pa1, pa2, pa3); pv_one<2>(o[2], vb, pa0, pa1, pa2, pa3); pv_one<3>(o[3], vb, pa0, pa1, pa2, pa3);
}

struct Unit {
    const bf16* Qb;
    const bf16* Kh;
    const bf16* Vh;
    bf16* Ob;
    int NT;
    int lat0;
    int i0;
    int windowed;
    int norm_q;
    float sink; int has_sink;
};

__device__ __forceinline__ void window_mask(f32x16& p0, f32x16& p1, int base, int hi) {
#pragma unroll
  for (int r = 0; r < 16; ++r) { const int d0 = base + crow(r, hi), d1 = d0 + 32;
    p0[r] = (d0 >= -128 && d0 <= 128) ? p0[r] : -__builtin_inff();
    p1[r] = (d1 >= -128 && d1 <= 128) ? p1[r] : -__builtin_inff(); }
}

__device__ __forceinline__ void attn_unit(const Unit u, const float* __restrict__ qn, const float* __restrict__ rcos, const float* __restrict__ rsin, char* lds, const int tid) {
  const int wid = tid >> 6, lane = tid & 63, r32 = lane & 31, hi = lane >> 5;
  char* V_lds = lds; char* K_lds = lds + 2 * SHM_V;
  float* wsx = (float*)(lds + 2 * SHM_V + 2 * SHM_K) + wid * 64; float* li_l = wsx; float* al_l = wsx + 32;
  float m_reg = u.has_sink ? u.sink * (1.0f / SCALE) : -1e30f, l_reg = u.has_sink ? 1.f : 0.f; f32x16 o[4] = {}; bf16x8 qr[8];
  const int qpos = u.i0 + wid * 32 + r32;
  {
    const bf16* Qw = u.Qb + (long)(wid * 32 + r32) * LDQ + hi * 8;
    float qf[8][8];
#pragma unroll
    for (int d0 = 0; d0 < 8; ++d0) { const u32x4 raw = *reinterpret_cast<const u32x4*>(Qw + d0 * 16);
#pragma unroll
      for (int e = 0; e < 4; ++e) { qf[d0][2 * e] = bf2f(raw[e] & 0xffffu); qf[d0][2 * e + 1] = bf2f(raw[e] >> 16); } }
    if (u.norm_q) { float ss = 0.f;
#pragma unroll
      for (int d0 = 0; d0 < 8; ++d0)
#pragma unroll
        for (int e = 0; e < 8; ++e) ss += qf[d0][e] * qf[d0][e];
      ss += xl_x32(ss);
      const float rstd = 1.0f / sqrtf(ss * (1.0f / 128.0f) + EPS);
#pragma unroll
      for (int d0 = 0; d0 < 8; ++d0) { const f32x4 g0 = *(const f32x4*)(qn + d0 * 16 + hi * 8), g1 = *(const f32x4*)(qn + d0 * 16 + hi * 8 + 4);
        qf[d0][0] *= rstd * g0.x; qf[d0][1] *= rstd * g0.y; qf[d0][2] *= rstd * g0.z; qf[d0][3] *= rstd * g0.w;
        qf[d0][4] *= rstd * g1.x; qf[d0][5] *= rstd * g1.y; qf[d0][6] *= rstd * g1.z; qf[d0][7] *= rstd * g1.w; } }
    if (u.i0 >= 0) {
#pragma unroll
      for (int hf = 0; hf < 2; ++hf) { const int pos = hf == 0 ? (qpos >> 6) : (qpos & 63);
#pragma unroll
        for (int dd = 0; dd < 2; ++dd) { const int pb = pos * 32 + dd * 16 + hi * 8;
          const f32x4 c0 = *(const f32x4*)(rcos + pb), c1 = *(const f32x4*)(rcos + pb + 4), s0 = *(const f32x4*)(rsin + pb), s1 = *(const f32x4*)(rsin + pb + 4);
          const float cs[8] = {c0.x, c0.y, c0.z, c0.w, c1.x, c1.y, c1.z, c1.w}, sn[8] = {s0.x, s0.y, s0.z, s0.w, s1.x, s1.y, s1.z, s1.w};
#pragma unroll
          for (int e = 0; e < 8; ++e) { const float a = qf[4 * hf + dd][e], b = qf[4 * hf + dd + 2][e];
            qf[4 * hf + dd][e] = a * cs[e] - b * sn[e]; qf[4 * hf + dd + 2][e] = b * cs[e] + a * sn[e]; } } } }
#pragma unroll
    for (int d0 = 0; d0 < 8; ++d0) { u32x4 w = {cvtpk(qf[d0][0], qf[d0][1]), cvtpk(qf[d0][2], qf[d0][3]), cvtpk(qf[d0][4], qf[d0][5]), cvtpk(qf[d0][6], qf[d0][7])}; qr[d0] = *reinterpret_cast<bf16x8*>(&w); }
  }
  const int sr = tid >> 4, sc = (tid & 15) * 8, vst0 = v_st(sr, sc), vst1 = v_st(32 + sr, sc);
  const int vb0 = (int)(uintptr_t)V_lds + v_rd_base(lane);
  const bf16* Kh = u.Kh; const bf16* Vh = u.Vh; const int lat0 = u.lat0;
  struct { bf16x8 vs0, vs1, ks0, ks1; } sr_[SDEPTH];
#define KOFF(t) (64 * (t) + ((t) >= 4 ? lat0 : 0))
#define SLOAD(i, k0) do { const long _k = (k0); sr_[i].vs0 = *reinterpret_cast<const bf16x8*>(&Vh[(_k + sr) * LDK + sc]); sr_[i].vs1 = *reinterpret_cast<const bf16x8*>(&Vh[(_k + 32 + sr) * LDK + sc]); \
    sr_[i].ks0 = *reinterpret_cast<const bf16x8*>(&Kh[(_k + sr) * LDK + sc]); sr_[i].ks1 = *reinterpret_cast<const bf16x8*>(&Kh[(_k + 32 + sr) * LDK + sc]); } while (0)
#define SWRITE(b, i) do { *(bf16x8*)(V_lds + (b) * SHM_V + vst0) = sr_[i].vs0;          \
    *(bf16x8*)(V_lds + (b) * SHM_V + vst1) = sr_[i].vs1; int kc = sc * 2;               \
    *(bf16x8*)(K_lds + (b) * SHM_K + KSWZ(sr, kc)) = sr_[i].ks0;                       \
    *(bf16x8*)(K_lds + (b) * SHM_K + KSWZ(32 + sr, kc)) = sr_[i].ks1; } while (0)
#define SWAIT() do { if constexpr (SDEPTH == 2) asm volatile("s_waitcnt vmcnt(4)" ::: "memory"); else asm volatile("s_waitcnt vmcnt(0)" ::: "memory"); } while (0)
#define RESC(a) do { if (__any((a) < 1.f)) { if (hi == 0) al_l[r32] = (a); asm volatile("s_waitcnt lgkmcnt(0)" ::: "memory"); \
    for (int d = 0; d < 4; ++d) for (int r = 0; r < 16; ++r) o[d][r] *= al_l[crow(r, hi)]; } } while (0)
#define WMASK(P0, P1, t) do { if (u.windowed && (t) >= 4) { const int _b = KOFF(t) - C - qpos; if (__any(_b < -128 || _b + 63 > 128)) window_mask(P0, P1, _b, hi); } } while (0)
  f32x16 pA0, pA1, pB0, pB1; float mnA, mnB, alA, alB; bf16x8 pa0, pa1, pa2, pa3; const int NT = u.NT;
  constexpr int SE = 0, SO = SDEPTH - 1;
  SLOAD(SE, KOFF(0)); asm volatile("s_waitcnt vmcnt(0)" ::: "memory"); SWRITE(0, SE); __syncthreads();
  qkt(pA0, pA1, K_lds, qr, r32, hi); WMASK(pA0, pA1, 0); partialSM(pA0, pA1, m_reg, mnA, alA);
  SLOAD(SO, KOFF(1)); if constexpr (SDEPTH == 2) { if (2 < NT) SLOAD(SE, KOFF(2)); }
  SWAIT(); SWRITE(1, SO); __syncthreads();
  for (int j = 1; j + 1 < NT; j += 2) {
    SBAR(); qkt(pB0, pB1, K_lds + SHM_K, qr, r32, hi);
    finishSM(pA0, pA1, alA, l_reg, pa0, pa1, pa2, pa3); SBAR();
    SLOAD(SO, KOFF(j + SDEPTH)); SBAR();
    pv_d0(o, vb0, pa0, pa1, pa2, pa3); WMASK(pB0, pB1, j); partialSM(pB0, pB1, m_reg, mnB, alB);
    __syncthreads(); SWAIT(); SWRITE(0, SE);
    RESC(alB); __syncthreads();
    SBAR(); qkt(pA0, pA1, K_lds, qr, r32, hi);
    finishSM(pB0, pB1, alB, l_reg, pa0, pa1, pa2, pa3); SBAR();
    if (SDEPTH == 1 || j + 3 < NT) SLOAD(SE, KOFF(j + 1 + SDEPTH)); SBAR();
    pv_d0(o, vb0 + (int)SHM_V, pa0, pa1, pa2, pa3); WMASK(pA0, pA1, j + 1); partialSM(pA0, pA1, m_reg, mnA, alA);
    __syncthreads(); SWAIT(); SWRITE(1, SO);
    RESC(alA); __syncthreads();
  }
  SBAR(); qkt(pB0, pB1, K_lds + SHM_K, qr, r32, hi);
  finishSM(pA0, pA1, alA, l_reg, pa0, pa1, pa2, pa3); SBAR();
  pv_d0(o, vb0, pa0, pa1, pa2, pa3); WMASK(pB0, pB1, NT - 1); partialSM(pB0, pB1, m_reg, mnB, alB);
  __syncthreads(); RESC(alB);
  finishSM(pB0, pB1, alB, l_reg, pa0, pa1, pa2, pa3); SBAR();
  pv_d0(o, vb0 + (int)SHM_V, pa0, pa1, pa2, pa3);
  if (hi == 0) li_l[r32] = l_reg; asm volatile("s_waitcnt lgkmcnt(0)" ::: "memory");
  float rli[16];
#pragma unroll
  for (int r = 0; r < 16; ++r) rli[r] = __builtin_amdgcn_rcpf(li_l[crow(r, hi)]);
  bf16* Ow = u.Ob + (long)(wid * 32) * LDO;
#pragma unroll
  for (int r = 0; r < 16; ++r) { const int orow = crow(r, hi);
#pragma unroll
    for (int d0 = 0; d0 < 4; ++d0) Ow[(long)orow * LDO + d0 * 32 + r32] = (bf16)f2bf(o[d0][r] * rli[r]); }
  __syncthreads();
#undef KOFF
#undef SLOAD
#undef SWRITE
#undef SWAIT
#undef RESC
#undef WMASK
}
#undef KSWZ
#undef SBAR
}

__device__ __forceinline__ void phase_attn(const Ctx& F, const bf16* QKV, const bf16* KP, const bf16* VP, bf16* O, bool ctx_out, const float* sink, const float* qnorm, const float* rcos, const float* rsin) {
    const int nunits = 256 + 256 + (ctx_out ? 16 : 0);
    for (int un = F.bid; un < nunits; un += F.G) {
        att::Unit u;
        int h, qb, isctx = 0;
#ifndef ATT_WROW
#define ATT_WROW 1
#endif
        if (un < 256 || (un < 512 && !ATT_WROW)) { const int w = un & 255, x = w & 7, idx = w >> 3; h = (un < 256 ? 8 : 0) + 4 * (x >> 2) + (idx >> 3); qb = 8 * (x & 3) + (idx & 7); }
        else if (un < 512) { const int w = un & 255, x = w & 7, idx = w >> 3; h = idx >> 2; qb = 4 * x + (idx & 3); }
        else { h = un - 512; qb = 32; isctx = 1; }
        const int kvh = h < 8 ? (h >> 2) : 2 + ((h - 8) >> 2);
        const int row0 = qb * 256;
        u.Qb = QKV + (size_t)row0 * AW + h * HD; u.Kh = KP + kvh * HD; u.Vh = VP + kvh * HD; u.Ob = O + (size_t)row0 * D + h * HD;
        u.i0 = isctx ? -1 : row0; u.norm_q = h >= 8; u.has_sink = h < 8; u.sink = h < 8 ? sink[h] : 0.f;
        if (isctx) { u.NT = 4; u.lat0 = 0; u.windowed = 0; }
        else if (h >= 8) { u.NT = R / 64; u.lat0 = 0; u.windowed = 0; }
        else { const int l0 = row0 - 128 < 0 ? 0 : row0 - 128, l1 = row0 + 384 > S ? S : row0 + 384; u.lat0 = l0; u.NT = 4 + (l1 - l0) / 64; u.windowed = 1; }
#if ATT16
        att16::attn_unit(u, qnorm, rcos, rsin, (char*)F.lds, F.tid);
#else
        att::attn_unit(u, qnorm, rcos, rsin, (char*)F.lds, F.tid);
#endif
    }
}
namespace hconv {
using bf16x8 = __attribute__((ext_vector_type(8))) short;
using f32x4v = __attribute__((ext_vector_type(4))) float;
using u32x4  = __attribute__((ext_vector_type(4))) unsigned;
constexpr int RLEN = 8320, ROFF = 4159;
constexpr int ZBYTES = 8 * 2048, RBYTES = RLEN * 2, ZERO_OFF = 4 * (ZBYTES + RBYTES);
static_assert(ZERO_OFF + 8192 + 16 <= LDS_BYTES - 256, "conv LDS map");

template <int TM>
__device__ __forceinline__ void conv_seg(const LAS unsigned char* zl, const LAS unsigned char* rl, const LAS unsigned char* zero, int nh, int q, int kg, int dl0, int dl1, f32x4v (&acc)[2][2][4]) {
    const LAS unsigned char* ap = rl + 2 * (8 * kg - 2 * q - 1 + ROFF) - 128 * dl0;
    const LAS unsigned char* zp = zl + kg * 2048 + 16 * (64 * nh - dl0 + q);
    int sb = 64 * nh - dl0 + q;
    asm volatile("" : "+v"(ap), "+v"(zp));
    unsigned ra0[4][5], ra1[4][5]; bf16x8 rb0[4][2], rb1[4][2];
#define CONV_LOAD(RA, RB) do { \
        _Pragma("unroll") for (int rh = 0; rh < 2; ++rh) _Pragma("unroll") for (int ks = 0; ks < 2; ++ks) { const LAS unsigned* p_ = (const LAS unsigned*)(ap + 64 * ks - 64 * rh); \
            RA[rh * 2 + ks][0] = p_[0]; RA[rh * 2 + ks][1] = p_[1]; RA[rh * 2 + ks][2] = p_[2]; RA[rh * 2 + ks][3] = p_[3]; RA[rh * 2 + ks][4] = p_[4]; } \
        _Pragma("unroll") for (int ct = 0; ct < 4; ++ct) if ((TM >> ct) & 1) { \
            const LAS unsigned char* bp_ = (unsigned)(sb + 16 * ct) < 128u ? zp + 256 * ct : zero; \
            RB[ct][0] = *(const LAS bf16x8*)bp_; RB[ct][1] = *(const LAS bf16x8*)(bp_ + 8192); } \
        ap -= 128; zp -= 16; sb -= 1; } while (0)
#define CONV_MMA(RA, RB) do { \
        _Pragma("unroll") for (int rh = 0; rh < 2; ++rh) _Pragma("unroll") for (int ks = 0; ks < 2; ++ks) { const int a_ = rh * 2 + ks; \
            u32x4 e_ = {__builtin_amdgcn_alignbit(RA[a_][1], RA[a_][0], 16), __builtin_amdgcn_alignbit(RA[a_][2], RA[a_][1], 16), __builtin_amdgcn_alignbit(RA[a_][3], RA[a_][2], 16), __builtin_amdgcn_alignbit(RA[a_][4], RA[a_][3], 16)}; \
            u32x4 o_ = {RA[a_][0], RA[a_][1], RA[a_][2], RA[a_][3]}; \
            _Pragma("unroll") for (int ct = 0; ct < 4; ++ct) if ((TM >> ct) & 1) { \
                acc[0][rh][ct] = __builtin_amdgcn_mfma_f32_16x16x32_bf16(*reinterpret_cast<bf16x8*>(&e_), RB[ct][ks], acc[0][rh][ct], 0, 0, 0); \
                acc[1][rh][ct] = __builtin_amdgcn_mfma_f32_16x16x32_bf16(*reinterpret_cast<bf16x8*>(&o_), RB[ct][ks], acc[1][rh][ct], 0, 0, 0); } } } while (0)
    CONV_LOAD(ra0, rb0);
    for (int dl = dl0; dl <= dl1; dl += 2) {
        CONV_LOAD(ra1, rb1);
        __builtin_amdgcn_sched_barrier(0);
        CONV_MMA(ra0, rb0);
        __builtin_amdgcn_sched_barrier(0);
        if (dl + 2 > dl1) { ap += 128; zp += 16; sb += 1; }
        CONV_LOAD(ra0, rb0);
        __builtin_amdgcn_sched_barrier(0);
        CONV_MMA(ra1, rb1);
        __builtin_amdgcn_sched_barrier(0);
    }
#undef CONV_LOAD
#undef CONV_MMA
}
__device__ __forceinline__ void conv_wave(const LAS unsigned char* zl, const LAS unsigned char* rl, const LAS unsigned char* zero, int nh, int lane, f32x4v (&acc)[2][2][4]) {
    asm volatile("" : "+v"(lane));
    const int q = lane & 15, kg = lane >> 4;
#pragma unroll
    for (int a = 0; a < 2; ++a)
#pragma unroll
        for (int b = 0; b < 2; ++b)
#pragma unroll
            for (int c = 0; c < 4; ++c) acc[a][b][c] = f32x4v{0.f, 0.f, 0.f, 0.f};
    if (nh == 0) { conv_seg<15>(zl, rl, zero, nh, q, kg, -64, 15, acc); conv_seg<14>(zl, rl, zero, nh, q, kg, 16, 31, acc); conv_seg<12>(zl, rl, zero, nh, q, kg, 32, 47, acc); conv_seg<8>(zl, rl, zero, nh, q, kg, 48, 63, acc); }
    else         { conv_seg<1>(zl, rl, zero, nh, q, kg, -63, -48, acc); conv_seg<3>(zl, rl, zero, nh, q, kg, -47, -32, acc); conv_seg<7>(zl, rl, zero, nh, q, kg, -31, -16, acc); conv_seg<15>(zl, rl, zero, nh, q, kg, -15, 64, acc); }
}
}

#ifdef PROBE_SUB
#define PSUB(k_) do { const unsigned long long tn_ = __builtin_amdgcn_s_memrealtime(); if (PROBE_SUB == (k_)) tsub += tn_ - tprev_; tprev_ = tn_; } while (0)
#else
#define PSUB(k_)
#endif
__device__ __forceinline__ void phase_longconv_mfma(const Ctx& F, const bf16* XV, bf16* ZC, const bf16* RG, const float* fpart, const float* skip, unsigned long long& tsub) {
#ifdef PROBE_SUB
    unsigned long long tprev_ = __builtin_amdgcn_s_memrealtime();
#endif
    using namespace hconv;
    const int chs = F.wave >> 1, nh = F.wave & 1, q = F.lane & 15, kg = F.lane >> 4;
    LAS unsigned char* zl = F.lds + chs * ZBYTES; LAS unsigned char* rl = F.lds + 4 * ZBYTES + chs * RBYTES; LAS unsigned char* zero = F.lds + ZERO_OFF;
    if (F.tid < 4) { ((LAS unsigned*)zero)[F.tid] = 0u; ((LAS unsigned*)(zero + 8192))[F.tid] = 0u; }
    for (int grp = F.bid; grp < D / 4; grp += F.G) {
        const int c0 = grp * 4, c = c0 + chs;
        for (int qq = F.tid; qq < 4 * 1024; qq += NTHREADS) { const int cc = qq >> 10, pc = qq & 1023;
            const v4u v = *(const v4u*)(XV + (size_t)(2 * D + c0 + cc) * R + pc * 8);
            *(LAS v4u*)(F.lds + cc * ZBYTES + (pc & 7) * 2048 + (pc >> 3) * 16) = v; }
        { const char* gb = (const char*)(RG + (size_t)c0 * RLEN);
          for (unsigned qq = F.tid; qq < 4u * (RLEN / 8); qq += NTHREADS) *(LAS v4u*)(F.lds + 4 * ZBYTES + qq * 16u) = *(const v4u*)(gb + qq * 16u); }
        float s0, s1;
        { const float a = F.lane < FCH ? fpart[c * FCH + F.lane] : 0.f, b = F.lane < FCH ? fpart[(D + c) * FCH + F.lane] : 0.f;
          s0 = 1.0f / sqrtf(wave_sum(a) + EPS); s1 = 1.0f / sqrtf(wave_sum(b) + EPS); }
        const float sk0 = skip[c], sk1 = skip[D + c];
        __syncthreads();
        PSUB(1);
        f32x4v acc[2][2][4];
        conv_wave(zl, rl, zero, nh, F.lane, acc);
        PSUB(2);
        int tl = F.tid; asm volatile("" : "+v"(tl));
        v4u r1[9];
#pragma unroll
        for (int k = 0; k < 9; ++k) { const unsigned qq = (unsigned)tl + NTHREADS * k; const char* gb = (const char*)(RG + (size_t)(D + c0) * RLEN);
            r1[k] = qq < 4u * (RLEN / 8) ? *(const v4u*)(gb + qq * 16u) : (v4u){0u, 0u, 0u, 0u}; }
        __builtin_amdgcn_sched_barrier(0);
        __syncthreads();
#pragma unroll
        for (int ct = 0; ct < 4; ++ct) { const int tb = 64 * nh + 16 * ct + q;
#pragma unroll
            for (int rh = 0; rh < 2; ++rh) { LAS v4u* zp = (LAS v4u*)(zl + (4 * rh + kg) * 2048 + tb * 16);
                const v4u vv = *zp; const v4u xx = *(const v4u*)(XV + (size_t)c * R + 64 * tb + 32 * rh + 8 * kg);
                v4u w;
#pragma unroll
                for (int r = 0; r < 4; ++r) { const float ye = acc[0][rh][ct][r], yo = acc[1][rh][ct][r];
                    const float ze = bf2f(xx[r] & 0xffffu) * (s0 * ye + bf2f(vv[r] & 0xffffu) * sk0), zo = bf2f(xx[r] >> 16) * (s0 * yo + bf2f(vv[r] >> 16) * sk0);
                    w[r] = pk2(ze, zo); }
                *zp = w; } }
#pragma unroll
        for (int k = 0; k < 9; ++k) { const unsigned qq = (unsigned)tl + NTHREADS * k;
            if (qq < 4u * (RLEN / 8)) *(LAS v4u*)(F.lds + 4 * ZBYTES + qq * 16u) = r1[k]; }
        __syncthreads();
        PSUB(3);
        conv_wave(zl, rl, zero, nh, F.lane, acc);
        PSUB(4);
#pragma unroll
        for (int ct = 0; ct < 4; ++ct) { const int tb = 64 * nh + 16 * ct + q;
#pragma unroll
            for (int rh = 0; rh < 2; ++rh) { const v4u vv = *(const LAS v4u*)(zl + (4 * rh + kg) * 2048 + tb * 16);
                const v4u xx = *(const v4u*)(XV + (size_t)(D + c) * R + 64 * tb + 32 * rh + 8 * kg);
                v4u w;
#pragma unroll
                for (int r = 0; r < 4; ++r) { const float ye = acc[0][rh][ct][r], yo = acc[1][rh][ct][r];
                    const float ze = bf2f(xx[r] & 0xffffu) * (s1 * ye + bf2f(vv[r] & 0xffffu) * sk1), zo = bf2f(xx[r] >> 16) * (s1 * yo + bf2f(vv[r] >> 16) * sk1);
                    w[r] = pk2(ze, zo); }
                *(v4u*)(ZC + (size_t)c * R + 64 * tb + 32 * rh + 8 * kg) = w; } }
        __syncthreads();
        PSUB(5);
    }
}

__device__ __forceinline__ void phase_ctxconv(const Ctx& F, const bf16* XV, bf16* ZC, const float* FILTC, const float* fpartc, const float* skip) {
    LAS float* zs = (LAS float*)(F.lds + F.wave * 4096); LAS float* Tp = zs + 256;
    for (int c = F.gw; c < D; c += F.NGW) {
        const bf16* v = XV + (size_t)(2 * D + c) * R + S; const bf16* x1 = XV + (size_t)c * R + S; const bf16* x2 = XV + (size_t)(D + c) * R + S;
        float e0 = 0.f, e1 = 0.f;
#pragma unroll
        for (int t = 0; t < 8; ++t) { e0 += fpartc[c * 8 + t]; e1 += fpartc[(D + c) * 8 + t]; }
        const float s0 = 1.0f / sqrtf(e0 + EPS), s1 = 1.0f / sqrtf(e1 + EPS), sk0 = skip[c], sk1 = skip[D + c];
        float vv[4], acc[4], z2[4];
#pragma unroll
        for (int q = 0; q < 4; ++q) { vv[q] = bf2f(v[F.lane + 64 * q]); zs[F.lane + 64 * q] = vv[q]; }
#pragma unroll
        for (int q = 0; q < 8; ++q) { const int src = F.lane + 64 * q - 128; Tp[F.lane + 64 * q] = (unsigned)src < 256u ? FILTC[(size_t)c * C + src] : 0.f; }
        LDS_WAIT();
#pragma unroll
        for (int q = 0; q < 4; ++q) acc[q] = 0.f;
        for (int s = 0; s < C; ++s) { const float zv = zs[s];
#pragma unroll
            for (int q = 0; q < 4; ++q) acc[q] += zv * Tp[F.lane + 64 * q - s + 256]; }
#pragma unroll
        for (int q = 0; q < 4; ++q) z2[q] = bf2f(x1[F.lane + 64 * q]) * (s0 * acc[q] + vv[q] * sk0);
        LDS_WAIT();
#pragma unroll
        for (int q = 0; q < 4; ++q) zs[F.lane + 64 * q] = z2[q];
#pragma unroll
        for (int q = 0; q < 8; ++q) { const int src = F.lane + 64 * q - 128; Tp[F.lane + 64 * q] = (unsigned)src < 256u ? FILTC[(size_t)(D + c) * C + src] : 0.f; }
        LDS_WAIT();
#pragma unroll
        for (int q = 0; q < 4; ++q) acc[q] = 0.f;
        for (int s = 0; s < C; ++s) { const float zv = zs[s];
#pragma unroll
            for (int q = 0; q < 4; ++q) acc[q] += zv * Tp[F.lane + 64 * q - s + 256]; }
#pragma unroll
        for (int q = 0; q < 4; ++q) ZC[(size_t)c * R + S + F.lane + 64 * q] = (bf16)f2bf(bf2f(x2[F.lane + 64 * q]) * (s1 * acc[q] + z2[q] * sk1));
        LDS_WAIT();
    }
}
#ifndef RP_PRO
#define RP_PRO 1
#endif
#ifndef RP_FIL
#define RP_FIL 1
#endif
#ifndef RP_THIN
#define RP_THIN 1
#endif
#ifndef RP_ATT
#define RP_ATT 1
#endif
#ifndef RP_CONV
#define RP_CONV 1
#endif
#ifndef RP_GIN
#define RP_GIN 1
#endif
#ifndef RP_GUP
#define RP_GUP 1
#endif
#define REP(n) for (int rep_ = 0; rep_ < (n); ++rep_)
#define REPSYNC __syncthreads();
#ifdef PROBE_MASK
#ifndef PROBE_BLOCK
#define PROBE_BLOCK 0
#endif
#ifndef PROBE_MULT
#define PROBE_MULT 4
#endif
#define PROBE_T0 const unsigned long long t0_ = __builtin_amdgcn_s_memrealtime();
#define PROBE_T1 const unsigned long long t1_ = __builtin_amdgcn_s_memrealtime(); if ((PROBE_MASK >> pcat_) & 1) tacc_ += t1_ - t0_;
#ifndef PROBE_WMASK
#define PROBE_WMASK 0xffff
#endif
#define PROBE_T2 if (((PROBE_MASK >> 15) & 1) && ((PROBE_WMASK >> pcat_) & 1)) tacc_ += __builtin_amdgcn_s_memrealtime() - t1_;
#else
#define PROBE_T0
#define PROBE_T1
#define PROBE_T2
#endif
struct Args { const float* in[30]; float* out; unsigned char* ws; int ph_lo, ph_hi; };
typedef const float* const __attribute__((address_space(4)))* InTab;
#ifdef PROBE_GK
constexpr int N_PHASES = 1 + 4 * 9 + 2;
#else
constexpr int N_PHASES = 1 + 4 * 9 + 1;
#endif

__global__ void __launch_bounds__(NTHREADS, 2) fwd(Args args) {
    extern __shared__ __attribute__((aligned(16))) unsigned char lds_raw[];
    Ctx F;
    F.lds = (LAS unsigned char*)lds_raw;
    F.tid = threadIdx.x; F.lane = F.tid & 63; F.wave = __builtin_amdgcn_readfirstlane(F.tid >> 6);
    F.bid = blockIdx.x; F.G = gridDim.x; F.gw = F.bid * NWAVES + F.wave; F.NGW = F.G * NWAVES;
    unsigned char* ws = args.ws;
    volatile LAS unsigned* MISC = (volatile LAS unsigned*)(F.lds + MISC_OFF);
    if (F.tid < 32) MISC[F.tid] = 0u;
    __syncthreads();
    XcdBarrier bar; bar.bar = (unsigned*)(ws + WS_CTL) + CW_BAR; bar.x = 0; bar.st = nullptr;
#if MK_ONE_LAUNCH
    bar = xcd_barrier_post((unsigned*)(ws + WS_CTL) + CW_BAR, MISC + 8);
#endif
    const int lo = args.ph_lo, hi = args.ph_hi;
    int ph = 0;
    unsigned long long tsub_ = 0ull; (void)tsub_;
#ifdef PROBE_MASK
    unsigned long long tacc_ = 0ull;
#endif
#define CAS __attribute__((address_space(4)))
#define PH_BEGIN(cat_) if (ph >= lo && ph < hi) { const int pcat_ = (cat_); (void)pcat_; PROBE_T0 int tid_ = threadIdx.x; asm volatile("" : "+v"(tid_)); F.tid = tid_; F.lane = tid_ & 63; \
    const CAS unsigned char* ka_ = (const CAS unsigned char*)__builtin_amdgcn_kernarg_segment_ptr(); asm volatile("" : "+s"(ka_)); \
    InTab in = (InTab)ka_; unsigned char* ws = *(unsigned char* const CAS*)(ka_ + 248); float* out_ = *(float* const CAS*)(ka_ + 240); (void)out_; \
    float* misc = (float*)(ws + WS_MISC); bf16* X = (bf16*)(ws + WS_X); bf16* H = (bf16*)(ws + WS_H); bf16* QKV = (bf16*)(ws + WS_QKV); bf16* KP = (bf16*)(ws + WS_KP); bf16* VP = (bf16*)(ws + WS_VP); \
    bf16* O = (bf16*)(ws + WS_O); bf16* U = (bf16*)(ws + WS_U); bf16* UP = (bf16*)(ws + WS_UP); bf16* XV = (bf16*)(ws + WS_XV); bf16* ZC = (bf16*)(ws + WS_ZC); float* PART = (float*)(ws + WS_PART); \
    const float* rcos = misc + MO_RCOS; const float* rsin = misc + MO_RSIN; const float* mod = misc + MO_MOD + i * NMODW; const float* modc = misc + MO_MODC + i * NMODW; \
    (void)X; (void)H; (void)QKV; (void)KP; (void)VP; (void)O; (void)U; (void)UP; (void)XV; (void)ZC; (void)PART; (void)rcos; (void)rsin; (void)mod; (void)modc; (void)in;
#if MK_ONE_LAUNCH
#define PH_END PROBE_T1 if (ph + 1 < hi) xcd_barrier(bar); PROBE_T2 } ++ph;
#else
#define PH_END } ++ph;
#endif
    int i = 0;
    PH_BEGIN(0) REP(RP_PRO) { phase_prologue(F, in, ws); REPSYNC } PH_END

    for (i = 0; i < DEPTH; ++i) {
        const int j = i >> 1; const bool is_attn = (i & 1) == 0, ctx_upd = i < 2, has_ctx = is_attn || ctx_upd;
        const int nrows1 = has_ctx ? R : S, nrows2 = ctx_upd ? R : S;
        PH_BEGIN(2) if (i == 0) { REP(RP_FIL) { phase_filters(F, in, ws); REPSYNC } }
            REP(RP_THIN) { phase_norm_mod(F, X, H, nrows1, in[6] + i * D, mod, mod + D, modc, modc + D, PART, (i == 1 || i == 2) ? KS_DOWN : 0, modc - NMODW + 5 * D, nullptr); REPSYNC } PH_END
        PH_BEGIN(3) REP(RP_GIN) { const int N = is_attn ? AW : HW;
            pg8::Gemm g{H, is_attn ? (const bf16*)(ws + WS_WAIN) + (size_t)j * AW * D : (const bf16*)(ws + WS_WHIN) + (size_t)j * HW * D, nrows1, N, D};
            pg8::StaticOrder So; So.init(nrows1, N, D, F.G, F.bid);
            pg8::EpiBf16<0> E{is_attn ? QKV : UP, N, is_attn ? nullptr : in[14] + j * HW};
            pg8::gemm_phase<pg8::EpiBf16<0>, pg8::StaticOrder, PG8_ALIGN, PG8_SP2>(F.lds, g, So, E, F.tid); REPSYNC } PH_END
        if (is_attn) {
            PH_BEGIN(4) REP(RP_THIN) { phase_kprep(F, QKV, KP, VP, in[12] + j * HD, rcos, rsin); REPSYNC } PH_END
            PH_BEGIN(5) REP(RP_ATT) { phase_attn(F, QKV, KP, VP, O, ctx_upd, in[10] + j * 8, in[11] + j * HD, rcos, rsin); REPSYNC } PH_END
            ++ph;
        } else {
            PH_BEGIN(4) REP(RP_THIN) { phase_shortconv(F, UP, XV, in[15] + (size_t)j * 3 * HW, in[16] + j * HW, nrows2); REPSYNC } PH_END
            PH_BEGIN(6) REP(RP_CONV) { phase_longconv_mfma(F, XV, ZC, (const bf16*)(ws + WS_FILT) + (size_t)j * 4096 * 8320, misc + MO_FPART + j * 4096 * FCH, in[24] + j * 2 * D, tsub_);
                if (ctx_upd) { __syncthreads(); phase_ctxconv(F, XV, ZC, (const float*)(ws + WS_FILTC), misc + MO_FPARTC, in[24] + j * 2 * D); } REPSYNC } PH_END
            PH_BEGIN(4) REP(RP_THIN) { phase_transpose_zc(F, ZC, O, nrows2); REPSYNC } PH_END
        }
        PH_BEGIN(7) { pg8::Gemm g{O, is_attn ? (const bf16*)(ws + WS_WAOUT) + (size_t)j * D * D : (const bf16*)(ws + WS_WHOUT) + (size_t)j * D * D, S, D, D};
            pg8::StaticOrder So; So.init(S, D, D, F.G, F.bid); if (ctx_upd) So.extend(S / 256, KS_OUT);
            pg8::EpiResGate E{X, D, is_attn ? nullptr : in[26] + j * D, mod + 2 * D, modc + 2 * D, S / 256, PART};
            pg8::gemm_phase<pg8::EpiResGate, pg8::StaticOrder, PG8_ALIGN, PG8_SP2>(F.lds, g, So, E, F.tid); } PH_END
        PH_BEGIN(2) REP(RP_THIN) { phase_norm_mod(F, X, H, nrows2, in[7] + i * D, mod + 3 * D, mod + 4 * D, modc + 3 * D, modc + 4 * D, PART, ctx_upd ? KS_OUT : 0, modc + 2 * D, is_attn ? nullptr : in[26] + j * D); REPSYNC } PH_END
        PH_BEGIN(8) REP(RP_GUP) { pg8::Gemm g{H, (const bf16*)(ws + WS_WM1) + (size_t)i * FF * D, nrows2, FF, D}; pg8::StaticOrder So; So.init(nrows2, FF, D, F.G, F.bid);
            pg8::EpiBf16<1> E{U, FF, nullptr};
            pg8::gemm_phase<pg8::EpiBf16<1>, pg8::StaticOrder, PG8_ALIGN, PG8_SP2>(F.lds, g, So, E, F.tid); REPSYNC } PH_END
        PH_BEGIN(9) { pg8::Gemm g{U, (const bf16*)(ws + WS_WM2) + (size_t)i * D * FF, S, D, FF}; pg8::StaticOrder So; So.init(S, D, FF, F.G, F.bid); if (ctx_upd) So.extend(S / 256, KS_DOWN);
            pg8::EpiResGate E{X, D, nullptr, mod + 5 * D, modc + 5 * D, S / 256, PART};
            pg8::gemm_phase<pg8::EpiResGate, pg8::StaticOrder, PG8_ALIGN, PG8_SP2>(F.lds, g, So, E, F.tid); } PH_END
    }
#ifdef PROBE_GK
    PH_BEGIN(11) for (int rep_ = 0; rep_ < PROBE_GREPS; ++rep_) { pg8::Gemm g{H, (const bf16*)(ws + WS_WM1), S, FF, PROBE_GK}; pg8::StaticOrder So; So.init(S, FF, PROBE_GK, F.G, F.bid);
#ifdef PROBE_GNULL
            pg8::EpiNull E{};
            pg8::gemm_phase<pg8::EpiNull, pg8::StaticOrder, PG8_ALIGN, PG8_SP2>(F.lds, g, So, E, F.tid); __syncthreads(); } PH_END
#else
            pg8::EpiBf16<1> E{UP, FF, nullptr};
            pg8::gemm_phase<pg8::EpiBf16<1>, pg8::StaticOrder, PG8_ALIGN, PG8_SP2>(F.lds, g, So, E, F.tid); __syncthreads(); } PH_END
#endif
#endif
    PH_BEGIN(10) REP(RP_THIN) { phase_final_norm(F, X, out_, in[29]); REPSYNC } PH_END
#ifdef PROBE_MASK
    if (blockIdx.x == PROBE_BLOCK && threadIdx.x == 0) { const unsigned long long tend_ = __builtin_amdgcn_s_memrealtime() + (unsigned long long)PROBE_MULT * (tacc_ + tsub_); while (__builtin_amdgcn_s_memrealtime() < tend_) __builtin_amdgcn_s_sleep(32); }
#endif
#undef PH_BEGIN
#undef PH_END
}

extern "C" void kernel_launch(void* const* d_in, const int* in_sizes, int n_in, void* d_out, int out_size, void* d_ws, size_t ws_size, hipStream_t stream) {
    static int grid = 0;
    if (grid == 0) {
        if (n_in != 30 || out_size != S * D || ws_size < WS_END) { fprintf(stderr, "kernel_launch: unexpected shapes: n_in %d out %d ws %zu (need %zu)\n", n_in, out_size, ws_size, (size_t)WS_END); grid = -1; return; }
        int dev = 0, cus = 0, per_cu = 0;
        if (hipGetDevice(&dev) != hipSuccess || hipDeviceGetAttribute(&cus, hipDeviceAttributeMultiprocessorCount, dev) != hipSuccess) { grid = -1; return; }
        if (hipFuncSetAttribute((const void*)fwd, hipFuncAttributeMaxDynamicSharedMemorySize, LDS_BYTES) != hipSuccess) { fprintf(stderr, "kernel_launch: hipFuncSetAttribute failed\n"); grid = -1; return; }
        if (hipOccupancyMaxActiveBlocksPerMultiprocessor(&per_cu, (const void*)fwd, NTHREADS, LDS_BYTES) != hipSuccess || per_cu < 1)
            fprintf(stderr, "kernel_launch: occupancy query reports %d workgroups per CU\n", per_cu);
        (void)hipGetLastError();
        grid = cus;
    }
    if (grid < 0) return;
    (void)hipMemsetAsync((char*)d_ws + WS_CTL, 0, CTL_ZERO_BYTES, stream);
    Args a{};
    for (int i = 0; i < 30; ++i) a.in[i] = (const float*)d_in[i];
    a.out = (float*)d_out; a.ws = (unsigned char*)d_ws;
#if MK_ONE_LAUNCH
    a.ph_lo = 0; a.ph_hi = N_PHASES;
    hipLaunchKernelGGL(fwd, dim3(grid), dim3(NTHREADS), LDS_BYTES, stream, a);
#else
    for (int p = 0; p < N_PHASES; ++p) { a.ph_lo = p; a.ph_hi = p + 1; hipLaunchKernelGGL(fwd, dim3(grid), dim3(NTHREADS), LDS_BYTES, stream, a); }
#endif
    const hipError_t le = hipPeekAtLastError();
    if (le != hipSuccess) fprintf(stderr, "kernel_launch: launch failed: %s\n", hipGetErrorName(le));
}
```
